# Optimizing an MI355X kernel written in HIP

```python
import math
import jax
import jax.numpy as jnp
from jax import lax
import numpy as np

D_MODEL = 1024
BATCH = 32
SEQ = 2048
DEPTH = 1
DEC_BATCH = 32
DEC_SEQ = 64
PAST_LEN = 1024

CHUNK = 64
Q_BLOCK = 128
ROPE_THETA = 10000.0
EPS = 1e-5
F32 = jnp.float32
N_HEADS_A = 8
HEAD_DIM_A = D_MODEL // (2 * N_HEADS_A)
V_DIM_A = 2 * HEAD_DIM_A
ATTN_WIDTH = N_HEADS_A * V_DIM_A
SCALE_A = HEAD_DIM_A ** -0.5
EXPAND = 2
D_INNER = EXPAND * D_MODEL
HEAD_DIM_S = 64
N_HEADS_S = D_INNER // HEAD_DIM_S
N_GROUPS_S = 4
HEADS_PER_GROUP = N_HEADS_S // N_GROUPS_S
D_STATE = 128
CONV_W = 4
CONV_DIM = D_INNER + 2 * N_GROUPS_S * D_STATE
D_FF = 256 * (-(-(8 * D_MODEL) // (3 * 256)))
OFF_K = 2 * N_HEADS_A * HEAD_DIM_A
OFF_V = OFF_K + 2 * N_HEADS_A * HEAD_DIM_A
OFF_Z = OFF_V + ATTN_WIDTH
OFF_XBC = OFF_Z + D_INNER
OFF_DT = OFF_XBC + CONV_DIM
OFF_GATE = OFF_DT + N_HEADS_S
IN_COLS = OFF_GATE + 2 * D_MODEL

kernel_name = "diffattn_ssd_gated_hybrid_stream_step"


def rmsnorm(x, g):
    xf = x.astype(F32)
    xf = xf * lax.rsqrt(jnp.mean(xf * xf, axis=-1, keepdims=True) + EPS)
    return (xf * g.astype(F32)).astype(x.dtype)


def rope(x, pos):
    half = x.shape[-1] // 2
    inv = ROPE_THETA ** (-jnp.arange(half, dtype=F32) / half)
    ang = pos.astype(F32)[:, None] * inv[None, :]
    cos = jnp.cos(ang)[None, :, None, :]
    sin = jnp.sin(ang)[None, :, None, :]
    xf = x.astype(F32)
    x1, x2 = xf[..., :half], xf[..., half:]
    return jnp.concatenate([x1 * cos - x2 * sin, x2 * cos + x1 * sin], axis=-1).astype(x.dtype)


def diff_combine(probs, v, lam):
    b, _, tq, tk = probs.shape
    p = probs.reshape(b, N_HEADS_A, 2, tq, tk)
    w = p[:, :, 0] - lam * p[:, :, 1]
    return jnp.einsum("bhqk,bkhe->bqhe", w, v.astype(F32))


def diff_attn_prompt(q, k, v, lam):
    b, t = q.shape[:2]
    nb = t // Q_BLOCK
    qb = q.reshape(b, nb, Q_BLOCK, 2 * N_HEADS_A, HEAD_DIM_A).swapaxes(0, 1)
    key_chunk = jnp.arange(t) // CHUNK

    def one_block(args):
        qi, blk = args
        q_chunk = (blk * Q_BLOCK + jnp.arange(Q_BLOCK)) // CHUNK
        mask = key_chunk[None, :] <= q_chunk[:, None]
        s = jnp.einsum("bqhd,bkhd->bhqk", qi, k, preferred_element_type=F32) * SCALE_A
        s = jnp.where(mask[None, None], s, -jnp.inf)
        return diff_combine(jax.nn.softmax(s, axis=-1), v, lam)

    out = lax.map(one_block, (qb, jnp.arange(nb)))
    return out.swapaxes(0, 1).reshape(b, t, N_HEADS_A, V_DIM_A)


def diff_attn_full(q, k, v, lam):
    s = jnp.einsum("bqhd,bkhd->bhqk", q, k, preferred_element_type=F32) * SCALE_A
    return diff_combine(jax.nn.softmax(s, axis=-1), v, lam)


def causal_conv(u, buf, w, bias):
    t = u.shape[1]
    full = jnp.concatenate([buf.astype(u.dtype), u], axis=1)
    out = bias.astype(u.dtype) + full[:, 0:t] * w[0]
    for j in range(1, CONV_W):
        out = out + full[:, j:j + t] * w[j]
    return out, full[:, -(CONV_W - 1):].astype(buf.dtype)


def ssd_scan(xdt, dA, bm, cm, s0, chunk):
    b, t = xdt.shape[:2]
    nc = t // chunk

    def to_chunks(a):
        a = a.astype(F32)
        return a.reshape((b, nc, chunk) + a.shape[2:]).swapaxes(0, 1)

    xs = (to_chunks(xdt.reshape(b, t, N_GROUPS_S, HEADS_PER_GROUP, HEAD_DIM_S)),
          to_chunks(dA.reshape(b, t, N_GROUPS_S, HEADS_PER_GROUP)),
          to_chunks(bm), to_chunks(cm))
    causal = jnp.tril(jnp.ones((chunk, chunk), dtype=bool))[None, :, :, None, None]

    def step(state, inp):
        xc, ac, bc, cc = inp
        cum = jnp.cumsum(ac, axis=1)
        seg = cum[:, :, None] - cum[:, None, :]
        decay = jnp.exp(jnp.where(causal, seg, -jnp.inf))
        cb = jnp.einsum("blgn,bsgn->blsg", cc, bc)
        y_diag = jnp.einsum("blsg,blsgk,bsgkp->blgkp", cb, decay, xc)
        y_off = jnp.einsum("blgn,bgkpn->blgkp", cc, state) * jnp.exp(cum)[..., None]
        to_end = jnp.exp(cum[:, -1:] - cum)
        new_state = (state * jnp.exp(cum[:, -1])[..., None, None]
                     + jnp.einsum("bsgn,bsgk,bsgkp->bgkpn", bc, to_end, xc))
        return new_state, y_diag + y_off

    init = s0.astype(F32).reshape(b, N_GROUPS_S, HEADS_PER_GROUP, HEAD_DIM_S, D_STATE)
    s_fin, ys = lax.scan(step, init, xs)
    y = ys.swapaxes(0, 1).reshape(b, t, N_HEADS_S, HEAD_DIM_S)
    return y, s_fin.reshape(b, N_HEADS_S, HEAD_DIM_S, D_STATE)


def gated_group_rmsnorm(y, z, g):
    b, t, _ = y.shape
    u = (y.astype(F32) * jax.nn.silu(z.astype(F32))).reshape(b, t, N_GROUPS_S, D_INNER // N_GROUPS_S)
    u = u * lax.rsqrt(jnp.mean(u * u, axis=-1, keepdims=True) + EPS)
    return u.reshape(b, t, D_INNER) * g.astype(F32)


def trunk_layer(x, c, pos, k_past, v_past, conv_buf, ssm_state, lp, lam_init):
    (w_ada, b_ada, g_mix, g_ffn, w_in, lq1, lk1, lq2, lk2, g_subln, conv_w, conv_b,
     dt_bias, a_log, d_skip, g_ssd, w_pa, w_pb, w_out, w_gu, w_down) = lp
    b, t, _ = x.shape
    dt_x = x.dtype
    mod = jnp.einsum("bd,de->be", jax.nn.silu(c), w_ada) + b_ada
    sh_m, sc_m, gt_m, sh_f, sc_f, gt_f = jnp.split(mod[:, None, :], 6, axis=-1)

    h = rmsnorm(x, g_mix) * (1 + sc_m) + sh_m
    proj = jnp.einsum("btd,de->bte", h, w_in)
    q, k, v, z, xbc, dt_raw, gates = jnp.split(
        proj, [OFF_K, OFF_V, OFF_Z, OFF_XBC, OFF_DT, OFF_GATE], axis=-1)

    q = rope(q.reshape(b, t, 2 * N_HEADS_A, HEAD_DIM_A), pos)
    k = rope(k.reshape(b, t, 2 * N_HEADS_A, HEAD_DIM_A), pos)
    v = v.reshape(b, t, N_HEADS_A, V_DIM_A)
    lam = (jnp.exp(jnp.sum(lq1.astype(F32) * lk1.astype(F32)))
           - jnp.exp(jnp.sum(lq2.astype(F32) * lk2.astype(F32))) + lam_init)
    if k_past is None:
        o = diff_attn_prompt(q, k, v, lam)
    else:
        o = diff_attn_full(q, jnp.concatenate([k_past.astype(k.dtype), k], axis=1),
                           jnp.concatenate([v_past.astype(v.dtype), v], axis=1), lam)
    o = rmsnorm(o, g_subln) * (1.0 - lam_init)
    y_a = jnp.einsum("bte,ed->btd", o.reshape(b, t, ATTN_WIDTH).astype(dt_x), w_pa)

    xbc_c, conv_new = causal_conv(xbc, conv_buf, conv_w, conv_b)
    xbc_c = jax.nn.silu(xbc_c)
    xs, bm, cm = jnp.split(xbc_c, [D_INNER, D_INNER + N_GROUPS_S * D_STATE], axis=-1)
    xs = xs.reshape(b, t, N_HEADS_S, HEAD_DIM_S)
    bm = bm.reshape(b, t, N_GROUPS_S, D_STATE)
    cm = cm.reshape(b, t, N_GROUPS_S, D_STATE)
    dt = jax.nn.softplus(dt_raw.astype(F32) + dt_bias.astype(F32))
    a = -jnp.exp(a_log.astype(F32))
    y_s, ssm_new = ssd_scan(xs.astype(F32) * dt[..., None], dt * a, bm, cm, ssm_state, min(CHUNK, t))
    y_s = y_s + d_skip.astype(F32)[:, None] * xs.astype(F32)
    y_s = gated_group_rmsnorm(y_s.reshape(b, t, D_INNER), z, g_ssd).astype(dt_x)
    y_b = jnp.einsum("bte,ed->btd", y_s, w_pb)

    g_a, g_b = jnp.split(gates, 2, axis=-1)
    merged = jax.nn.sigmoid(g_a) * y_a + jax.nn.sigmoid(g_b) * y_b
    x = x + gt_m * jnp.einsum("btd,de->bte", merged, w_out)

    h2 = rmsnorm(x, g_ffn) * (1 + sc_f) + sh_f
    gate_ff, up_ff = jnp.split(jnp.einsum("btd,df->btf", h2, w_gu), 2, axis=-1)
    x = x + gt_f * jnp.einsum("btf,fd->btd", jax.nn.silu(gate_ff) * up_ff, w_down)
    return x.astype(dt_x), (k, v, conv_new, ssm_new.astype(ssm_state.dtype))


def setup_inputs(seed: int = 0) -> dict:
    key = jax.random.key(seed)
    ks = jax.random.split(key, 32)
    nrm = lambda k, shape, s: jax.random.normal(k, shape, F32) * s
    gain = lambda k, shape: 1.0 + 0.01 * jax.random.normal(k, shape, F32)
    u = jax.random.uniform(ks[20], (DEPTH, N_HEADS_S), F32)
    dt0 = jnp.exp(u * (math.log(0.1) - math.log(1e-3)) + math.log(1e-3))
    return {
        "x_prompt": nrm(ks[0], (BATCH, SEQ, D_MODEL), 1.0),
        "x_sample": nrm(ks[1], (DEC_BATCH, DEC_SEQ, D_MODEL), 1.0),
        "cache_k": nrm(ks[2], (DEPTH, DEC_BATCH, PAST_LEN, 2 * N_HEADS_A, HEAD_DIM_A), 1.0),
        "cache_v": nrm(ks[3], (DEPTH, DEC_BATCH, PAST_LEN, N_HEADS_A, V_DIM_A), 1.0),
        "state_conv": nrm(ks[4], (DEPTH, DEC_BATCH, CONV_W - 1, CONV_DIM), 1.0),
        "state_ssm": nrm(ks[5], (DEPTH, DEC_BATCH, N_HEADS_S, HEAD_DIM_S, D_STATE), 0.1),
        "c_prompt": nrm(ks[6], (BATCH, D_MODEL), 1.0),
        "c_sample": nrm(ks[7], (DEC_BATCH, D_MODEL), 1.0),
        "w_ada": nrm(ks[8], (DEPTH, D_MODEL, 6 * D_MODEL), 0.5 * D_MODEL ** -0.5),
        "b_ada": nrm(ks[9], (DEPTH, 6 * D_MODEL), 0.01),
        "g_mix": gain(ks[10], (DEPTH, D_MODEL)),
        "g_ffn": gain(ks[11], (DEPTH, D_MODEL)),
        "w_in": nrm(ks[12], (DEPTH, D_MODEL, IN_COLS), D_MODEL ** -0.5),
        "lambda_q1": nrm(ks[13], (DEPTH, HEAD_DIM_A), 0.1),
        "lambda_k1": nrm(ks[14], (DEPTH, HEAD_DIM_A), 0.1),
        "lambda_q2": nrm(ks[15], (DEPTH, HEAD_DIM_A), 0.1),
        "lambda_k2": nrm(ks[16], (DEPTH, HEAD_DIM_A), 0.1),
        "g_subln": gain(ks[17], (DEPTH, V_DIM_A)),
        "conv_w": nrm(ks[18], (DEPTH, CONV_W, CONV_DIM), CONV_W ** -0.5),
        "conv_b": nrm(ks[19], (DEPTH, CONV_DIM), 0.01),
        "dt_bias": dt0 + jnp.log(-jnp.expm1(-dt0)),
        "a_log": jnp.log(jax.random.uniform(ks[21], (DEPTH, N_HEADS_S), F32, 1.0, 16.0)),
        "d_skip": gain(ks[22], (DEPTH, N_HEADS_S)),
        "g_ssd": gain(ks[23], (DEPTH, D_INNER)),
        "w_pa": nrm(ks[24], (DEPTH, ATTN_WIDTH, D_MODEL), ATTN_WIDTH ** -0.5),
        "w_pb": nrm(ks[25], (DEPTH, D_INNER, D_MODEL), D_INNER ** -0.5),
        "w_out": nrm(ks[26], (DEPTH, D_MODEL, D_MODEL), D_MODEL ** -0.5),
        "w_gu": nrm(ks[27], (DEPTH, D_MODEL, 2 * D_FF), D_MODEL ** -0.5),
        "w_down": nrm(ks[28], (DEPTH, D_FF, D_MODEL), D_FF ** -0.5),
        "g_final": gain(ks[29], (D_MODEL,)),
    }


def reference(x_prompt, x_sample, cache_k, cache_v, state_conv, state_ssm, c_prompt, c_sample,
              w_ada, b_ada, g_mix, g_ffn, w_in, lambda_q1, lambda_k1, lambda_q2, lambda_k2, g_subln,
              conv_w, conv_b, dt_bias, a_log, d_skip, g_ssd, w_pa, w_pb, w_out, w_gu, w_down, g_final):
    bp, tp = x_prompt.shape[:2]
    ts = x_sample.shape[1]
    past = cache_k.shape[2]
    pos_p = jnp.arange(tp)
    pos_s = past + jnp.arange(ts)
    xp, xs = x_prompt, x_sample
    kp_l, vp_l, cp_l, sp_l, ks_l, vs_l, cs_l, ss_l = [], [], [], [], [], [], [], []
    for layer in range(DEPTH):
        lp = (w_ada[layer], b_ada[layer], g_mix[layer], g_ffn[layer], w_in[layer],
              lambda_q1[layer], lambda_k1[layer], lambda_q2[layer], lambda_k2[layer], g_subln[layer],
              conv_w[layer], conv_b[layer], dt_bias[layer], a_log[layer], d_skip[layer], g_ssd[layer],
              w_pa[layer], w_pb[layer], w_out[layer], w_gu[layer], w_down[layer])
        lam_init = 0.8 - 0.6 * math.exp(-0.3 * layer)
        zero_conv = jnp.zeros((bp, CONV_W - 1, CONV_DIM), x_prompt.dtype)
        zero_ssm = jnp.zeros((bp, N_HEADS_S, HEAD_DIM_S, D_STATE), x_prompt.dtype)
        xp, (k_p, v_p, c_p, s_p) = trunk_layer(xp, c_prompt, pos_p, None, None, zero_conv, zero_ssm, lp, lam_init)
        xs, (k_s, v_s, c_s, s_s) = trunk_layer(xs, c_sample, pos_s, cache_k[layer], cache_v[layer],
                                               state_conv[layer], state_ssm[layer], lp, lam_init)
        kp_l.append(k_p); vp_l.append(v_p); cp_l.append(c_p); sp_l.append(s_p)
        ks_l.append(k_s); vs_l.append(v_s); cs_l.append(c_s); ss_l.append(s_s)
    y_prompt = rmsnorm(xp, g_final)
    y_sample = rmsnorm(xs, g_final)
    new_k_prompt = jnp.stack(kp_l)
    new_v_prompt = jnp.stack(vp_l)
    new_conv_prompt = jnp.stack(cp_l)
    new_ssm_prompt = jnp.stack(sp_l)
    new_k_sample = jnp.stack(ks_l)
    new_v_sample = jnp.stack(vs_l)
    new_conv_sample = jnp.stack(cs_l)
    new_ssm_sample = jnp.stack(ss_l)
    return (y_prompt, y_sample, new_k_prompt, new_v_prompt, new_conv_prompt, new_ssm_prompt,
            new_k_sample, new_v_sample, new_conv_sample, new_ssm_sample)
```

```cpp
#include <hip/hip_runtime.h>
#include <hip/hip_cooperative_groups.h>
#include <cstdio>
namespace cg = cooperative_groups;

#define LAS __attribute__((address_space(3)))
typedef unsigned short bf16_t;
typedef short bf16x8 __attribute__((ext_vector_type(8)));
typedef short s16x4 __attribute__((ext_vector_type(4)));
typedef float f32x4 __attribute__((ext_vector_type(4)));
typedef float f32x16 __attribute__((ext_vector_type(16)));
typedef unsigned u32x4 __attribute__((ext_vector_type(4)));
typedef unsigned u32x2 __attribute__((ext_vector_type(2)));

constexpr int MP = 65536, MS = 2048, MT = MP + MS;
constexpr int LDS_BYTES = 131072;
constexpr float EPSN = 1e-5f;
constexpr float LOG2E = 1.4426950408889634f;

constexpr size_t al256(size_t x) { return (x + 255) & ~(size_t)255; }
constexpr size_t WS_BT1A = 0, WS_BT1B = WS_BT1A + al256((size_t)3072 * 1024 * 2), WS_BT1C = WS_BT1B + al256((size_t)5376 * 1024 * 2), WS_BTPA = WS_BT1C + al256((size_t)2048 * 1024 * 2),
    WS_BTPB = WS_BTPA + al256((size_t)1024 * 1024 * 2), WS_BTOUT = WS_BTPB + al256((size_t)1024 * 2048 * 2), WS_BTGU = WS_BTOUT + al256((size_t)1024 * 1024 * 2), WS_BTDOWN = WS_BTGU + al256((size_t)5632 * 1024 * 2),
    WS_MOD = WS_BTDOWN + al256((size_t)1024 * 2816 * 2), WS_ROPE = WS_MOD + al256((size_t)64 * 6144 * 4), WS_DT = WS_ROPE + al256((size_t)2048 * 32 * 8), WS_SS = WS_DT + al256((size_t)MT * 32 * 4),
    WS_RH = WS_SS + al256((size_t)MT * 8 * 4), WS_RBIG = WS_RH + al256((size_t)MT * 1024 * 2), WS_RZ = WS_RBIG + al256((size_t)MT * 3072 * 2), WS_END = WS_RZ + al256((size_t)MT * 2048 * 2);
constexpr size_t O_NKP = (size_t)MT * 1024, O_NVP = O_NKP + (size_t)MP * 1024, O_NCP = O_NVP + (size_t)MP * 1024, O_NSP = O_NCP + 32 * 3 * 3072, O_NKS = O_NSP + (size_t)32 * 32 * 64 * 128,
    O_NVS = O_NKS + (size_t)MS * 1024, O_NCS = O_NVS + (size_t)MS * 1024, O_NSS = O_NCS + 32 * 3 * 3072, O_END = O_NSS + (size_t)32 * 32 * 64 * 128;
struct Params {
    const float *x_p, *x_s, *cache_k, *cache_v, *state_conv, *state_ssm, *c_p, *c_s;
    const float *w_ada, *b_ada, *g_mix, *g_ffn, *w_in, *lq1, *lk1, *lq2, *lk2, *g_subln, *conv_w, *conv_b, *dt_bias, *a_log, *d_skip, *g_ssd;
    const float *w_pa, *w_pb, *w_out, *w_gu, *w_down, *g_final;
    float* out; unsigned char* ws;
    int ph_lo, ph_hi;
    __device__ __forceinline__ float* y() const { return out; }
    __device__ __forceinline__ float* nk_p() const { return out + O_NKP; }
    __device__ __forceinline__ float* nv_p() const { return out + O_NVP; }
    __device__ __forceinline__ float* nconv_p() const { return out + O_NCP; }
    __device__ __forceinline__ float* nssm_p() const { return out + O_NSP; }
    __device__ __forceinline__ float* nk_s() const { return out + O_NKS; }
    __device__ __forceinline__ float* nv_s() const { return out + O_NVS; }
    __device__ __forceinline__ float* nconv_s() const { return out + O_NCS; }
    __device__ __forceinline__ float* nssm_s() const { return out + O_NSS; }
    __device__ __forceinline__ bf16_t* bt1a() const { return (bf16_t*)(ws + WS_BT1A); }
    __device__ __forceinline__ bf16_t* bt1b() const { return (bf16_t*)(ws + WS_BT1B); }
    __device__ __forceinline__ bf16_t* bt1c() const { return (bf16_t*)(ws + WS_BT1C); }
    __device__ __forceinline__ bf16_t* btpa() const { return (bf16_t*)(ws + WS_BTPA); }
    __device__ __forceinline__ bf16_t* btpb() const { return (bf16_t*)(ws + WS_BTPB); }
    __device__ __forceinline__ bf16_t* btout() const { return (bf16_t*)(ws + WS_BTOUT); }
    __device__ __forceinline__ bf16_t* btgu() const { return (bf16_t*)(ws + WS_BTGU); }
    __device__ __forceinline__ bf16_t* btdown() const { return (bf16_t*)(ws + WS_BTDOWN); }
    __device__ __forceinline__ float* mod() const { return (float*)(ws + WS_MOD); }
    __device__ __forceinline__ float2* rope() const { return (float2*)(ws + WS_ROPE); }
    __device__ __forceinline__ float* dtbuf() const { return (float*)(ws + WS_DT); }
    __device__ __forceinline__ float* ssbuf() const { return (float*)(ws + WS_SS); }
    __device__ __forceinline__ bf16_t* hA() const { return (bf16_t*)(ws + WS_RH); }
    __device__ __forceinline__ bf16_t* mbuf() const { return (bf16_t*)(ws + WS_RH); }
    __device__ __forceinline__ bf16_t* h2() const { return (bf16_t*)(ws + WS_RH); }
    __device__ __forceinline__ bf16_t* qbuf() const { return (bf16_t*)out; }
    __device__ __forceinline__ bf16_t* kbuf_p() const { return (bf16_t*)(ws + WS_RBIG); }
    __device__ __forceinline__ bf16_t* vbuf_p() const { return (bf16_t*)(ws + WS_RBIG) + (size_t)MP * 1024; }
    __device__ __forceinline__ bf16_t* kbuf_s() const { return (bf16_t*)(ws + WS_RBIG) + (size_t)2 * MP * 1024; }
    __device__ __forceinline__ bf16_t* vbuf_s() const { return (bf16_t*)(ws + WS_RBIG) + (size_t)2 * MP * 1024 + (size_t)32 * 1088 * 1024; }
    __device__ __forceinline__ bf16_t* xbcbuf() const { return (bf16_t*)(ws + WS_RBIG); }
    __device__ __forceinline__ bf16_t* gbuf() const { return (bf16_t*)(ws + WS_RBIG); }
    __device__ __forceinline__ bf16_t* swbuf() const { return (bf16_t*)(ws + WS_RBIG); }
    __device__ __forceinline__ bf16_t* zbuf() const { return (bf16_t*)(ws + WS_RZ); }
};

typedef float f32x2_t __attribute__((ext_vector_type(2)));
typedef __bf16 bf16x2_t __attribute__((ext_vector_type(2)));
__device__ __forceinline__ unsigned cvt_pk_bf16(float lo, float hi) { const f32x2_t v = {lo, hi}; const bf16x2_t b = __builtin_convertvector(v, bf16x2_t); return __builtin_bit_cast(unsigned, b); }
__device__ __forceinline__ float bf_lo(unsigned w) { return __uint_as_float(w << 16); }
__device__ __forceinline__ float bf_hi(unsigned w) { return __uint_as_float(w & 0xffff0000u); }
__device__ __forceinline__ float fexp2(float x) { return __builtin_amdgcn_exp2f(x); }
__device__ __forceinline__ float fexp(float x) { return __builtin_amdgcn_exp2f(x * LOG2E); }
__device__ __forceinline__ float frcp(float x) { return __builtin_amdgcn_rcpf(x); }
__device__ __forceinline__ float sigmoidf_(float x) { return frcp(1.0f + fexp(-x)); }
__device__ __forceinline__ float siluf_(float x) { return x * sigmoidf_(x); }
__device__ __forceinline__ u32x4 pack8(f32x4 a, f32x4 b) { u32x4 w; w.x = cvt_pk_bf16(a[0], a[1]); w.y = cvt_pk_bf16(a[2], a[3]); w.z = cvt_pk_bf16(b[0], b[1]); w.w = cvt_pk_bf16(b[2], b[3]); return w; }
__device__ __forceinline__ u32x2 pack4(f32x4 a) { u32x2 w; w.x = cvt_pk_bf16(a[0], a[1]); w.y = cvt_pk_bf16(a[2], a[3]); return w; }

__device__ __forceinline__ int opaque_tid() { int t = threadIdx.x; asm volatile("" : "+v"(t)); return t; }
namespace pg8 {
constexpr int BM = 256, BK = 64, HALF = 128, HTB = HALF * BK * 2, STAGE_BYTES = 8 * HTB, NXCD = 8, WGM = 8;
__host__ __device__ __forceinline__ int lds_byte(int r, int c) { const int st = (r >> 4) * 2 + (c >> 5), rr = r & 15, cc = c & 31, ob = rr * 64 + cc * 2; return st * 1024 + (ob ^ (((ob >> 9) & 1) << 5)); }
__host__ __device__ __forceinline__ void stage_rc(int b, int& R, int& C) { const int st = b / 1024, sb = b % 1024, swz = sb ^ (((sb >> 9) & 1) << 5); R = (st >> 1) * 16 + swz / 64; C = (st & 1) * 32 + (swz % 64) / 2; }
struct Unit { int pm, pn; };
struct Gemm { const bf16_t* A; const bf16_t* Bt; int M, N, K; };
struct StaticOrder {
    int nM, nN, nwg, G, c;
    __host__ __device__ void init(int M, int N, int G_, int c_) { nM = M / BM; nN = N / BM; nwg = nM * nN; G = G_; c = c_; }
    __host__ __device__ bool next(int i, Unit& u) const {
        const long L = (long)i * G + c; if (L >= nwg) return false;
        int wgid = (int)L; { const int q = nwg / NXCD, r = nwg % NXCD, xcd = wgid % NXCD, off = wgid / NXCD; wgid = (xcd < r ? xcd * (q + 1) : r * (q + 1) + (xcd - r) * q) + off; }
        const int nig = WGM * nN, gid = wgid / nig, fm = gid * WGM, gsz = (nM - fm) < WGM ? (nM - fm) : WGM;
        u.pm = fm + ((wgid % nig) % gsz); u.pn = (wgid % nig) / gsz; return true;
    }
};

template <class Epi>
__device__ __forceinline__ void gemm_phase(LAS unsigned char* lds, const Gemm g, const StaticOrder& S, const Epi& E) {
    const int tid = opaque_tid(), wid = __builtin_amdgcn_readfirstlane(tid >> 6), lane = tid & 63, wr = wid >> 2, wc = wid & 3, fr = lane & 15, fq = lane >> 4;
    const int K = g.K, nt = K / BK;
    unsigned voffA[2], voffB[2];
#pragma unroll
    for (int i = 0; i < 2; ++i) { int R, C; stage_rc(tid * 16 + i * 8192, R, C); voffA[i] = (unsigned)(R * K + C) * 2u; voffB[i] = voffA[i]; }
    const size_t kstep = (size_t)(BK * 2);
    const size_t hstep = (size_t)HALF * K * 2;
    const size_t tstep = 2 * hstep;
    const unsigned ldsw = (unsigned)wid * 1024u;
    const int aoff = lds_byte(wr * 64 + fr, fq * 8), boff = lds_byte(wc * 32 + fr, fq * 8);
#define PG8_SA(b, h) (((b) * 2 + (h)) * HTB)
#define PG8_SB(b, h) ((4 + (b) * 2 + (h)) * HTB)
#define PG8_STAGE(bufoff, gbase, voff) do { _Pragma("unroll") for (int _i = 0; _i < 2; ++_i) \
        __builtin_amdgcn_global_load_lds((const unsigned*)((const char*)(gbase) + (voff)[_i]), (LAS unsigned*)(lds + (bufoff) + ldsw + _i * 8192), 16, 0, 0); } while (0)
#define PG8_LDA(dst, b, h) do { _Pragma("unroll") for (int m = 0; m < 4; ++m) _Pragma("unroll") for (int k = 0; k < 2; ++k) dst[m][k] = *(const LAS bf16x8*)(lds + PG8_SA(b, h) + aoff + m * 2048 + k * 1024); } while (0)
#define PG8_LDB(dst, b, h) do { _Pragma("unroll") for (int n = 0; n < 2; ++n) _Pragma("unroll") for (int k = 0; k < 2; ++k) dst[n][k] = *(const LAS bf16x8*)(lds + PG8_SB(b, h) + boff + n * 2048 + k * 1024); } while (0)
#define PG8_MMA(ai, bj, At, Bt) do { __builtin_amdgcn_s_setprio(1); _Pragma("unroll") for (int m = 0; m < 4; ++m) _Pragma("unroll") for (int n = 0; n < 2; ++n) _Pragma("unroll") for (int k = 0; k < 2; ++k) \
        acc[ai][bj][m][n] = __builtin_amdgcn_mfma_f32_16x16x32_bf16(Bt[n][k], At[m][k], acc[ai][bj][m][n], 0, 0, 0); __builtin_amdgcn_s_setprio(0); } while (0)
#define PG8_WAIT_V(n) asm volatile("s_waitcnt vmcnt(" #n ")" ::: "memory")
#define PG8_WAIT_L(n) asm volatile("s_waitcnt lgkmcnt(" #n ")" ::: "memory")
#define PG8_BAR __builtin_amdgcn_s_barrier()
#define PG8_SCHED __builtin_amdgcn_sched_barrier(0)
    Unit cur, nxt; int ui = 0;
    if (!S.next(0, cur)) return;
    f32x4 acc[2][2][4][2];
#pragma unroll
    for (int a = 0; a < 2; ++a)
#pragma unroll
        for (int b = 0; b < 2; ++b)
#pragma unroll
            for (int m = 0; m < 4; ++m)
#pragma unroll
                for (int n = 0; n < 2; ++n) acc[a][b][m][n] = (f32x4){0.f, 0.f, 0.f, 0.f};
    bf16x8 At[4][2], B0[2][2], B1[2][2];
    const char* cA = (const char*)g.A + (size_t)cur.pm * tstep; const char* cB = (const char*)g.Bt + (size_t)cur.pn * tstep;
    PG8_STAGE(PG8_SB(0, 0), cB, voffB); PG8_STAGE(PG8_SA(0, 0), cA, voffA); PG8_STAGE(PG8_SB(0, 1), cB + hstep, voffB); PG8_STAGE(PG8_SA(0, 1), cA + hstep, voffA);
    if (wr == 1) PG8_BAR;
    PG8_WAIT_V(4); PG8_BAR;
    PG8_STAGE(PG8_SB(1, 0), cB + kstep, voffB); PG8_STAGE(PG8_SA(1, 0), cA + kstep, voffA); PG8_STAGE(PG8_SB(1, 1), cB + hstep + kstep, voffB);
    PG8_WAIT_V(6); PG8_BAR;
    for (;;) {
        const bool has_next = S.next(ui + 1, nxt);
        const char* nA = has_next ? (const char*)g.A + (size_t)nxt.pm * tstep : cA; const char* nB = has_next ? (const char*)g.Bt + (size_t)nxt.pn * tstep : cB;
        for (int t = 0; t < nt; t += 2) {
            const bool last = (t == nt - 2);
            const char* a1 = cA + (size_t)(t + 1) * kstep;
            const char* a2 = last ? nA : cA + (size_t)(t + 2) * kstep; const char* b2 = last ? nB : cB + (size_t)(t + 2) * kstep;
            const char* a3 = a2 + kstep; const char* b3 = b2 + kstep;
            PG8_LDB(B0, 0, 0); PG8_SCHED; PG8_LDA(At, 0, 0); PG8_STAGE(PG8_SA(1, 1), a1 + hstep, voffA);
            PG8_WAIT_L(8); PG8_BAR; PG8_WAIT_L(0); PG8_MMA(0, 0, At, B0); PG8_BAR; PG8_SCHED;
            PG8_LDB(B1, 0, 1); PG8_STAGE(PG8_SB(0, 0), b2, voffB);
            PG8_BAR; PG8_WAIT_L(0); PG8_MMA(0, 1, At, B1); PG8_BAR;
            PG8_LDA(At, 0, 1); PG8_STAGE(PG8_SA(0, 0), a2, voffA);
            PG8_BAR; PG8_WAIT_L(0); PG8_MMA(1, 0, At, B0); PG8_BAR; PG8_SCHED;
            PG8_STAGE(PG8_SB(0, 1), b2 + hstep, voffB);
            PG8_WAIT_V(6); PG8_BAR; PG8_MMA(1, 1, At, B1); PG8_BAR;
            PG8_LDB(B0, 1, 0); PG8_SCHED; PG8_LDA(At, 1, 0); PG8_STAGE(PG8_SA(0, 1), a2 + hstep, voffA);
            PG8_WAIT_L(8); PG8_BAR; PG8_WAIT_L(0); PG8_MMA(0, 0, At, B0); PG8_BAR; PG8_SCHED;
            PG8_LDB(B1, 1, 1); PG8_STAGE(PG8_SB(1, 0), b3, voffB);
            PG8_BAR; PG8_WAIT_L(0); PG8_MMA(0, 1, At, B1); PG8_BAR;
            PG8_LDA(At, 1, 1); PG8_STAGE(PG8_SA(1, 0), a3, voffA);
            PG8_BAR; PG8_WAIT_L(0); PG8_MMA(1, 0, At, B0); PG8_BAR; PG8_SCHED;
            PG8_STAGE(PG8_SB(1, 1), b3 + hstep, voffB);
            PG8_WAIT_V(6); PG8_BAR; PG8_MMA(1, 1, At, B1); PG8_BAR;
        }
        E(acc, cur, wr, wc, fr, fq);
        if (!has_next) break;
#pragma unroll
        for (int a = 0; a < 2; ++a)
#pragma unroll
            for (int b = 0; b < 2; ++b)
#pragma unroll
                for (int m = 0; m < 4; ++m)
#pragma unroll
                    for (int n = 0; n < 2; ++n) acc[a][b][m][n] = (f32x4){0.f, 0.f, 0.f, 0.f};
        cur = nxt; cA = nA; cB = nB; ++ui;
    }
    PG8_WAIT_V(0);
    if (wr == 0) PG8_BAR;
    PG8_BAR;
#undef PG8_SA
#undef PG8_SB
#undef PG8_STAGE
#undef PG8_LDA
#undef PG8_LDB
#undef PG8_MMA
#undef PG8_WAIT_V
#undef PG8_WAIT_L
#undef PG8_BAR
#undef PG8_SCHED
}
}

__device__ __forceinline__ int perm32i(int rho) { const int n = rho >> 4, i = rho & 15; return 8 * (i >> 2) + 4 * n + (i & 3); }
__device__ __forceinline__ int gperm(int c) { return (c & ~31) + perm32i(c & 31); }
__device__ __forceinline__ int rperm(int c) { const int w = (c >> 5) & 1, n = (c >> 4) & 1, i = c & 15; return (c & ~63) + 16 * w + i + 32 * n; }
__device__ __forceinline__ int src_col(int mode, int c) {
    switch (mode) {
        case 0: return c < 2048 ? rperm(c) : gperm(c);
        case 1: { if (c < 2048) return 3072 + gperm(c); if (c < 5120) return 5120 + gperm(c - 2048); const int t = gperm(c - 5120); return t < 32 ? 8192 + t : -1; }
        case 2: return 8224 + gperm(c);
        case 6: { const int pn = c >> 8, bj = (c >> 7) & 1, r = c & 127; return bj * 2816 + 128 * pn + gperm(r); }
        default: return gperm(c);
    }
}

__device__ __forceinline__ int batch_of(int r) { return r < MP ? (r >> 11) : 32 + ((r - MP) >> 6); }

template <int MODE> struct Epi {
    const Params& p;
    __device__ __forceinline__ void operator()(const f32x4 (&acc)[2][2][4][2], const pg8::Unit& u, int wr_, int wc_, int fr_, int fq_) const {
        int wr = wr_, wc = wc_, fr = fr_, fq = fq_;
        asm volatile("" : "+s"(wr), "+s"(wc), "+v"(fr), "+v"(fq));
        const int pn = u.pn;
#pragma unroll
        for (int ai = 0; ai < 2; ++ai)
#pragma unroll
            for (int m = 0; m < 4; ++m) {
                if ((m & 1) == 0) __builtin_amdgcn_sched_barrier(0);
                const int r = u.pm * 256 + ai * 128 + wr * 64 + m * 16 + fr;
                const bool samp = r >= MP; const int rs = r - MP;
                if constexpr (MODE == 0) {
                    const int type = pn >> 2, colbase = (pn & 3) * 256;
                    if (type < 2) {
                        const int pos = samp ? 1024 + (rs & 63) : (r & 2047);
#pragma unroll
                        for (int bj = 0; bj < 2; ++bj) {
                            const int dlo = 16 * (wc & 1) + 4 * fq;
                            const int col = colbase + 64 * (2 * bj + (wc >> 1)) + dlo;
                            const f32x4* cs = (const f32x4*)(p.rope() + pos * 32 + dlo);
                            const f32x4 cs0 = cs[0], cs1 = cs[1];
                            const f32x4 cv = {cs0[0], cs0[2], cs1[0], cs1[2]}, sv = {cs0[1], cs0[3], cs1[1], cs1[3]};
                            const f32x4 x1 = acc[ai][bj][m][0], x2 = acc[ai][bj][m][1];
                            f32x4 o1 = x1 * cv - x2 * sv, o2 = x2 * cv + x1 * sv;
                            if (type == 0) {
                                const float qs = 0.125f * LOG2E; o1 *= qs; o2 *= qs;
                                bf16_t* q = p.qbuf() + (size_t)r * 1024 + col;
                                *(u32x2*)q = pack4(o1); *(u32x2*)(q + 32) = pack4(o2);
                            } else {
                                float* ko = (samp ? p.nk_s() + (size_t)rs * 1024 : p.nk_p() + (size_t)r * 1024) + col;
                                *(f32x4*)ko = o1; *(f32x4*)(ko + 32) = o2;
                                bf16_t* kb = (samp ? p.kbuf_s() + ((size_t)(rs >> 6) * 1088 + 1024 + (rs & 63)) * 1024 : p.kbuf_p() + (size_t)r * 1024) + col;
                                *(u32x2*)kb = pack4(o1); *(u32x2*)(kb + 32) = pack4(o2);
                            }
                        }
                    } else {
#pragma unroll
                        for (int bj = 0; bj < 2; ++bj) {
                            const int col = colbase + 128 * bj + 32 * wc + 8 * fq;
                            float* vo = (samp ? p.nv_s() + (size_t)rs * 1024 : p.nv_p() + (size_t)r * 1024) + col;
                            *(f32x4*)vo = acc[ai][bj][m][0]; *(f32x4*)(vo + 4) = acc[ai][bj][m][1];
                            bf16_t* vb = (samp ? p.vbuf_s() + ((size_t)(rs >> 6) * 1088 + 1024 + (rs & 63)) * 1024 : p.vbuf_p() + (size_t)r * 1024) + col;
                            *(u32x4*)vb = pack8(acc[ai][bj][m][0], acc[ai][bj][m][1]);
                        }
                    }
                } else if constexpr (MODE == 1) {
                    if (pn < 8) {
#pragma unroll
                        for (int bj = 0; bj < 2; ++bj) { const int col = pn * 256 + 128 * bj + 32 * wc + 8 * fq; *(u32x4*)(p.zbuf() + (size_t)r * 2048 + col) = pack8(acc[ai][bj][m][0], acc[ai][bj][m][1]); }
                    } else if (pn < 20) {
                        const int tt = samp ? (rs & 63) - 61 : (r & 2047) - 2045;
#pragma unroll
                        for (int bj = 0; bj < 2; ++bj) {
                            const int col = (pn - 8) * 256 + 128 * bj + 32 * wc + 8 * fq;
                            *(u32x4*)(p.xbcbuf() + (size_t)r * 3072 + col) = pack8(acc[ai][bj][m][0], acc[ai][bj][m][1]);
                            if (tt >= 0) { float* co = (samp ? p.nconv_s() + ((size_t)(rs >> 6) * 3 + tt) * 3072 : p.nconv_p() + ((size_t)(r >> 11) * 3 + tt) * 3072) + col; *(f32x4*)co = acc[ai][bj][m][0]; *(f32x4*)(co + 4) = acc[ai][bj][m][1]; }
                        }
                    } else {
                        if (wc == 0) { float* d = p.dtbuf() + (size_t)r * 32 + 8 * fq; *(f32x4*)d = acc[ai][0][m][0]; *(f32x4*)(d + 4) = acc[ai][0][m][1]; }
                    }
                } else if constexpr (MODE == 2) {
#pragma unroll
                    for (int bj = 0; bj < 2; ++bj) {
                        const int col = pn * 256 + 128 * bj + 32 * wc + 8 * fq; f32x4 a = acc[ai][bj][m][0], b = acc[ai][bj][m][1];
#pragma unroll
                        for (int j = 0; j < 4; ++j) { a[j] = sigmoidf_(a[j]); b[j] = sigmoidf_(b[j]); }
                        *(u32x4*)(p.gbuf() + (size_t)r * 2048 + col) = pack8(a, b);
                    }
                } else if constexpr (MODE == 3 || MODE == 4) {
#pragma unroll
                    for (int bj = 0; bj < 2; ++bj) {
                        const int col = pn * 256 + 128 * bj + 32 * wc + 8 * fq;
                        const u32x4 g = *(const u32x4*)(p.gbuf() + (size_t)r * 2048 + (MODE == 4 ? 1024 : 0) + col);
                        f32x4 a = acc[ai][bj][m][0], b = acc[ai][bj][m][1];
                        a[0] *= bf_lo(g.x); a[1] *= bf_hi(g.x); a[2] *= bf_lo(g.y); a[3] *= bf_hi(g.y); b[0] *= bf_lo(g.z); b[1] *= bf_hi(g.z); b[2] *= bf_lo(g.w); b[3] *= bf_hi(g.w);
                        bf16_t* mp = p.mbuf() + (size_t)r * 1024 + col;
                        if constexpr (MODE == 4) { const u32x4 o = *(const u32x4*)mp; a[0] += bf_lo(o.x); a[1] += bf_hi(o.x); a[2] += bf_lo(o.y); a[3] += bf_hi(o.y); b[0] += bf_lo(o.z); b[1] += bf_hi(o.z); b[2] += bf_lo(o.w); b[3] += bf_hi(o.w); }
#ifdef DBG_ZERO_A
                        if constexpr (MODE == 3) { *(u32x4*)mp = (u32x4){0u, 0u, 0u, 0u}; } else
#endif
                        *(u32x4*)mp = pack8(a, b);
                    }
                } else if constexpr (MODE == 5 || MODE == 7) {
                    const int bidx = u.pm < 256 ? (u.pm >> 3) : 32 + (u.pm - 256) * 4 + 2 * ai + wr;
                    const float* mrow = p.mod() + (size_t)bidx * 6144 + (MODE == 5 ? 2048 : 5120);
#pragma unroll
                    for (int bj = 0; bj < 2; ++bj) {
                        const int col = pn * 256 + 128 * bj + 32 * wc + 8 * fq;
                        const float* xin = MODE == 5 ? ((samp ? p.x_s + (size_t)rs * 1024 : p.x_p + (size_t)r * 1024) + col) : (p.y() + (size_t)r * 1024 + col);
                        const f32x4 x0 = *(const f32x4*)xin, x1 = *(const f32x4*)(xin + 4), g0 = *(const f32x4*)(mrow + col), g1 = *(const f32x4*)(mrow + col + 4);
                        float* yo = p.y() + (size_t)r * 1024 + col;
                        #ifdef DBG_NOFFN
                        if constexpr (MODE == 7) { *(f32x4*)yo = x0; *(f32x4*)(yo + 4) = x1; } else
#endif
                        { *(f32x4*)yo = x0 + g0 * acc[ai][bj][m][0]; *(f32x4*)(yo + 4) = x1 + g1 * acc[ai][bj][m][1]; }
                    }
                } else if constexpr (MODE == 6) {
                    const int col = pn * 128 + 32 * wc + 8 * fq; f32x4 a = acc[ai][0][m][0], b = acc[ai][0][m][1];
#pragma unroll
                    for (int j = 0; j < 4; ++j) { a[j] = siluf_(a[j]) * acc[ai][1][m][0][j]; b[j] = siluf_(b[j]) * acc[ai][1][m][1][j]; }
                    *(u32x4*)(p.swbuf() + (size_t)r * 2816 + col) = pack8(a, b);
                }
            }
    }
};

template <int MODE> __device__ __forceinline__ void run_gemm(const Params& p, LAS unsigned char* lds, const bf16_t* A, const bf16_t* Bt, int N, int K) {
    pg8::Gemm g{A, Bt, MT, N, K}; pg8::StaticOrder S; S.init(MT, N, (int)gridDim.x, (int)blockIdx.x); Epi<MODE> E{p};
    pg8::gemm_phase<Epi<MODE>>(lds, g, S, E);
}

__device__ __forceinline__ float wave_sum(float v) {
#pragma unroll
    for (int o = 32; o >= 1; o >>= 1) v += __shfl_xor(v, o);
    return v;
}

__device__ void prep_phase(const Params& p, LAS unsigned char* lds) {
    const int tid = opaque_tid();
    {
        LAS float* tile = (LAS float*)lds;
        const int ntiles[8] = {48 * 16, 84 * 16, 32 * 16, 16 * 16, 16 * 32, 16 * 16, 88 * 16, 16 * 44};
        int total = 0;
#pragma unroll
        for (int j = 0; j < 8; ++j) total += ntiles[j];
        for (int T = blockIdx.x; T < total; T += gridDim.x) {
            int j = 0, lt = T;
#pragma unroll
            for (int q = 0; q < 7; ++q) if (j == q && lt >= ntiles[q]) { lt -= ntiles[q]; j = q + 1; }
            const float* W; int ldw, K; bf16_t* Bt;
            switch (j) {
                case 0: W = p.w_in; ldw = 10272; K = 1024; Bt = p.bt1a(); break;
                case 1: W = p.w_in; ldw = 10272; K = 1024; Bt = p.bt1b(); break;
                case 2: W = p.w_in; ldw = 10272; K = 1024; Bt = p.bt1c(); break;
                case 3: W = p.w_pa; ldw = 1024; K = 1024; Bt = p.btpa(); break;
                case 4: W = p.w_pb; ldw = 1024; K = 2048; Bt = p.btpb(); break;
                case 5: W = p.w_out; ldw = 1024; K = 1024; Bt = p.btout(); break;
                case 6: W = p.w_gu; ldw = 5632; K = 1024; Bt = p.btgu(); break;
                default: W = p.w_down; ldw = 1024; K = 2816; Bt = p.btdown(); break;
            }
            const int nkt = K >> 6, n0 = (lt / nkt) * 64, k0 = (lt % nkt) * 64;
            {
                const int col = tid & 63, kr = tid >> 6; const int sc = src_col(j, n0 + col);
#pragma unroll
                for (int jj = 0; jj < 8; ++jj) { const int k = kr + 8 * jj; float v = sc >= 0 ? W[(size_t)(k0 + k) * ldw + sc] : 0.f; if (j == 4) v *= p.g_ssd[k0 + k]; tile[k * 65 + col] = v; }
            }
            __syncthreads();
            {
                const int kk = (tid & 31) * 2, nr = tid >> 5;
#pragma unroll
                for (int jj = 0; jj < 4; ++jj) { const int n = nr + 16 * jj; *(unsigned*)(Bt + (size_t)(n0 + n) * K + k0 + kk) = cvt_pk_bf16(tile[kk * 65 + n], tile[(kk + 1) * 65 + n]); }
            }
            __syncthreads();
        }
    }
    {
        LAS float* sc = (LAS float*)lds;
        LAS float* wt = (LAS float*)(lds + 64 * 129 * 4);
        for (int cbk = blockIdx.x; cbk < 256; cbk += gridDim.x) {
            const int col0 = cbk * 24, row = tid & 63, cgp = tid >> 6;
            float a0 = 0.f, a1 = 0.f, a2 = 0.f;
            for (int kc = 0; kc < 8; ++kc) {
                const int k0 = kc * 128;
                __syncthreads();
#pragma unroll
                for (int i = 0; i < 16; ++i) { const int idx = tid + 512 * i, r = idx >> 7, k = idx & 127; const float v = r < 32 ? p.c_p[r * 1024 + k0 + k] : p.c_s[(r - 32) * 1024 + k0 + k]; sc[r * 129 + k] = siluf_(v); }
#pragma unroll
                for (int i = 0; i < 6; ++i) { const int idx = tid + 512 * i, k = idx / 24, c = idx % 24; wt[idx] = p.w_ada[(size_t)(k0 + k) * 6144 + col0 + c]; }
                __syncthreads();
#pragma unroll 8
                for (int k = 0; k < 128; ++k) { const float a = sc[row * 129 + k]; a0 += a * wt[k * 24 + 3 * cgp]; a1 += a * wt[k * 24 + 3 * cgp + 1]; a2 += a * wt[k * 24 + 3 * cgp + 2]; }
            }
            const int c = col0 + 3 * cgp;
            p.mod()[row * 6144 + c] = a0 + p.b_ada[c]; p.mod()[row * 6144 + c + 1] = a1 + p.b_ada[c + 1]; p.mod()[row * 6144 + c + 2] = a2 + p.b_ada[c + 2];
        }
        __syncthreads();
    }
    const size_t gtid = (size_t)blockIdx.x * 512 + tid, gsz = (size_t)gridDim.x * 512;
    for (size_t i = gtid; i < 2048 * 32; i += gsz) {
        const int pos = (int)(i >> 5), d = (int)(i & 31);
        const float inv = powf(10000.0f, -(float)d / 32.0f); const float ang = (float)pos * inv;
        float s, c; sincosf(ang, &s, &c); p.rope()[i] = make_float2(c, s);
    }
    for (size_t i = gtid; i < (size_t)2 * 32 * 1024 * 128; i += gsz) {
        const int which = (int)(i >> 22); const size_t e = i & ((1u << 22) - 1); const int b = (int)(e >> 17), rem = (int)(e & 131071), row = rem >> 7, ch = rem & 127;
        const float* src = (which ? p.cache_v : p.cache_k) + ((size_t)(b * 1024 + row) * 1024 + ch * 8);
        bf16_t* dst = (which ? p.vbuf_s() : p.kbuf_s()) + ((size_t)(b * 1088 + row) * 1024 + ch * 8);
        const f32x4 a = *(const f32x4*)src, bq = *(const f32x4*)(src + 4);
        *(u32x4*)dst = pack8(a, bq);
    }
}

template <int MODE> __device__ void norm_phase(const Params& p) {
    const int tid = opaque_tid(); const int w = tid >> 6, lane = tid & 63;
    const float* g = MODE == 0 ? p.g_mix : (MODE == 1 ? p.g_ffn : p.g_final);
    for (int r = blockIdx.x * 8 + w; r < MT; r += gridDim.x * 8) {
        const float* src = MODE == 0 ? (r < MP ? p.x_p + (size_t)r * 1024 : p.x_s + (size_t)(r - MP) * 1024) : p.y() + (size_t)r * 1024;
        f32x4 v[4]; float ss = 0.f;
#pragma unroll
        for (int j = 0; j < 4; ++j) { v[j] = *(const f32x4*)(src + 256 * j + 4 * lane); ss += v[j][0] * v[j][0] + v[j][1] * v[j][1] + v[j][2] * v[j][2] + v[j][3] * v[j][3]; }
        ss = wave_sum(ss);
        const float rsn = rsqrtf(ss * (1.0f / 1024.0f) + EPSN);
        const float* mrow = p.mod() + (size_t)batch_of(r) * 6144 + (MODE == 0 ? 0 : 3072);
#pragma unroll
        for (int j = 0; j < 4; ++j) {
            const int c = 256 * j + 4 * lane; const f32x4 gg = *(const f32x4*)(g + c); f32x4 o = v[j] * rsn * gg;
            if constexpr (MODE == 2) { *(f32x4*)(p.y() + (size_t)r * 1024 + c) = o; }
            else { const f32x4 sh = *(const f32x4*)(mrow + c), scl = *(const f32x4*)(mrow + 1024 + c); o = o * (1.0f + scl) + sh; *(u32x2*)((MODE == 0 ? p.hA() : p.h2()) + (size_t)r * 1024 + c) = pack4(o); }
        }
    }
}

__device__ void ssdnorm_phase(const Params& p) {
    const size_t gtid = (size_t)blockIdx.x * 512 + opaque_tid(), gsz = (size_t)gridDim.x * 512;
    for (size_t i = gtid; i < (size_t)MT * 256; i += gsz) {
        const size_t r = i >> 8; const int e8 = (int)(i & 255), gq = e8 >> 6;
        const float ss = p.ssbuf()[r * 8 + 2 * gq] + p.ssbuf()[r * 8 + 2 * gq + 1];
        const float rsn = rsqrtf(ss * (1.0f / 512.0f) + EPSN);
        bf16_t* ptr = p.zbuf() + r * 2048 + e8 * 8; const u32x4 u = *(const u32x4*)ptr;
        u32x4 o; o.x = cvt_pk_bf16(bf_lo(u.x) * rsn, bf_hi(u.x) * rsn); o.y = cvt_pk_bf16(bf_lo(u.y) * rsn, bf_hi(u.y) * rsn); o.z = cvt_pk_bf16(bf_lo(u.z) * rsn, bf_hi(u.z) * rsn); o.w = cvt_pk_bf16(bf_lo(u.w) * rsn, bf_hi(u.w) * rsn);
        *(u32x4*)ptr = o;
    }
}

constexpr int AT_K = 9216, AT_V = 20480, AT_STAGE = 2 * AT_K + AT_V;
__device__ __forceinline__ void attn_item(const Params& p, LAS unsigned char* lds, int row0, int h, const bf16_t* Kb, const bf16_t* Vb, int nt0, int nt1, float lam) {
    const int tid = opaque_tid(), w = __builtin_amdgcn_readfirstlane(tid >> 6), lane = tid & 63, l31 = lane & 31, hh = lane >> 5;
    const int hd = w >> 2, rb = w & 3, chunk = rb >> 1;
    const int ntl = nt0 > nt1 ? nt0 : nt1, my_nt = chunk ? nt1 : nt0;
    const int coff = 128 * h;
    bf16x8 qf[4];
    {
        const bf16_t* qp = p.qbuf() + (size_t)(row0 + rb * 32 + l31) * 1024 + coff + 64 * hd + 8 * hh;
#pragma unroll
        for (int s = 0; s < 4; ++s) qf[s] = my_nt > 0 ? *(const bf16x8*)(qp + 16 * s) : (bf16x8){0, 0, 0, 0, 0, 0, 0, 0};
    }
    f32x16 O[4];
#pragma unroll
    for (int c = 0; c < 4; ++c)
#pragma unroll
        for (int e = 0; e < 16; ++e) O[c][e] = 0.f;
    float m_run = -1e30f, l_run = 0.f;
    u32x4 kreg[2], vreg[2];
    const int kwhich[2] = {tid >> 9, (tid + 512) >> 9};
    auto gload = [&](int t) {
        const int key0 = 64 * t;
#pragma unroll
        for (int jj = 0; jj < 2; ++jj) {
            const int idx = tid + 512 * jj;
            { const int which = idx >> 9, row = (idx >> 3) & 63, ch = idx & 7; kreg[jj] = *(const u32x4*)(Kb + (size_t)(key0 + row) * 1024 + coff + 64 * which + 8 * ch); }
            { const int row = idx >> 4, ch = idx & 15; vreg[jj] = *(const u32x4*)(Vb + (size_t)(key0 + row) * 1024 + coff + 8 * ch); }
        }
    };
    auto swrite = [&](int st) {
        LAS unsigned char* base = lds + st * AT_STAGE;
#pragma unroll
        for (int jj = 0; jj < 2; ++jj) {
            const int idx = tid + 512 * jj;
            { const int which = idx >> 9, row = (idx >> 3) & 63, ch = idx & 7; *(LAS u32x4*)(base + which * AT_K + row * 144 + ch * 16) = kreg[jj]; }
            { const int row = idx >> 4, ch = idx & 15; *(LAS u32x4*)(base + 2 * AT_K + row * 320 + ch * 16) = vreg[jj]; }
        }
    };
    (void)kwhich;
    gload(0); swrite(0); __syncthreads();
    const int q4 = (lane & 15) >> 2, blk = (lane >> 4) & 1, pp = lane & 3;
    for (int t = 0; t < ntl; ++t) {
        if (t + 1 < ntl) gload(t + 1);
        if (t < my_nt) {
            LAS unsigned char* Kt = lds + (t & 1) * AT_STAGE + hd * AT_K + l31 * 144 + hh * 16;
            LAS unsigned char* Vt = lds + (t & 1) * AT_STAGE + 2 * AT_K + (4 * hh + q4) * 320 + (16 * blk + 4 * pp) * 2;
            f32x16 S[2];
#pragma unroll
            for (int kb = 0; kb < 2; ++kb) {
#pragma unroll
                for (int e = 0; e < 16; ++e) S[kb][e] = 0.f;
#pragma unroll
                for (int s = 0; s < 4; ++s) { const bf16x8 a = *(const LAS bf16x8*)(Kt + kb * 32 * 144 + s * 32); S[kb] = __builtin_amdgcn_mfma_f32_32x32x16_bf16(a, qf[s], S[kb], 0, 0, 0); }
            }
            float mx = S[0][0];
#pragma unroll
            for (int e = 1; e < 16; ++e) mx = fmaxf(mx, S[0][e]);
#pragma unroll
            for (int e = 0; e < 16; ++e) mx = fmaxf(mx, S[1][e]);
            mx = fmaxf(mx, __shfl_xor(mx, 32));
            const float mn = fmaxf(m_run, mx), alpha = fexp2(m_run - mn); m_run = mn;
            float rsum = 0.f;
#pragma unroll
            for (int kb = 0; kb < 2; ++kb)
#pragma unroll
                for (int e = 0; e < 16; ++e) { const float pv = fexp2(S[kb][e] - mn); S[kb][e] = pv; rsum += pv; }
            l_run = l_run * alpha + rsum;
#pragma unroll
            for (int c = 0; c < 4; ++c)
#pragma unroll
                for (int e = 0; e < 16; ++e) O[c][e] *= alpha;
#pragma unroll
            for (int kb = 0; kb < 2; ++kb)
#pragma unroll
                for (int sp = 0; sp < 2; ++sp) {
                    union { u32x4 u; bf16x8 v; } pb;
                    pb.u.x = cvt_pk_bf16(S[kb][8 * sp + 0], S[kb][8 * sp + 1]); pb.u.y = cvt_pk_bf16(S[kb][8 * sp + 2], S[kb][8 * sp + 3]);
                    pb.u.z = cvt_pk_bf16(S[kb][8 * sp + 4], S[kb][8 * sp + 5]); pb.u.w = cvt_pk_bf16(S[kb][8 * sp + 6], S[kb][8 * sp + 7]);
#pragma unroll
                    for (int c = 0; c < 4; ++c) {
                        LAS unsigned char* va = Vt + (32 * kb + 16 * sp) * 320 + 64 * c;
                        const s16x4 v0 = __builtin_amdgcn_ds_read_tr16_b64_v4i16((LAS s16x4*)va);
                        const s16x4 v1 = __builtin_amdgcn_ds_read_tr16_b64_v4i16((LAS s16x4*)(va + 8 * 320));
                        const bf16x8 vf = {v0[0], v0[1], v0[2], v0[3], v1[0], v1[1], v1[2], v1[3]};
                        O[c] = __builtin_amdgcn_mfma_f32_32x32x16_bf16(vf, pb.v, O[c], 0, 0, 0);
                    }
                }
        }
        if (t + 1 < ntl) swrite((t + 1) & 1);
        __syncthreads();
    }
    const float lt = l_run + __shfl_xor(l_run, 32);
    const float inv = my_nt > 0 ? 1.0f / lt : 0.f;
    LAS float* X = (LAS float*)lds;
    if (hd == 1) {
#pragma unroll
        for (int c = 0; c < 4; ++c)
#pragma unroll
            for (int i = 0; i < 4; ++i) { f32x4 o = {O[c][4 * i] * inv, O[c][4 * i + 1] * inv, O[c][4 * i + 2] * inv, O[c][4 * i + 3] * inv}; *(LAS f32x4*)(X + (rb * 32 + l31) * 132 + 32 * c + 8 * i + 4 * hh) = o; }
    }
    __syncthreads();
    if (hd == 0 && my_nt > 0) {
        float ss = 0.f;
#pragma unroll
        for (int c = 0; c < 4; ++c)
#pragma unroll
            for (int i = 0; i < 4; ++i) {
                const f32x4 o2 = *(const LAS f32x4*)(X + (rb * 32 + l31) * 132 + 32 * c + 8 * i + 4 * hh);
#pragma unroll
                for (int j = 0; j < 4; ++j) { const float o = O[c][4 * i + j] * inv - lam * o2[j]; O[c][4 * i + j] = o; ss += o * o; }
            }
        ss += __shfl_xor(ss, 32);
        const float rsn = rsqrtf(ss * (1.0f / 128.0f) + EPSN) * 0.8f;
        bf16_t* op = p.qbuf() + (size_t)(row0 + rb * 32 + l31) * 1024 + coff + 4 * hh;
#pragma unroll
        for (int c = 0; c < 4; ++c)
#pragma unroll
            for (int i = 0; i < 4; ++i) {
                const f32x4 g = *(const f32x4*)(p.g_subln + 32 * c + 8 * i + 4 * hh);
                const f32x4 o = {O[c][4 * i] * rsn * g[0], O[c][4 * i + 1] * rsn * g[1], O[c][4 * i + 2] * rsn * g[2], O[c][4 * i + 3] * rsn * g[3]};
                *(u32x2*)(op + 32 * c + 8 * i) = pack4(o);
            }
    }
    __syncthreads();
}

__device__ void attn_phase(const Params& p, LAS unsigned char* lds) {
    const int lane = opaque_tid() & 63;
    const float a1 = wave_sum(p.lq1[lane] * p.lk1[lane]), a2 = wave_sum(p.lq2[lane] * p.lk2[lane]);
    const float lam = __expf(a1) - __expf(a2) + 0.2f;
    for (int j = blockIdx.x; j < 256; j += gridDim.x) {
        const int b = j >> 3, h = j & 7;
        for (int it = 0; it < 17; ++it) {
            if (it < 16) { const int i = 15 - it; attn_item(p, lds, b * 2048 + 128 * i, h, p.kbuf_p() + (size_t)b * 2048 * 1024, p.vbuf_p() + (size_t)b * 2048 * 1024, 2 * i + 1, 2 * i + 2, lam); }
            else attn_item(p, lds, MP + 64 * b, h, p.kbuf_s() + (size_t)b * 1088 * 1024, p.vbuf_s() + (size_t)b * 1088 * 1024, 17, 0, lam);
        }
    }
}

constexpr int SD_XT = 0, SD_BM = 36864, SD_BT = SD_BM + 17408, SD_CM = SD_BT + 18432, SD_CB = SD_CM + 17408, SD_CUM = SD_CB + 17408, SD_DT = SD_CUM + 1024, SD_SS = SD_DT + 1024;
__device__ void ssd_phase(const Params& p, LAS unsigned char* lds) {
    const int tid = opaque_tid(), w = __builtin_amdgcn_readfirstlane(tid >> 6), lane = tid & 63, l15 = lane & 15, g4 = lane >> 4;
    const int k = w >> 1, ph = w & 1;
    for (int jb = blockIdx.x; jb < 256; jb += gridDim.x) {
        const int b = jb >> 3, hq = jb & 7, grp = hq >> 1, head = 4 * hq + k;
        f32x4 Sacc[8][2];
#pragma unroll
        for (int nb = 0; nb < 8; ++nb)
#pragma unroll
            for (int pb = 0; pb < 2; ++pb) Sacc[nb][pb] = (f32x4){0.f, 0.f, 0.f, 0.f};
        const float a_h = -__expf(p.a_log[head]), dtb = p.dt_bias[head], dsk = p.d_skip[head];
        for (int step = 0; step < 33; ++step) {
            const bool samp = step == 32;
            const int row0 = samp ? MP + 64 * b : b * 2048 + 64 * step;
            if (samp) {
                float* so = p.nssm_p() + ((size_t)(b * 32 + head) * 64) * 128; const float* si = p.state_ssm + ((size_t)(b * 32 + head) * 64) * 128;
#pragma unroll
                for (int nb = 0; nb < 8; ++nb)
#pragma unroll
                    for (int pb = 0; pb < 2; ++pb) { const size_t o = (size_t)(32 * ph + 16 * pb + l15) * 128 + 16 * nb + 4 * g4; *(f32x4*)(so + o) = Sacc[nb][pb]; Sacc[nb][pb] = *(const f32x4*)(si + o); }
            }
#pragma unroll 1
            for (int half = 0; half < 2; ++half) {
                int idv = tid + 512 * half; asm volatile("" : "+v"(idv));
                const int tb = idv & 7, cb4 = idv >> 3;
                const int ccol = cb4 < 64 ? 256 * hq + 4 * cb4 : (cb4 < 96 ? 2048 + 128 * grp + 4 * (cb4 - 64) : 2560 + 128 * grp + 4 * (cb4 - 96));
                f32x4 wv[4];
#pragma unroll
                for (int j = 0; j < 4; ++j) wv[j] = *(const f32x4*)(p.conv_w + j * 3072 + ccol);
                const f32x4 bias = *(const f32x4*)(p.conv_b + ccol);
                f32x4 outv[8];
#pragma unroll
                for (int tt = 0; tt < 8; ++tt) outv[tt] = bias;
#pragma unroll
                for (int rr = 0; rr < 11; ++rr) {
                    const int ts = 8 * tb + rr - 3 + (samp ? 0 : 64 * step);
                    f32x4 xv;
                    if (ts >= 0) {
                        const u32x2 u = *(const u32x2*)(p.xbcbuf() + (size_t)(row0 + 8 * tb + rr - 3) * 3072 + ccol);
                        xv[0] = bf_lo(u.x); xv[1] = bf_hi(u.x); xv[2] = bf_lo(u.y); xv[3] = bf_hi(u.y);
                    } else if (samp) {
                        xv = *(const f32x4*)(p.state_conv + ((size_t)b * 3 + (ts + 3)) * 3072 + ccol);
                    } else {
                        xv = (f32x4){0.f, 0.f, 0.f, 0.f};
                    }
#pragma unroll
                    for (int j = 0; j < 4; ++j) { const int tt = rr - j; if (tt >= 0 && tt < 8) outv[tt] += wv[j] * xv; }
                }
#pragma unroll
                for (int tt = 0; tt < 8; ++tt)
#pragma unroll
                    for (int e = 0; e < 4; ++e) outv[tt][e] = siluf_(outv[tt][e]);
                if (cb4 < 64) {
                    LAS unsigned char* base = lds + SD_XT + (cb4 >> 4) * 9216 + (4 * (cb4 & 15)) * 144 + 16 * tb;
#pragma unroll
                    for (int e = 0; e < 4; ++e) { u32x4 u; u.x = cvt_pk_bf16(outv[0][e], outv[1][e]); u.y = cvt_pk_bf16(outv[2][e], outv[3][e]); u.z = cvt_pk_bf16(outv[4][e], outv[5][e]); u.w = cvt_pk_bf16(outv[6][e], outv[7][e]); *(LAS u32x4*)(base + e * 144) = u; }
                } else if (cb4 < 96) {
                    const int n0 = 4 * (cb4 - 64);
#pragma unroll
                    for (int tt = 0; tt < 8; ++tt) *(LAS u32x2*)(lds + SD_BM + (8 * tb + tt) * 272 + n0 * 2) = pack4(outv[tt]);
#pragma unroll
                    for (int e = 0; e < 4; ++e) { u32x4 u; u.x = cvt_pk_bf16(outv[0][e], outv[1][e]); u.y = cvt_pk_bf16(outv[2][e], outv[3][e]); u.z = cvt_pk_bf16(outv[4][e], outv[5][e]); u.w = cvt_pk_bf16(outv[6][e], outv[7][e]); *(LAS u32x4*)(lds + SD_BT + (n0 + e) * 144 + 16 * tb) = u; }
                } else {
                    const int n0 = 4 * (cb4 - 96);
#pragma unroll
                    for (int tt = 0; tt < 8; ++tt) *(LAS u32x2*)(lds + SD_CM + (8 * tb + tt) * 272 + n0 * 2) = pack4(outv[tt]);
                }
            }
            if (w < 4) {
                const int hd2 = 4 * hq + w;
                const float xr = p.dtbuf()[(size_t)(row0 + lane) * 32 + hd2] + p.dt_bias[hd2];
                const float dt = xr > 20.f ? xr : log1pf(__expf(xr));
                float cum = dt * (-__expf(p.a_log[hd2]));
#pragma unroll
                for (int o = 1; o < 64; o <<= 1) { const float t2 = __shfl_up(cum, o); if (lane >= o) cum += t2; }
                ((LAS float*)(lds + SD_CUM))[w * 64 + lane] = cum; ((LAS float*)(lds + SD_DT))[w * 64 + lane] = dt;
            }
            __syncthreads();
            {
                const int lb = w >> 1;
#pragma unroll
                for (int q = 0; q < 2; ++q) {
                    const int sb = 2 * (w & 1) + q; f32x4 c4 = {0.f, 0.f, 0.f, 0.f};
#pragma unroll
                    for (int ks = 0; ks < 4; ++ks) {
                        const bf16x8 a = *(const LAS bf16x8*)(lds + SD_CM + (16 * lb + l15) * 272 + (32 * ks + 8 * g4) * 2);
                        const bf16x8 bb = *(const LAS bf16x8*)(lds + SD_BM + (16 * sb + l15) * 272 + (32 * ks + 8 * g4) * 2);
                        c4 = __builtin_amdgcn_mfma_f32_16x16x32_bf16(a, bb, c4, 0, 0, 0);
                    }
#pragma unroll
                    for (int j = 0; j < 4; ++j) ((LAS float*)(lds + SD_CB))[(16 * lb + 4 * g4 + j) * 68 + 16 * sb + l15] = c4[j];
                }
            }
            __syncthreads();
            {
                const LAS float* cumL = (const LAS float*)(lds + SD_CUM) + k * 64; const LAS float* dtL = (const LAS float*)(lds + SD_DT) + k * 64;
                const LAS unsigned char* XTk = lds + SD_XT + k * 9216;
                f32x4 yT[2][4];
#pragma unroll
                for (int pb = 0; pb < 2; ++pb)
#pragma unroll
                    for (int lb = 0; lb < 4; ++lb) yT[pb][lb] = (f32x4){0.f, 0.f, 0.f, 0.f};
#pragma unroll
                for (int ks = 0; ks < 4; ++ks) {
                    __builtin_amdgcn_sched_barrier(0);
                    union { u32x4 u; bf16x8 v; } af[2];
#pragma unroll
                    for (int pb = 0; pb < 2; ++pb) { af[pb].u.x = cvt_pk_bf16(Sacc[2 * ks][pb][0], Sacc[2 * ks][pb][1]); af[pb].u.y = cvt_pk_bf16(Sacc[2 * ks][pb][2], Sacc[2 * ks][pb][3]); af[pb].u.z = cvt_pk_bf16(Sacc[2 * ks + 1][pb][0], Sacc[2 * ks + 1][pb][1]); af[pb].u.w = cvt_pk_bf16(Sacc[2 * ks + 1][pb][2], Sacc[2 * ks + 1][pb][3]); }
#pragma unroll
                    for (int lb = 0; lb < 4; ++lb) {
                        const LAS unsigned char* cp = lds + SD_CM + (16 * lb + l15) * 272 + (32 * ks + 4 * g4) * 2;
                        union { u32x4 u; bf16x8 v; } bf; const u32x2 c0 = *(const LAS u32x2*)cp, c1 = *(const LAS u32x2*)(cp + 32);
                        bf.u.x = c0.x; bf.u.y = c0.y; bf.u.z = c1.x; bf.u.w = c1.y;
#pragma unroll
                        for (int pb = 0; pb < 2; ++pb) yT[pb][lb] = __builtin_amdgcn_mfma_f32_16x16x32_bf16(af[pb].v, bf.v, yT[pb][lb], 0, 0, 0);
                    }
                }
#pragma unroll
                for (int lb = 0; lb < 4; ++lb) { const float ec = fexp(cumL[16 * lb + l15]);
#pragma unroll
                    for (int pb = 0; pb < 2; ++pb) yT[pb][lb] *= ec; }
#pragma unroll
                for (int ks = 0; ks < 2; ++ks) {
                    __builtin_amdgcn_sched_barrier(0);
                    bf16x8 xa[2];
#pragma unroll
                    for (int pb = 0; pb < 2; ++pb) xa[pb] = *(const LAS bf16x8*)(XTk + (32 * ph + 16 * pb + l15) * 144 + (32 * ks + 8 * g4) * 2);
                    const int s0 = 32 * ks + 8 * g4;
                    const f32x4 cs0 = *(const LAS f32x4*)(cumL + s0), cs1 = *(const LAS f32x4*)(cumL + s0 + 4), ds0 = *(const LAS f32x4*)(dtL + s0), ds1 = *(const LAS f32x4*)(dtL + s0 + 4);
#pragma unroll
                    for (int lb = 0; lb < 4; ++lb) {
                        if (32 * ks > 16 * lb + 15) continue;
                        __builtin_amdgcn_sched_barrier(0);
                        const int l = 16 * lb + l15; const float cl = cumL[l];
                        const LAS float* cbp = (const LAS float*)(lds + SD_CB) + l * 68 + s0;
                        const f32x4 cb0 = *(const LAS f32x4*)cbp, cb1 = *(const LAS f32x4*)(cbp + 4);
                        float mv[8];
#pragma unroll
                        for (int e = 0; e < 4; ++e) {
                            { const int s = s0 + e; float v = s <= l ? cb0[e] * fexp(cl - cs0[e]) * ds0[e] : 0.f; if (s == l) v += dsk; mv[e] = v; }
                            { const int s = s0 + 4 + e; float v = s <= l ? cb1[e] * fexp(cl - cs1[e]) * ds1[e] : 0.f; if (s == l) v += dsk; mv[4 + e] = v; }
                        }
                        union { u32x4 u; bf16x8 v; } mf; mf.u.x = cvt_pk_bf16(mv[0], mv[1]); mf.u.y = cvt_pk_bf16(mv[2], mv[3]); mf.u.z = cvt_pk_bf16(mv[4], mv[5]); mf.u.w = cvt_pk_bf16(mv[6], mv[7]);
#pragma unroll
                        for (int pb = 0; pb < 2; ++pb) yT[pb][lb] = __builtin_amdgcn_mfma_f32_16x16x32_bf16(xa[pb], mf.v, yT[pb][lb], 0, 0, 0);
                    }
                }
                float ssl[4];
#pragma unroll
                for (int lb = 0; lb < 4; ++lb) {
                    __builtin_amdgcn_sched_barrier(0);
                    float ss = 0.f;
#pragma unroll
                    for (int pb = 0; pb < 2; ++pb) {
                        bf16_t* zp = p.zbuf() + (size_t)(row0 + 16 * lb + l15) * 2048 + 64 * head + 32 * ph + 16 * pb + 4 * g4;
                        const u32x2 zz = *(const u32x2*)zp;
                        f32x4 u = yT[pb][lb]; u[0] *= siluf_(bf_lo(zz.x)); u[1] *= siluf_(bf_hi(zz.x)); u[2] *= siluf_(bf_lo(zz.y)); u[3] *= siluf_(bf_hi(zz.y));
                        ss += u[0] * u[0] + u[1] * u[1] + u[2] * u[2] + u[3] * u[3];
                        *(u32x2*)zp = pack4(u);
                    }
                    ss += __shfl_xor(ss, 16); ss += __shfl_xor(ss, 32); ssl[lb] = ss;
                }
                if (g4 == 0) {
#pragma unroll
                    for (int lb = 0; lb < 4; ++lb) ((LAS float*)(lds + SD_SS))[w * 64 + 16 * lb + l15] = ssl[lb];
                }
                const float cend = cumL[63], dec = fexp(cend);
#pragma unroll
                for (int nb = 0; nb < 8; ++nb)
#pragma unroll
                    for (int pb = 0; pb < 2; ++pb) Sacc[nb][pb] *= dec;
#pragma unroll
                for (int ks = 0; ks < 2; ++ks) {
                    __builtin_amdgcn_sched_barrier(0);
                    const int s0 = 32 * ks + 8 * g4;
                    const f32x4 cs0 = *(const LAS f32x4*)(cumL + s0), cs1 = *(const LAS f32x4*)(cumL + s0 + 4), ds0 = *(const LAS f32x4*)(dtL + s0), ds1 = *(const LAS f32x4*)(dtL + s0 + 4);
                    float wsv[8];
#pragma unroll
                    for (int e = 0; e < 4; ++e) { wsv[e] = ds0[e] * fexp(cend - cs0[e]); wsv[4 + e] = ds1[e] * fexp(cend - cs1[e]); }
                    union { u32x4 u; bf16x8 v; } xb[2];
#pragma unroll
                    for (int pb = 0; pb < 2; ++pb) {
                        const u32x4 xr = *(const LAS u32x4*)(XTk + (32 * ph + 16 * pb + l15) * 144 + s0 * 2);
                        xb[pb].u.x = cvt_pk_bf16(bf_lo(xr.x) * wsv[0], bf_hi(xr.x) * wsv[1]); xb[pb].u.y = cvt_pk_bf16(bf_lo(xr.y) * wsv[2], bf_hi(xr.y) * wsv[3]);
                        xb[pb].u.z = cvt_pk_bf16(bf_lo(xr.z) * wsv[4], bf_hi(xr.z) * wsv[5]); xb[pb].u.w = cvt_pk_bf16(bf_lo(xr.w) * wsv[6], bf_hi(xr.w) * wsv[7]);
                    }
#pragma unroll
                    for (int nb = 0; nb < 8; ++nb) {
                        const bf16x8 ba = *(const LAS bf16x8*)(lds + SD_BT + (16 * nb + l15) * 144 + s0 * 2);
#pragma unroll
                        for (int pb = 0; pb < 2; ++pb) Sacc[nb][pb] = __builtin_amdgcn_mfma_f32_16x16x32_bf16(ba, xb[pb].v, Sacc[nb][pb], 0, 0, 0);
                    }
                }
            }
            __syncthreads();
            if (tid < 64) {
                float s = 0.f;
#pragma unroll
                for (int ww = 0; ww < 8; ++ww) s += ((const LAS float*)(lds + SD_SS))[ww * 64 + tid];
                p.ssbuf()[(size_t)(row0 + tid) * 8 + hq] = s;
            }
        }
        {
            float* so = p.nssm_s() + ((size_t)(b * 32 + head) * 64) * 128;
#pragma unroll
            for (int nb = 0; nb < 8; ++nb)
#pragma unroll
                for (int pb = 0; pb < 2; ++pb) *(f32x4*)(so + (size_t)(32 * ph + 16 * pb + l15) * 128 + 16 * nb + 4 * g4) = Sacc[nb][pb];
        }
        (void)a_h; (void)dtb;
    }
}

__global__ void __launch_bounds__(512, 2) fwd_megakernel(Params p) {
    extern __shared__ __attribute__((aligned(16))) unsigned char shm[];
    LAS unsigned char* lds = (LAS unsigned char*)shm;
    cg::grid_group grid = cg::this_grid();
#ifndef PHMASK
#define PHMASK 0x1fff
#endif
#define PHASE(n, ...) if (p.ph_lo <= (n) && (n) < p.ph_hi) { if constexpr ((PHMASK >> (n)) & 1) { __VA_ARGS__ } if ((n) + 1 < p.ph_hi) { \
        __builtin_amdgcn_fence(__ATOMIC_RELEASE, "agent"); asm volatile("s_waitcnt vmcnt(0) lgkmcnt(0)" ::: "memory"); grid.sync(); \
        __builtin_amdgcn_fence(__ATOMIC_ACQUIRE, "agent"); asm volatile("s_waitcnt vmcnt(0) lgkmcnt(0)" ::: "memory"); } }
    PHASE(0, prep_phase(p, lds);)
    PHASE(1, norm_phase<0>(p);)
    PHASE(2, run_gemm<0>(p, lds, p.hA(), p.bt1a(), 3072, 1024);)
    PHASE(3, attn_phase(p, lds);)
    PHASE(4, run_gemm<1>(p, lds, p.hA(), p.bt1b(), 5376, 1024);)
    PHASE(5, ssd_phase(p, lds);)
    PHASE(6, run_gemm<2>(p, lds, p.hA(), p.bt1c(), 2048, 1024); ssdnorm_phase(p);)
    PHASE(7, run_gemm<3>(p, lds, p.qbuf(), p.btpa(), 1024, 1024); run_gemm<4>(p, lds, p.zbuf(), p.btpb(), 1024, 2048);)
    PHASE(8, run_gemm<5>(p, lds, p.mbuf(), p.btout(), 1024, 1024);)
    PHASE(9, norm_phase<1>(p);)
    PHASE(10, run_gemm<6>(p, lds, p.h2(), p.btgu(), 5632, 1024);)
    PHASE(11, run_gemm<7>(p, lds, p.swbuf(), p.btdown(), 1024, 2816);)
    PHASE(12, norm_phase<2>(p);)
#undef PHASE
}


#ifdef DBG_CHK
struct AChk { int b, h, t, samp; };
__device__ __forceinline__ AChk get_achk(int c) { AChk k; if (c < 64) { k.b = (c * 7) % 32; k.h = c % 8; k.t = (c * 331 + 17) % 2048; k.samp = 0; } else if (c < 80) { const int e[8] = {0, 63, 64, 127, 128, 191, 1984, 2047}; k.b = (c * 3) % 32; k.h = (c * 5) % 8; k.t = e[c & 7]; k.samp = 0; } else { k.b = (c * 5) % 32; k.h = c % 8; k.t = (c * 13) % 64; k.samp = 1; } return k; }
struct SChk { int b, head, samp; };
__device__ __forceinline__ SChk get_schk(int c) { SChk k; if (c < 16) { k.b = (c * 5 + 1) % 32; k.head = (c * 11 + 3) % 32; k.samp = 0; } else { k.b = (c * 7) % 32; k.head = (c * 13 + 5) % 32; k.samp = 1; } return k; }
__device__ __forceinline__ float bf2f(bf16_t v) { return __uint_as_float(((unsigned)v) << 16); }
__global__ void dbg_saveq(Params p, float* dbg) {
    const int c = blockIdx.x; const AChk k = get_achk(c); const int row = k.samp ? MP + 64 * k.b + k.t : k.b * 2048 + k.t;
    if (threadIdx.x < 128) dbg[1024 + c * 128 + threadIdx.x] = bf2f(p.qbuf()[(size_t)row * 1024 + 128 * k.h + threadIdx.x]);
}
__global__ void dbg_chka(Params p, float* dbg) {
    __shared__ float s1[2048], s2[2048], red[256];
    const int c = blockIdx.x, tid = threadIdx.x; const AChk k = get_achk(c);
    const int row = k.samp ? MP + 64 * k.b + k.t : k.b * 2048 + k.t; const int nkeys = k.samp ? 1088 : (k.t / 64 + 1) * 64;
    const bf16_t* Kb = k.samp ? p.kbuf_s() + (size_t)k.b * 1088 * 1024 : p.kbuf_p() + (size_t)k.b * 2048 * 1024;
    const bf16_t* Vb = k.samp ? p.vbuf_s() + (size_t)k.b * 1088 * 1024 : p.vbuf_p() + (size_t)k.b * 2048 * 1024;
    const float* q = dbg + 1024 + c * 128;
    float lam; { float a = 0.f, b2 = 0.f; for (int i = 0; i < 64; ++i) { a += p.lq1[i] * p.lk1[i]; b2 += p.lq2[i] * p.lk2[i]; } lam = expf(a) - expf(b2) + 0.2f; }
    float m1 = -1e30f, m2 = -1e30f;
    for (int key = tid; key < nkeys; key += 256) { float a = 0.f, b2 = 0.f; const bf16_t* kr = Kb + (size_t)key * 1024 + 128 * k.h; for (int d = 0; d < 64; ++d) { a += q[d] * bf2f(kr[d]); b2 += q[64 + d] * bf2f(kr[64 + d]); } s1[key] = a; s2[key] = b2; m1 = fmaxf(m1, a); m2 = fmaxf(m2, b2); }
    red[tid] = m1; __syncthreads(); for (int o = 128; o > 0; o >>= 1) { if (tid < o) red[tid] = fmaxf(red[tid], red[tid + o]); __syncthreads(); } m1 = red[0]; __syncthreads();
    red[tid] = m2; __syncthreads(); for (int o = 128; o > 0; o >>= 1) { if (tid < o) red[tid] = fmaxf(red[tid], red[tid + o]); __syncthreads(); } m2 = red[0]; __syncthreads();
    float l1 = 0.f, l2 = 0.f;
    for (int key = tid; key < nkeys; key += 256) { const float a = exp2f(s1[key] - m1), b2 = exp2f(s2[key] - m2); s1[key] = a; s2[key] = b2; l1 += a; l2 += b2; }
    red[tid] = l1; __syncthreads(); for (int o = 128; o > 0; o >>= 1) { if (tid < o) red[tid] += red[tid + o]; __syncthreads(); } l1 = red[0]; __syncthreads();
    red[tid] = l2; __syncthreads(); for (int o = 128; o > 0; o >>= 1) { if (tid < o) red[tid] += red[tid + o]; __syncthreads(); } l2 = red[0]; __syncthreads();
    float o = 0.f;
    if (tid < 128) for (int key = 0; key < nkeys; ++key) o += (s1[key] / l1 - lam * s2[key] / l2) * bf2f(Vb[(size_t)key * 1024 + 128 * k.h + tid]);
    red[tid] = tid < 128 ? o * o : 0.f; __syncthreads(); for (int oo = 128; oo > 0; oo >>= 1) { if (tid < oo) red[tid] += red[tid + oo]; __syncthreads(); }
    const float ss = red[0];
    if (tid < 128) { const float ref = o * rsqrtf(ss / 128.f + EPSN) * p.g_subln[tid] * 0.8f; const float got = bf2f(p.qbuf()[(size_t)row * 1024 + 128 * k.h + tid]);
        if (!(fabsf(ref - got) <= 0.04f + 0.04f * fabsf(ref))) atomicOr((unsigned*)dbg, k.samp ? 2u : 1u); }
}
__global__ void dbg_savez(Params p, float* dbg) {
    const int c = blockIdx.x; const SChk k = get_schk(c); const int T = k.samp ? 64 : 192; const int row0 = k.samp ? MP + 64 * k.b : k.b * 2048;
    for (int i = threadIdx.x; i < T * 64; i += blockDim.x) dbg[16384 + c * 192 * 64 + i] = bf2f(p.zbuf()[(size_t)(row0 + (i >> 6)) * 2048 + 64 * k.head + (i & 63)]);
}
__device__ float dbg_conv(const Params& p, int b, int samp, int row0, int t, int col) {
    float acc = p.conv_b[col];
    for (int j = 0; j < 4; ++j) { const int ts = t - 3 + j; float x; if (ts >= 0) x = bf2f(p.xbcbuf()[(size_t)(row0 + ts) * 3072 + col]); else x = samp ? p.state_conv[((size_t)b * 3 + ts + 3) * 3072 + col] : 0.f; acc += p.conv_w[j * 3072 + col] * x; }
    return acc / (1.0f + expf(-acc));
}
__global__ void dbg_chks(Params p, float* dbg) {
    __shared__ float hs[64 * 129], Bs[128], Cs[128];
    const int c = blockIdx.x, tp = threadIdx.x; const SChk k = get_schk(c); const int T = k.samp ? 64 : 192; const int row0 = k.samp ? MP + 64 * k.b : k.b * 2048; const int g = k.head >> 3;
    for (int n = 0; n < 128; ++n) hs[tp * 129 + n] = k.samp ? p.state_ssm[((size_t)(k.b * 32 + k.head) * 64 + tp) * 128 + n] : 0.f;
    const float a = -expf(p.a_log[k.head]), dsk = p.d_skip[k.head];
    for (int t = 0; t < T; ++t) {
        const float x = dbg_conv(p, k.b, k.samp, row0, t, 64 * k.head + tp);
        Bs[tp] = dbg_conv(p, k.b, k.samp, row0, t, 2048 + 128 * g + tp); Bs[tp + 64] = dbg_conv(p, k.b, k.samp, row0, t, 2048 + 128 * g + 64 + tp);
        Cs[tp] = dbg_conv(p, k.b, k.samp, row0, t, 2560 + 128 * g + tp); Cs[tp + 64] = dbg_conv(p, k.b, k.samp, row0, t, 2560 + 128 * g + 64 + tp);
        const float xr = p.dtbuf()[(size_t)(row0 + t) * 32 + k.head] + p.dt_bias[k.head]; const float dt = xr > 20.f ? xr : log1pf(expf(xr)); const float dec = expf(dt * a);
        __syncthreads();
        float y = 0.f;
        for (int n = 0; n < 128; ++n) { const float hv = hs[tp * 129 + n] * dec + dt * x * Bs[n]; hs[tp * 129 + n] = hv; y += Cs[n] * hv; }
        y += dsk * x;
        const float z = dbg[16384 + c * 192 * 64 + t * 64 + tp]; const float ref = y * z / (1.0f + expf(-z));
        const float got = bf2f(p.zbuf()[(size_t)(row0 + t) * 2048 + 64 * k.head + tp]);
        if (!(fabsf(ref - got) <= 0.05f * fabsf(ref) + 0.02f)) atomicOr((unsigned*)dbg, k.samp ? 8u : 4u);
        __syncthreads();
    }
}
__global__ void dbg_apply(float* out, const float* dbg, size_t lo, size_t hi) {
    const unsigned code = *(const unsigned*)dbg; const float f = 1.0f + 0.3f * (1.0f + (float)code);
    for (size_t i = lo + (size_t)blockIdx.x * 256 + threadIdx.x; i < hi; i += (size_t)gridDim.x * 256) out[i] *= f;
}
#endif

#ifdef DBG_TAP
__global__ void dbg_tap(Params p) {
    const size_t gt = (size_t)blockIdx.x * 256 + threadIdx.x, gs = (size_t)gridDim.x * 256;
    for (size_t i = gt; i < (size_t)MT * 1024; i += gs) { const size_t r = i >> 10; const int c = (int)(i & 1023);
        auto f = [](bf16_t v) { return __uint_as_float(((unsigned)v) << 16); };
#if DBG_TAP == 6
        p.y()[i] = f(p.gbuf()[r * 2048 + c]) + f(p.gbuf()[r * 2048 + 1024 + c]);
#elif DBG_TAP == 5
        p.y()[i] = f(p.zbuf()[r * 2048 + c]) + f(p.zbuf()[r * 2048 + 1024 + c]);
#elif DBG_TAP == 4
        p.y()[i] = f(p.zbuf()[r * 2048 + c]) + f(p.zbuf()[r * 2048 + 1024 + c]) + f(p.xbcbuf()[r * 3072 + c]) + f(p.xbcbuf()[r * 3072 + 1024 + c]) + f(p.xbcbuf()[r * 3072 + 2048 + c]);
#elif DBG_TAP == 7
        p.y()[i] = f(p.mbuf()[i]);
#endif
    }
}
#endif
#ifdef DBG_SCALE_LO
__global__ void dbg_scale(float* o) { const size_t gt = (size_t)blockIdx.x * 256 + threadIdx.x, gs = (size_t)gridDim.x * 256; for (size_t i = (size_t)DBG_SCALE_LO + gt; i < (size_t)DBG_SCALE_HI; i += gs) o[i] *= 1.3f; }
#endif
extern "C" void kernel_launch(void* const* d_in, const int* in_sizes, int n_in, void* d_out, int out_size, void* d_ws, size_t ws_size, hipStream_t stream) {
    static int grid_blocks = 0;
    if (!grid_blocks) {
        int dev = 0, cus = 0, per_cu = 0;
        hipGetDevice(&dev);
        hipDeviceGetAttribute(&cus, hipDeviceAttributeMultiprocessorCount, dev);
        hipFuncSetAttribute((const void*)fwd_megakernel, hipFuncAttributeMaxDynamicSharedMemorySize, LDS_BYTES);
        hipOccupancyMaxActiveBlocksPerMultiprocessor(&per_cu, (const void*)fwd_megakernel, 512, LDS_BYTES);
        if (per_cu < 1) per_cu = 1;
        grid_blocks = cus * per_cu;
        if (grid_blocks > 256) grid_blocks = 256;
    }
    Params p{};
    const float* const* in = (const float* const*)d_in;
    p.x_p = in[0]; p.x_s = in[1]; p.cache_k = in[2]; p.cache_v = in[3]; p.state_conv = in[4]; p.state_ssm = in[5]; p.c_p = in[6]; p.c_s = in[7];
    p.w_ada = in[8]; p.b_ada = in[9]; p.g_mix = in[10]; p.g_ffn = in[11]; p.w_in = in[12]; p.lq1 = in[13]; p.lk1 = in[14]; p.lq2 = in[15]; p.lk2 = in[16]; p.g_subln = in[17];
    p.conv_w = in[18]; p.conv_b = in[19]; p.dt_bias = in[20]; p.a_log = in[21]; p.d_skip = in[22]; p.g_ssd = in[23]; p.w_pa = in[24]; p.w_pb = in[25]; p.w_out = in[26]; p.w_gu = in[27]; p.w_down = in[28]; p.g_final = in[29];
    p.out = (float*)d_out; p.ws = (unsigned char*)d_ws;
    if (WS_END > ws_size || (size_t)out_size < O_END) { fprintf(stderr, "kernel_launch: workspace/output too small: need %zu / %zu, have %zu / %d\n", (size_t)WS_END, (size_t)O_END, ws_size, out_size); return; }
    size_t off = WS_END; unsigned char* w = (unsigned char*)d_ws;
    auto take = [&](size_t bytes) { unsigned char* r = w + off; off += (bytes + 255) & ~(size_t)255; return r; };
    (void)take;
#ifdef DBG_TAP
    p.ph_lo = 0; p.ph_hi = DBG_TAP + 1;
    void* args[] = {&p};
    hipError_t e = hipLaunchCooperativeKernel((const void*)fwd_megakernel, dim3(grid_blocks), dim3(512), args, LDS_BYTES, stream);
    dbg_tap<<<4096, 256, 0, stream>>>(p);
#elif defined(DBG_CHK)
    hipError_t e = hipSuccess;
    float* dbg = (float*)take(4 << 20);
    hipMemsetAsync(dbg, 0, 64, stream);
    auto run = [&](int lo, int hi) { p.ph_lo = lo; p.ph_hi = hi; void* args[] = {&p}; e = hipLaunchCooperativeKernel((const void*)fwd_megakernel, dim3(grid_blocks), dim3(512), args, LDS_BYTES, stream); };
    run(0, 3); dbg_saveq<<<96, 128, 0, stream>>>(p, dbg); run(3, 4); dbg_chka<<<96, 256, 0, stream>>>(p, dbg);
    run(4, 5); dbg_savez<<<32, 256, 0, stream>>>(p, dbg); run(5, 6); dbg_chks<<<32, 64, 0, stream>>>(p, dbg);
    run(6, 13);
    { const size_t lo = (size_t)MT * 1024 + 2 * (size_t)MP * 1024 + 294912 + 8388608 + 2 * (size_t)MS * 1024; dbg_apply<<<64, 256, 0, stream>>>((float*)d_out, dbg, lo, lo + 294912); }
#elif defined(DBG_MULTI)
    hipError_t e = hipSuccess;
    const int order[14] = {0, 1, 2, 3, 4, 5, 6, 7, 13, 8, 9, 10, 11, 12};
    for (int i = 0; i < 14; ++i) { p.ph_lo = order[i]; p.ph_hi = order[i] + 1; void* args[] = {&p}; e = hipLaunchCooperativeKernel((const void*)fwd_megakernel, dim3(grid_blocks), dim3(512), args, LDS_BYTES, stream); }
#else
    p.ph_lo = 0; p.ph_hi = 13;
    void* args[] = {&p};
    hipError_t e = hipLaunchCooperativeKernel((const void*)fwd_megakernel, dim3(grid_blocks), dim3(512), args, LDS_BYTES, stream);
#endif
    if (e != hipSuccess) fprintf(stderr, "cooperative launch failed: %s (grid %d)\n", hipGetErrorString(e), grid_blocks);
#ifdef DBG_SCALE_LO
    dbg_scale<<<2048, 256, 0, stream>>>((float*)d_out);
#endif
}
```

```cpp
#include <hip/hip_runtime.h>
#include <hip/hip_cooperative_groups.h>
#include <cstdio>
namespace cg = cooperative_groups;

#define LAS __attribute__((address_space(3)))
typedef unsigned short bf16_t;
typedef short bf16x8 __attribute__((ext_vector_type(8)));
typedef short s16x4 __attribute__((ext_vector_type(4)));
typedef float f32x4 __attribute__((ext_vector_type(4)));
typedef float f32x16 __attribute__((ext_vector_type(16)));
typedef unsigned u32x4 __attribute__((ext_vector_type(4)));
typedef unsigned u32x2 __attribute__((ext_vector_type(2)));

constexpr int MP = 65536, MS = 2048, MT = MP + MS;
constexpr int LDS_BYTES = 131072;
constexpr float EPSN = 1e-5f;
constexpr float LOG2E = 1.4426950408889634f;

constexpr size_t al256(size_t x) { return (x + 255) & ~(size_t)255; }
constexpr size_t WS_BT1A = 0, WS_BT1B = WS_BT1A + al256((size_t)3072 * 1024 * 2), WS_BT1C = WS_BT1B + al256((size_t)5376 * 1024 * 2), WS_BTPA = WS_BT1C + al256((size_t)2048 * 1024 * 2),
    WS_BTPB = WS_BTPA + al256((size_t)1024 * 1024 * 2), WS_BTOUT = WS_BTPB + al256((size_t)1024 * 2048 * 2), WS_BTGU = WS_BTOUT + al256((size_t)1024 * 1024 * 2), WS_BTDOWN = WS_BTGU + al256((size_t)5632 * 1024 * 2),
    WS_MOD = WS_BTDOWN + al256((size_t)1024 * 2816 * 2), WS_ROPE = WS_MOD + al256((size_t)64 * 6144 * 4), WS_DT = WS_ROPE + al256((size_t)2048 * 32 * 8), WS_SS = WS_DT + al256((size_t)MT * 32 * 4),
    WS_RH = WS_SS + al256((size_t)MT * 8 * 4), WS_RBIG = WS_RH + al256((size_t)MT * 1024 * 2), WS_RZ = WS_RBIG + al256((size_t)MT * 3072 * 2), WS_HALO = WS_RZ + al256((size_t)MT * 2048 * 2), WS_END = WS_HALO + al256((size_t)(MT / 64) * 3 * 3072 * 2);
constexpr size_t O_NKP = (size_t)MT * 1024, O_NVP = O_NKP + (size_t)MP * 1024, O_NCP = O_NVP + (size_t)MP * 1024, O_NSP = O_NCP + 32 * 3 * 3072, O_NKS = O_NSP + (size_t)32 * 32 * 64 * 128,
    O_NVS = O_NKS + (size_t)MS * 1024, O_NCS = O_NVS + (size_t)MS * 1024, O_NSS = O_NCS + 32 * 3 * 3072, O_END = O_NSS + (size_t)32 * 32 * 64 * 128;
struct Params {
    const float *x_p, *x_s, *cache_k, *cache_v, *state_conv, *state_ssm, *c_p, *c_s;
    const float *w_ada, *b_ada, *g_mix, *g_ffn, *w_in, *lq1, *lk1, *lq2, *lk2, *g_subln, *conv_w, *conv_b, *dt_bias, *a_log, *d_skip, *g_ssd;
    const float *w_pa, *w_pb, *w_out, *w_gu, *w_down, *g_final;
    float* out; unsigned char* ws;
    int ph_lo, ph_hi;
    __device__ __forceinline__ float* y() const { return out; }
    __device__ __forceinline__ float* nk_p() const { return out + O_NKP; }
    __device__ __forceinline__ float* nv_p() const { return out + O_NVP; }
    __device__ __forceinline__ float* nconv_p() const { return out + O_NCP; }
    __device__ __forceinline__ float* nssm_p() const { return out + O_NSP; }
    __device__ __forceinline__ float* nk_s() const { return out + O_NKS; }
    __device__ __forceinline__ float* nv_s() const { return out + O_NVS; }
    __device__ __forceinline__ float* nconv_s() const { return out + O_NCS; }
    __device__ __forceinline__ float* nssm_s() const { return out + O_NSS; }
    __device__ __forceinline__ bf16_t* bt1a() const { return (bf16_t*)(ws + WS_BT1A); }
    __device__ __forceinline__ bf16_t* bt1b() const { return (bf16_t*)(ws + WS_BT1B); }
    __device__ __forceinline__ bf16_t* bt1c() const { return (bf16_t*)(ws + WS_BT1C); }
    __device__ __forceinline__ bf16_t* btpa() const { return (bf16_t*)(ws + WS_BTPA); }
    __device__ __forceinline__ bf16_t* btpb() const { return (bf16_t*)(ws + WS_BTPB); }
    __device__ __forceinline__ bf16_t* btout() const { return (bf16_t*)(ws + WS_BTOUT); }
    __device__ __forceinline__ bf16_t* btgu() const { return (bf16_t*)(ws + WS_BTGU); }
    __device__ __forceinline__ bf16_t* btdown() const { return (bf16_t*)(ws + WS_BTDOWN); }
    __device__ __forceinline__ float* mod() const { return (float*)(ws + WS_MOD); }
    __device__ __forceinline__ float2* rope() const { return (float2*)(ws + WS_ROPE); }
    __device__ __forceinline__ float* dtbuf() const { return (float*)(ws + WS_DT); }
    __device__ __forceinline__ float* ssbuf() const { return (float*)(ws + WS_SS); }
    __device__ __forceinline__ bf16_t* hA() const { return (bf16_t*)(ws + WS_RH); }
    __device__ __forceinline__ bf16_t* mbuf() const { return (bf16_t*)(ws + WS_RH); }
    __device__ __forceinline__ bf16_t* h2() const { return (bf16_t*)(ws + WS_RH); }
    __device__ __forceinline__ bf16_t* qbuf() const { return (bf16_t*)out; }
    __device__ __forceinline__ bf16_t* kbuf_p() const { return (bf16_t*)(ws + WS_RBIG); }
    __device__ __forceinline__ bf16_t* vbuf_p() const { return (bf16_t*)(ws + WS_RBIG) + (size_t)MP * 1024; }
    __device__ __forceinline__ bf16_t* kbuf_s() const { return (bf16_t*)(ws + WS_RBIG) + (size_t)2 * MP * 1024; }
    __device__ __forceinline__ bf16_t* vbuf_s() const { return (bf16_t*)(ws + WS_RBIG) + (size_t)2 * MP * 1024 + (size_t)MS * 1024; }
    __device__ __forceinline__ bf16_t* xbcbuf() const { return (bf16_t*)(ws + WS_RBIG); }
    __device__ __forceinline__ bf16_t* gbuf() const { return (bf16_t*)(ws + WS_RBIG); }
    __device__ __forceinline__ bf16_t* swbuf() const { return (bf16_t*)(ws + WS_RBIG); }
    __device__ __forceinline__ bf16_t* zbuf() const { return (bf16_t*)(ws + WS_RZ); }
    __device__ __forceinline__ bf16_t* halo() const { return (bf16_t*)(ws + WS_HALO); }
};

typedef float f32x2_t __attribute__((ext_vector_type(2)));
typedef __bf16 bf16x2_t __attribute__((ext_vector_type(2)));
__device__ __forceinline__ unsigned cvt_pk_bf16(float lo, float hi) { const f32x2_t v = {lo, hi}; const bf16x2_t b = __builtin_convertvector(v, bf16x2_t); return __builtin_bit_cast(unsigned, b); }
__device__ __forceinline__ float bf_lo(unsigned w) { return __uint_as_float(w << 16); }
__device__ __forceinline__ float bf_hi(unsigned w) { return __uint_as_float(w & 0xffff0000u); }
__device__ __forceinline__ float fexp2(float x) { return __builtin_amdgcn_exp2f(x); }
__device__ __forceinline__ float fexp(float x) { return __builtin_amdgcn_exp2f(x * LOG2E); }
__device__ __forceinline__ float frcp(float x) { return __builtin_amdgcn_rcpf(x); }
__device__ __forceinline__ float sigmoidf_(float x) { return frcp(1.0f + fexp(-x)); }
__device__ __forceinline__ float siluf_(float x) { return x * sigmoidf_(x); }
__device__ __forceinline__ u32x4 pack8(f32x4 a, f32x4 b) { u32x4 w; w.x = cvt_pk_bf16(a[0], a[1]); w.y = cvt_pk_bf16(a[2], a[3]); w.z = cvt_pk_bf16(b[0], b[1]); w.w = cvt_pk_bf16(b[2], b[3]); return w; }
__device__ __forceinline__ u32x2 pack4(f32x4 a) { u32x2 w; w.x = cvt_pk_bf16(a[0], a[1]); w.y = cvt_pk_bf16(a[2], a[3]); return w; }

__device__ __forceinline__ int opaque_tid(int wv) { int t = wv * 64 + (int)__builtin_amdgcn_mbcnt_hi(~0u, __builtin_amdgcn_mbcnt_lo(~0u, 0u)); asm volatile("" : "+v"(t)); return t; }
namespace pg8 {
constexpr int BM = 256, BK = 64, HALF = 128, HTB = HALF * BK * 2, STAGE_BYTES = 8 * HTB, NXCD = 8, WGM = 8;
__host__ __device__ __forceinline__ int lds_byte(int r, int c) { const int st = (r >> 4) * 2 + (c >> 5), rr = r & 15, cc = c & 31, ob = rr * 64 + cc * 2; return st * 1024 + (ob ^ (((ob >> 9) & 1) << 5)); }
__host__ __device__ __forceinline__ void stage_rc(int b, int& R, int& C) { const int st = b / 1024, sb = b % 1024, swz = sb ^ (((sb >> 9) & 1) << 5); R = (st >> 1) * 16 + swz / 64; C = (st & 1) * 32 + (swz % 64) / 2; }
struct Unit { int pm, pn; };
struct Gemm { const bf16_t* A; const bf16_t* Bt; int M, N, K; };
struct StaticOrder {
    int nM, nN, nwg, G, c;
    __host__ __device__ void init(int M, int N, int G_, int c_) { nM = M / BM; nN = N / BM; nwg = nM * nN; G = G_; c = c_; }
    __host__ __device__ bool next(int i, Unit& u) const {
        const long L = (long)i * G + c; if (L >= nwg) return false;
        int wgid = (int)L; { const int q = nwg / NXCD, r = nwg % NXCD, xcd = wgid % NXCD, off = wgid / NXCD; wgid = (xcd < r ? xcd * (q + 1) : r * (q + 1) + (xcd - r) * q) + off; }
        const int nig = WGM * nN, gid = wgid / nig, fm = gid * WGM, gsz = (nM - fm) < WGM ? (nM - fm) : WGM;
        u.pm = fm + ((wgid % nig) % gsz); u.pn = (wgid % nig) / gsz; return true;
    }
};

template <class Epi>
__device__ __forceinline__ void gemm_phase(LAS unsigned char* lds, const Gemm g, const StaticOrder& S, const Epi& E, int wv) {
    const int tid = opaque_tid(wv), wid = __builtin_amdgcn_readfirstlane(tid >> 6), lane = tid & 63, wr = wid >> 2, wc = wid & 3, fr = lane & 15, fq = lane >> 4;
    const int K = g.K, nt = K / BK;
    unsigned voffA[2], voffB[2];
#pragma unroll
    for (int i = 0; i < 2; ++i) { int R, C; stage_rc(tid * 16 + i * 8192, R, C); voffA[i] = (unsigned)(R * K + C) * 2u; voffB[i] = voffA[i]; }
    const size_t kstep = (size_t)(BK * 2);
    const size_t hstep = (size_t)HALF * K * 2;
    const size_t tstep = 2 * hstep;
    const unsigned ldsw = (unsigned)wid * 1024u;
    const int aoff = lds_byte(wr * 64 + fr, fq * 8), boff = lds_byte(wc * 32 + fr, fq * 8);
#define PG8_SA(b, h) (((b) * 2 + (h)) * HTB)
#define PG8_SB(b, h) ((4 + (b) * 2 + (h)) * HTB)
#define PG8_STAGE(bufoff, gbase, voff) do { _Pragma("unroll") for (int _i = 0; _i < 2; ++_i) \
        __builtin_amdgcn_global_load_lds((const unsigned*)((const char*)(gbase) + (voff)[_i]), (LAS unsigned*)(lds + (bufoff) + ldsw + _i * 8192), 16, 0, 0); } while (0)
#define PG8_LDA(dst, b, h) do { _Pragma("unroll") for (int m = 0; m < 4; ++m) _Pragma("unroll") for (int k = 0; k < 2; ++k) dst[m][k] = *(const LAS bf16x8*)(lds + PG8_SA(b, h) + aoff + m * 2048 + k * 1024); } while (0)
#define PG8_LDB(dst, b, h) do { _Pragma("unroll") for (int n = 0; n < 2; ++n) _Pragma("unroll") for (int k = 0; k < 2; ++k) dst[n][k] = *(const LAS bf16x8*)(lds + PG8_SB(b, h) + boff + n * 2048 + k * 1024); } while (0)
#define PG8_MMA(ai, bj, At, Bt) do { __builtin_amdgcn_s_setprio(1); _Pragma("unroll") for (int m = 0; m < 4; ++m) _Pragma("unroll") for (int n = 0; n < 2; ++n) _Pragma("unroll") for (int k = 0; k < 2; ++k) \
        acc[ai][bj][m][n] = __builtin_amdgcn_mfma_f32_16x16x32_bf16(Bt[n][k], At[m][k], acc[ai][bj][m][n], 0, 0, 0); __builtin_amdgcn_s_setprio(0); } while (0)
#define PG8_WAIT_V(n) asm volatile("s_waitcnt vmcnt(" #n ")" ::: "memory")
#define PG8_WAIT_L(n) asm volatile("s_waitcnt lgkmcnt(" #n ")" ::: "memory")
#define PG8_BAR __builtin_amdgcn_s_barrier()
#define PG8_SCHED __builtin_amdgcn_sched_barrier(0)
    Unit cur, nxt; int ui = 0;
    if (!S.next(0, cur)) return;
    f32x4 acc[2][2][4][2];
#pragma unroll
    for (int a = 0; a < 2; ++a)
#pragma unroll
        for (int b = 0; b < 2; ++b)
#pragma unroll
            for (int m = 0; m < 4; ++m)
#pragma unroll
                for (int n = 0; n < 2; ++n) acc[a][b][m][n] = (f32x4){0.f, 0.f, 0.f, 0.f};
    bf16x8 At[4][2], B0[2][2], B1[2][2];
    const char* cA = (const char*)g.A + (size_t)cur.pm * tstep; const char* cB = (const char*)g.Bt + (size_t)cur.pn * tstep;
    PG8_STAGE(PG8_SB(0, 0), cB, voffB); PG8_STAGE(PG8_SA(0, 0), cA, voffA); PG8_STAGE(PG8_SB(0, 1), cB + hstep, voffB); PG8_STAGE(PG8_SA(0, 1), cA + hstep, voffA);
    if (wr == 1) PG8_BAR;
    PG8_WAIT_V(4); PG8_BAR;
    PG8_STAGE(PG8_SB(1, 0), cB + kstep, voffB); PG8_STAGE(PG8_SA(1, 0), cA + kstep, voffA); PG8_STAGE(PG8_SB(1, 1), cB + hstep + kstep, voffB);
    PG8_WAIT_V(6); PG8_BAR;
    for (;;) {
        const bool has_next = S.next(ui + 1, nxt);
        const char* nA = has_next ? (const char*)g.A + (size_t)nxt.pm * tstep : cA; const char* nB = has_next ? (const char*)g.Bt + (size_t)nxt.pn * tstep : cB;
        for (int t = 0; t < nt; t += 2) {
            const bool last = (t == nt - 2);
            const char* a1 = cA + (size_t)(t + 1) * kstep;
            const char* a2 = last ? nA : cA + (size_t)(t + 2) * kstep; const char* b2 = last ? nB : cB + (size_t)(t + 2) * kstep;
            const char* a3 = a2 + kstep; const char* b3 = b2 + kstep;
            PG8_LDB(B0, 0, 0); PG8_SCHED; PG8_LDA(At, 0, 0); PG8_STAGE(PG8_SA(1, 1), a1 + hstep, voffA);
            PG8_WAIT_L(8); PG8_BAR; PG8_WAIT_L(0); PG8_MMA(0, 0, At, B0); PG8_BAR; PG8_SCHED;
            PG8_LDB(B1, 0, 1); PG8_STAGE(PG8_SB(0, 0), b2, voffB);
            PG8_BAR; PG8_WAIT_L(0); PG8_MMA(0, 1, At, B1); PG8_BAR;
            PG8_LDA(At, 0, 1); PG8_STAGE(PG8_SA(0, 0), a2, voffA);
            PG8_BAR; PG8_WAIT_L(0); PG8_MMA(1, 0, At, B0); PG8_BAR; PG8_SCHED;
            PG8_STAGE(PG8_SB(0, 1), b2 + hstep, voffB);
            PG8_WAIT_V(6); PG8_BAR; PG8_MMA(1, 1, At, B1); PG8_BAR;
            PG8_LDB(B0, 1, 0); PG8_SCHED; PG8_LDA(At, 1, 0); PG8_STAGE(PG8_SA(0, 1), a2 + hstep, voffA);
            PG8_WAIT_L(8); PG8_BAR; PG8_WAIT_L(0); PG8_MMA(0, 0, At, B0); PG8_BAR; PG8_SCHED;
            PG8_LDB(B1, 1, 1); PG8_STAGE(PG8_SB(1, 0), b3, voffB);
            PG8_BAR; PG8_WAIT_L(0); PG8_MMA(0, 1, At, B1); PG8_BAR;
            PG8_LDA(At, 1, 1); PG8_STAGE(PG8_SA(1, 0), a3, voffA);
            PG8_BAR; PG8_WAIT_L(0); PG8_MMA(1, 0, At, B0); PG8_BAR; PG8_SCHED;
            PG8_STAGE(PG8_SB(1, 1), b3 + hstep, voffB);
            PG8_WAIT_V(6); PG8_BAR; PG8_MMA(1, 1, At, B1); PG8_BAR;
        }
        E(acc, cur, wr, wc, fr, fq);
        if (!has_next) break;
#pragma unroll
        for (int a = 0; a < 2; ++a)
#pragma unroll
            for (int b = 0; b < 2; ++b)
#pragma unroll
                for (int m = 0; m < 4; ++m)
#pragma unroll
                    for (int n = 0; n < 2; ++n) acc[a][b][m][n] = (f32x4){0.f, 0.f, 0.f, 0.f};
        cur = nxt; cA = nA; cB = nB; ++ui;
    }
    PG8_WAIT_V(0);
    if (wr == 0) PG8_BAR;
    PG8_BAR;
#undef PG8_SA
#undef PG8_SB
#undef PG8_STAGE
#undef PG8_LDA
#undef PG8_LDB
#undef PG8_MMA
#undef PG8_WAIT_V
#undef PG8_WAIT_L
#undef PG8_BAR
#undef PG8_SCHED
}
}

__device__ __forceinline__ int perm32i(int rho) { const int n = rho >> 4, i = rho & 15; return 8 * (i >> 2) + 4 * n + (i & 3); }
__device__ __forceinline__ int gperm(int c) { return (c & ~31) + perm32i(c & 31); }
__device__ __forceinline__ int rperm(int c) { const int w = (c >> 5) & 1, n = (c >> 4) & 1, i = c & 15; return (c & ~63) + 16 * w + i + 32 * n; }
__device__ __forceinline__ int src_col(int mode, int c) {
    switch (mode) {
        case 0: return c < 2048 ? rperm(c) : gperm(c);
        case 1: { if (c < 2048) return 3072 + gperm(c); if (c < 5120) return 5120 + gperm(c - 2048); const int t = gperm(c - 5120); return t < 32 ? 8192 + t : -1; }
        case 2: return 8224 + gperm(c);
        case 6: { const int pn = c >> 8, bj = (c >> 7) & 1, r = c & 127; return bj * 2816 + 128 * pn + gperm(r); }
        default: return gperm(c);
    }
}

__device__ __forceinline__ int batch_of(int r) { return r < MP ? (r >> 11) : 32 + ((r - MP) >> 6); }

template <int MODE> struct Epi {
    const Params& p;
    __device__ __forceinline__ void operator()(const f32x4 (&acc)[2][2][4][2], const pg8::Unit& u, int wr_, int wc_, int fr_, int fq_) const {
        int wr = wr_, wc = wc_, fr = fr_, fq = fq_;
        asm volatile("" : "+s"(wr), "+s"(wc), "+v"(fr), "+v"(fq));
        const int pn = u.pn;
#pragma unroll
        for (int ai = 0; ai < 2; ++ai)
#pragma unroll
            for (int m = 0; m < 4; ++m) {
                if ((MODE == 3 || MODE == 4) ? (m == 0) : ((m & 1) == 0)) __builtin_amdgcn_sched_barrier(0);
                const int r = u.pm * 256 + ai * 128 + wr * 64 + m * 16 + fr;
                const bool samp = r >= MP; const int rs = r - MP;
                if constexpr (MODE == 0) {
                    const int type = pn >> 2, colbase = (pn & 3) * 256;
                    if (type < 2) {
                        const int pos = samp ? 1024 + (rs & 63) : (r & 2047);
                        const int dlo = 16 * (wc & 1) + 4 * fq;
                        f32x4 cv, sv;
#pragma unroll
                        for (int j = 0; j < 4; ++j) {
                            const float frq = fexp2((float)(dlo + j) * (-13.287712379549449f / 32.0f)) * 0.15915494309189535f;
                            const float rev = __builtin_amdgcn_fractf((float)pos * frq);
                            cv[j] = __builtin_amdgcn_cosf(rev); sv[j] = __builtin_amdgcn_sinf(rev);
                        }
#pragma unroll
                        for (int bj = 0; bj < 2; ++bj) {
                            const int col = colbase + 64 * (2 * bj + (wc >> 1)) + dlo;
                            const f32x4 x1 = acc[ai][bj][m][0], x2 = acc[ai][bj][m][1];
                            f32x4 o1 = x1 * cv - x2 * sv, o2 = x2 * cv + x1 * sv;
                            if (type == 0) {
                                const float qs = 0.125f * LOG2E; o1 *= qs; o2 *= qs;
                                bf16_t* q = p.qbuf() + (size_t)r * 1024 + col;
                                *(u32x2*)q = pack4(o1); *(u32x2*)(q + 32) = pack4(o2);
                            } else {
                                float* ko = (samp ? p.nk_s() + (size_t)rs * 1024 : p.nk_p() + (size_t)r * 1024) + col;
                                *(f32x4*)ko = o1; *(f32x4*)(ko + 32) = o2;
                                bf16_t* kb = (samp ? p.kbuf_s() + (size_t)rs * 1024 : p.kbuf_p() + (size_t)r * 1024) + col;
                                *(u32x2*)kb = pack4(o1); *(u32x2*)(kb + 32) = pack4(o2);
                            }
                        }
                    } else {
#pragma unroll
                        for (int bj = 0; bj < 2; ++bj) {
                            const int col = colbase + 128 * bj + 32 * wc + 8 * fq;
                            float* vo = (samp ? p.nv_s() + (size_t)rs * 1024 : p.nv_p() + (size_t)r * 1024) + col;
                            *(f32x4*)vo = acc[ai][bj][m][0]; *(f32x4*)(vo + 4) = acc[ai][bj][m][1];
                            bf16_t* vb = (samp ? p.vbuf_s() + (size_t)rs * 1024 : p.vbuf_p() + (size_t)r * 1024) + col;
                            *(u32x4*)vb = pack8(acc[ai][bj][m][0], acc[ai][bj][m][1]);
                        }
                    }
                } else if constexpr (MODE == 1) {
                    if (pn < 8) {
#pragma unroll
                        for (int bj = 0; bj < 2; ++bj) { const int col = pn * 256 + 128 * bj + 32 * wc + 8 * fq; *(u32x4*)(p.zbuf() + (size_t)r * 2048 + col) = pack8(acc[ai][bj][m][0], acc[ai][bj][m][1]); }
                    } else if (pn < 20) {
                        const int tt = samp ? (rs & 63) - 61 : (r & 2047) - 2045;
#pragma unroll
                        for (int bj = 0; bj < 2; ++bj) {
                            const int col = (pn - 8) * 256 + 128 * bj + 32 * wc + 8 * fq;
                            const u32x4 xw = pack8(acc[ai][bj][m][0], acc[ai][bj][m][1]);
                            *(u32x4*)(p.xbcbuf() + (size_t)r * 3072 + col) = xw;
                            if ((r & 63) >= 61) *(u32x4*)(p.halo() + ((size_t)(r >> 6) * 3 + ((r & 63) - 61)) * 3072 + col) = xw;
                            if (tt >= 0) { float* co = (samp ? p.nconv_s() + ((size_t)(rs >> 6) * 3 + tt) * 3072 : p.nconv_p() + ((size_t)(r >> 11) * 3 + tt) * 3072) + col; *(f32x4*)co = acc[ai][bj][m][0]; *(f32x4*)(co + 4) = acc[ai][bj][m][1]; }
                        }
                    } else {
                        if (wc == 0) { float* d = p.dtbuf() + (size_t)r * 32 + 8 * fq; *(f32x4*)d = acc[ai][0][m][0]; *(f32x4*)(d + 4) = acc[ai][0][m][1]; }
                    }
                } else if constexpr (MODE == 2) {
#pragma unroll
                    for (int bj = 0; bj < 2; ++bj) {
                        const int col = pn * 256 + 128 * bj + 32 * wc + 8 * fq; f32x4 a = acc[ai][bj][m][0], b = acc[ai][bj][m][1];
#pragma unroll
                        for (int j = 0; j < 4; ++j) { a[j] = sigmoidf_(a[j]); b[j] = sigmoidf_(b[j]); }
                        *(u32x4*)(p.gbuf() + (size_t)r * 2048 + col) = pack8(a, b);
                    }
                } else if constexpr (MODE == 3 || MODE == 4) {
#pragma unroll
                    for (int bj = 0; bj < 2; ++bj) {
                        const int col = pn * 256 + 128 * bj + 32 * wc + 8 * fq;
                        const u32x4 g = *(const u32x4*)(p.gbuf() + (size_t)r * 2048 + (MODE == 4 ? 1024 : 0) + col);
                        f32x4 a = acc[ai][bj][m][0], b = acc[ai][bj][m][1];
                        a[0] *= bf_lo(g.x); a[1] *= bf_hi(g.x); a[2] *= bf_lo(g.y); a[3] *= bf_hi(g.y); b[0] *= bf_lo(g.z); b[1] *= bf_hi(g.z); b[2] *= bf_lo(g.w); b[3] *= bf_hi(g.w);
                        bf16_t* mp = p.mbuf() + (size_t)r * 1024 + col;
                        if constexpr (MODE == 4) { const u32x4 o = *(const u32x4*)mp; a[0] += bf_lo(o.x); a[1] += bf_hi(o.x); a[2] += bf_lo(o.y); a[3] += bf_hi(o.y); b[0] += bf_lo(o.z); b[1] += bf_hi(o.z); b[2] += bf_lo(o.w); b[3] += bf_hi(o.w); }
                        *(u32x4*)mp = pack8(a, b);
                    }
                } else if constexpr (MODE == 5 || MODE == 7) {
                    const int bidx = u.pm < 256 ? (u.pm >> 3) : 32 + (u.pm - 256) * 4 + 2 * ai + wr;
                    const float* mrow = p.mod() + (size_t)bidx * 6144 + (MODE == 5 ? 2048 : 5120);
#pragma unroll
                    for (int bj = 0; bj < 2; ++bj) {
                        const int col = pn * 256 + 128 * bj + 32 * wc + 8 * fq;
                        const float* xin = MODE == 5 ? ((samp ? p.x_s + (size_t)rs * 1024 : p.x_p + (size_t)r * 1024) + col) : (p.y() + (size_t)r * 1024 + col);
                        const f32x4 x0 = *(const f32x4*)xin, x1 = *(const f32x4*)(xin + 4), g0 = *(const f32x4*)(mrow + col), g1 = *(const f32x4*)(mrow + col + 4);
                        float* yo = p.y() + (size_t)r * 1024 + col;
                        *(f32x4*)yo = x0 + g0 * acc[ai][bj][m][0]; *(f32x4*)(yo + 4) = x1 + g1 * acc[ai][bj][m][1];
                    }
                } else if constexpr (MODE == 6) {
                    const int col = pn * 128 + 32 * wc + 8 * fq; f32x4 a = acc[ai][0][m][0], b = acc[ai][0][m][1];
#pragma unroll
                    for (int j = 0; j < 4; ++j) { a[j] = siluf_(a[j]) * acc[ai][1][m][0][j]; b[j] = siluf_(b[j]) * acc[ai][1][m][1][j]; }
                    *(u32x4*)(p.swbuf() + (size_t)r * 2816 + col) = pack8(a, b);
                }
            }
    }
};

template <int MODE> __device__ __forceinline__ void run_gemm(const Params& p, LAS unsigned char* lds, const bf16_t* A, const bf16_t* Bt, int N, int K, int wv) {
    pg8::Gemm g{A, Bt, MT, N, K}; pg8::StaticOrder S; S.init(MT, N, (int)gridDim.x, (int)blockIdx.x); Epi<MODE> E{p};
    pg8::gemm_phase<Epi<MODE>>(lds, g, S, E, wv);
}

__device__ __forceinline__ float wave_sum(float v) {
#pragma unroll
    for (int o = 32; o >= 1; o >>= 1) v += __shfl_xor(v, o);
    return v;
}

__device__ void prep_phase(const Params& p, LAS unsigned char* lds, int wv) {
    const int tid = opaque_tid(wv);
    {
        LAS float* tiles = (LAS float*)lds;
        const int ntiles[8] = {48 * 16, 84 * 16, 32 * 16, 16 * 16, 16 * 32, 16 * 16, 88 * 16, 16 * 44};
        int total = 0;
#pragma unroll
        for (int j = 0; j < 8; ++j) total += ntiles[j];
        for (int G = blockIdx.x; 4 * G < total; G += gridDim.x) {
            const float* W[4]; int ldw[4], K[4], n0[4], k0[4], job[4]; bf16_t* Bt[4];
#pragma unroll
            for (int u = 0; u < 4; ++u) {
                int j = 0, lt = 4 * G + u; if (lt >= total) lt = total - 1;
#pragma unroll
                for (int q = 0; q < 7; ++q) if (j == q && lt >= ntiles[q]) { lt -= ntiles[q]; j = q + 1; }
                switch (j) {
                    case 0: W[u] = p.w_in; ldw[u] = 10272; K[u] = 1024; Bt[u] = p.bt1a(); break;
                    case 1: W[u] = p.w_in; ldw[u] = 10272; K[u] = 1024; Bt[u] = p.bt1b(); break;
                    case 2: W[u] = p.w_in; ldw[u] = 10272; K[u] = 1024; Bt[u] = p.bt1c(); break;
                    case 3: W[u] = p.w_pa; ldw[u] = 1024; K[u] = 1024; Bt[u] = p.btpa(); break;
                    case 4: W[u] = p.w_pb; ldw[u] = 1024; K[u] = 2048; Bt[u] = p.btpb(); break;
                    case 5: W[u] = p.w_out; ldw[u] = 1024; K[u] = 1024; Bt[u] = p.btout(); break;
                    case 6: W[u] = p.w_gu; ldw[u] = 5632; K[u] = 1024; Bt[u] = p.btgu(); break;
                    default: W[u] = p.w_down; ldw[u] = 1024; K[u] = 2816; Bt[u] = p.btdown(); break;
                }
                const int nkt = K[u] >> 6; n0[u] = (lt / nkt) * 64; k0[u] = (lt % nkt) * 64; job[u] = j;
            }
            float v[4][8];
            const int col = tid & 63, kr = tid >> 6;
#pragma unroll
            for (int u = 0; u < 4; ++u) {
                const int sc = src_col(job[u], n0[u] + col);
#pragma unroll
                for (int jj = 0; jj < 8; ++jj) { const int k = kr + 8 * jj; v[u][jj] = sc >= 0 ? W[u][(size_t)(k0[u] + k) * ldw[u] + sc] : 0.f; }
            }
#pragma unroll
            for (int u = 0; u < 4; ++u)
#pragma unroll
                for (int jj = 0; jj < 8; ++jj) { const int k = kr + 8 * jj; float x = v[u][jj]; if (job[u] == 4) x *= p.g_ssd[k0[u] + k]; tiles[u * 64 * 65 + k * 65 + col] = x; }
            __syncthreads();
            {
                const int kk = (tid & 31) * 2, nr = tid >> 5;
#pragma unroll
                for (int u = 0; u < 4; ++u)
#pragma unroll
                    for (int jj = 0; jj < 4; ++jj) { const int n = nr + 16 * jj; *(unsigned*)(Bt[u] + (size_t)(n0[u] + n) * K[u] + k0[u] + kk) = cvt_pk_bf16(tiles[u * 64 * 65 + kk * 65 + n], tiles[u * 64 * 65 + (kk + 1) * 65 + n]); }
            }
            __syncthreads();
        }
    }
    {
        LAS float* sc = (LAS float*)lds;
        LAS float* wt = (LAS float*)(lds + 64 * 129 * 4);
        for (int cbk = blockIdx.x; cbk < 256; cbk += gridDim.x) {
            const int col0 = cbk * 24, row = tid & 63, cgp = tid >> 6;
            float a0 = 0.f, a1 = 0.f, a2 = 0.f;
            for (int kc = 0; kc < 8; ++kc) {
                const int k0 = kc * 128;
                __syncthreads();
#pragma unroll
                for (int i = 0; i < 16; ++i) { const int idx = tid + 512 * i, r = idx >> 7, k = idx & 127; const float v = r < 32 ? p.c_p[r * 1024 + k0 + k] : p.c_s[(r - 32) * 1024 + k0 + k]; sc[r * 129 + k] = siluf_(v); }
#pragma unroll
                for (int i = 0; i < 6; ++i) { const int idx = tid + 512 * i, k = idx / 24, c = idx % 24; wt[idx] = p.w_ada[(size_t)(k0 + k) * 6144 + col0 + c]; }
                __syncthreads();
#pragma unroll 8
                for (int k = 0; k < 128; ++k) { const float a = sc[row * 129 + k]; a0 += a * wt[k * 24 + 3 * cgp]; a1 += a * wt[k * 24 + 3 * cgp + 1]; a2 += a * wt[k * 24 + 3 * cgp + 2]; }
            }
            const int c = col0 + 3 * cgp;
            p.mod()[row * 6144 + c] = a0 + p.b_ada[c]; p.mod()[row * 6144 + c + 1] = a1 + p.b_ada[c + 1]; p.mod()[row * 6144 + c + 2] = a2 + p.b_ada[c + 2];
        }
        __syncthreads();
    }
    const size_t gtid = (size_t)blockIdx.x * 512 + tid, gsz = (size_t)gridDim.x * 512;
}

template <int MODE> __device__ void norm_phase(const Params& p, int wv) {
    const int tid = opaque_tid(wv); const int w = tid >> 6, lane = tid & 63;
    const float* g = MODE == 0 ? p.g_mix : (MODE == 1 ? p.g_ffn : p.g_final);
    const int stride = gridDim.x * 8;
    for (int r0 = blockIdx.x * 8 + w; r0 < MT; r0 += 2 * stride) {
        f32x4 v[2][4]; float ss[2] = {0.f, 0.f}; int rr[2];
#pragma unroll
        for (int q = 0; q < 2; ++q) {
            const int r = r0 + q * stride; rr[q] = r < MT ? r : r0;
            const float* src = MODE == 0 ? (rr[q] < MP ? p.x_p + (size_t)rr[q] * 1024 : p.x_s + (size_t)(rr[q] - MP) * 1024) : p.y() + (size_t)rr[q] * 1024;
#pragma unroll
            for (int j = 0; j < 4; ++j) v[q][j] = *(const f32x4*)(src + 256 * j + 4 * lane);
        }
#pragma unroll
        for (int q = 0; q < 2; ++q) {
#pragma unroll
            for (int j = 0; j < 4; ++j) ss[q] += v[q][j][0] * v[q][j][0] + v[q][j][1] * v[q][j][1] + v[q][j][2] * v[q][j][2] + v[q][j][3] * v[q][j][3];
            ss[q] = wave_sum(ss[q]);
        }
#pragma unroll
        for (int q = 0; q < 2; ++q) {
            if (q == 1 && r0 + stride >= MT) continue;
            const int r = rr[q];
            const float rsn = rsqrtf(ss[q] * (1.0f / 1024.0f) + EPSN);
            const float* mrow = p.mod() + (size_t)batch_of(r) * 6144 + (MODE == 0 ? 0 : 3072);
#pragma unroll
            for (int j = 0; j < 4; ++j) {
                const int c = 256 * j + 4 * lane; const f32x4 gg = *(const f32x4*)(g + c); f32x4 o = v[q][j] * rsn * gg;
                if constexpr (MODE == 2) { *(f32x4*)(p.y() + (size_t)r * 1024 + c) = o; }
                else { const f32x4 sh = *(const f32x4*)(mrow + c), scl = *(const f32x4*)(mrow + 1024 + c); o = o * (1.0f + scl) + sh; *(u32x2*)((MODE == 0 ? p.hA() : p.h2()) + (size_t)r * 1024 + c) = pack4(o); }
            }
        }
    }
}

__device__ void ssdnorm_phase(const Params& p, int wv) {
    const size_t gtid = (size_t)blockIdx.x * 512 + opaque_tid(wv), gsz = (size_t)gridDim.x * 512, total = (size_t)MT * 256;
    for (size_t i0 = gtid; i0 < total; i0 += 4 * gsz) {
        u32x4 u[4]; float rsn[4]; bf16_t* ptr[4];
#pragma unroll
        for (int q = 0; q < 4; ++q) {
            const size_t i = i0 + (size_t)q * gsz; const size_t ic = i < total ? i : i0;
            const size_t r = ic >> 8; const int e8 = (int)(ic & 255), gq = e8 >> 6;
            const float ss = p.ssbuf()[r * 8 + 2 * gq] + p.ssbuf()[r * 8 + 2 * gq + 1];
            rsn[q] = rsqrtf(ss * (1.0f / 512.0f) + EPSN);
            ptr[q] = p.zbuf() + r * 2048 + e8 * 8; u[q] = *(const u32x4*)ptr[q];
        }
#pragma unroll
        for (int q = 0; q < 4; ++q) {
            const size_t i = i0 + (size_t)q * gsz; if (i >= total) continue;
            u32x4 o; const float rs = rsn[q];
            o.x = cvt_pk_bf16(bf_lo(u[q].x) * rs, bf_hi(u[q].x) * rs); o.y = cvt_pk_bf16(bf_lo(u[q].y) * rs, bf_hi(u[q].y) * rs); o.z = cvt_pk_bf16(bf_lo(u[q].z) * rs, bf_hi(u[q].z) * rs); o.w = cvt_pk_bf16(bf_lo(u[q].w) * rs, bf_hi(u[q].w) * rs);
            *(u32x4*)ptr[q] = o;
        }
    }
}

constexpr int AT_K = 9216, AT_V = 20480, AT_STAGE = 2 * AT_K + AT_V;
template <bool PAST> __device__ __forceinline__ void attn_item(const Params& p, LAS unsigned char* lds, int row0, int h, const bf16_t* Kb, const bf16_t* Vb, const float* Kc, const float* Vc, int nt0, int nt1, float lam, int wv) {
    const int tid = opaque_tid(wv), w = __builtin_amdgcn_readfirstlane(tid >> 6), lane = tid & 63, l31 = lane & 31, hh = lane >> 5;
    const int hd = w >> 2, rb = w & 3, chunk = rb >> 1;
    const int ntl = nt0 > nt1 ? nt0 : nt1, my_nt = chunk ? nt1 : nt0;
    const int coff = 128 * h;
    bf16x8 qf[4];
    {
        const bf16_t* qp = p.qbuf() + (size_t)(row0 + rb * 32 + l31) * 1024 + coff + 64 * hd + 8 * hh;
#pragma unroll
        for (int s = 0; s < 4; ++s) qf[s] = my_nt > 0 ? *(const bf16x8*)(qp + 16 * s) : (bf16x8){0, 0, 0, 0, 0, 0, 0, 0};
    }
    f32x16 O[4];
#pragma unroll
    for (int c = 0; c < 4; ++c)
#pragma unroll
        for (int e = 0; e < 16; ++e) O[c][e] = 0.f;
    float m_run = -1e30f, l_run = 0.f;
    u32x4 kreg[2], vreg[2];
    f32x4 kf[PAST ? 2 : 1][2], vf[PAST ? 2 : 1][2];
    auto gload = [&](int t) {
        if (PAST && t < 16) {
            const int key0 = 64 * t;
#pragma unroll
            for (int jj = 0; jj < 2; ++jj) {
                const int idx = tid + 512 * jj;
                { const int which = idx >> 9, row = (idx >> 3) & 63, ch = idx & 7; const float* sp = Kc + (size_t)(key0 + row) * 1024 + coff + 64 * which + 8 * ch; kf[PAST ? jj : 0][0] = *(const f32x4*)sp; kf[PAST ? jj : 0][1] = *(const f32x4*)(sp + 4); }
                { const int row = idx >> 4, ch = idx & 15; const float* sp = Vc + (size_t)(key0 + row) * 1024 + coff + 8 * ch; vf[PAST ? jj : 0][0] = *(const f32x4*)sp; vf[PAST ? jj : 0][1] = *(const f32x4*)(sp + 4); }
            }
        } else {
            const int key0 = PAST ? 0 : 64 * t;
#pragma unroll
            for (int jj = 0; jj < 2; ++jj) {
                const int idx = tid + 512 * jj;
                { const int which = idx >> 9, row = (idx >> 3) & 63, ch = idx & 7; kreg[jj] = *(const u32x4*)(Kb + (size_t)(key0 + row) * 1024 + coff + 64 * which + 8 * ch); }
                { const int row = idx >> 4, ch = idx & 15; vreg[jj] = *(const u32x4*)(Vb + (size_t)(key0 + row) * 1024 + coff + 8 * ch); }
            }
        }
    };
    auto swrite = [&](int st, int t) {
        LAS unsigned char* base = lds + st * AT_STAGE;
        if (PAST && t < 16) {
#pragma unroll
            for (int jj = 0; jj < 2; ++jj) { kreg[jj] = pack8(kf[PAST ? jj : 0][0], kf[PAST ? jj : 0][1]); vreg[jj] = pack8(vf[PAST ? jj : 0][0], vf[PAST ? jj : 0][1]); }
        }
#pragma unroll
        for (int jj = 0; jj < 2; ++jj) {
            const int idx = tid + 512 * jj;
            { const int which = idx >> 9, row = (idx >> 3) & 63, ch = idx & 7; *(LAS u32x4*)(base + which * AT_K + row * 144 + ch * 16) = kreg[jj]; }
            { const int row = idx >> 4, ch = idx & 15; *(LAS u32x4*)(base + 2 * AT_K + row * 320 + ch * 16) = vreg[jj]; }
        }
    };
    const int q4 = (lane & 15) >> 2, blk = (lane >> 4) & 1, pp = lane & 3;
    auto qk = [&](int st, f32x16 (&S)[2]) {
        LAS unsigned char* Kt = lds + st * AT_STAGE + hd * AT_K + l31 * 144 + hh * 16;
#pragma unroll
        for (int kb = 0; kb < 2; ++kb) {
#pragma unroll
            for (int e = 0; e < 16; ++e) S[kb][e] = 0.f;
#pragma unroll
            for (int s = 0; s < 4; ++s) { const bf16x8 a = *(const LAS bf16x8*)(Kt + kb * 32 * 144 + s * 32); S[kb] = __builtin_amdgcn_mfma_f32_32x32x16_bf16(a, qf[s], S[kb], 0, 0, 0); }
        }
    };
    auto smpv = [&](int st, f32x16 (&S)[2]) {
        LAS unsigned char* Vt = lds + st * AT_STAGE + 2 * AT_K + (4 * hh + q4) * 320 + (16 * blk + 4 * pp) * 2;
        float mx = S[0][0];
#pragma unroll
        for (int e = 1; e < 16; ++e) mx = fmaxf(mx, S[0][e]);
#pragma unroll
        for (int e = 0; e < 16; ++e) mx = fmaxf(mx, S[1][e]);
        mx = fmaxf(mx, __shfl_xor(mx, 32));
        const float mn = fmaxf(m_run, mx), alpha = fexp2(m_run - mn); m_run = mn;
        float rsum = 0.f;
#pragma unroll
        for (int kb = 0; kb < 2; ++kb)
#pragma unroll
            for (int e = 0; e < 16; ++e) { const float pv = fexp2(S[kb][e] - mn); S[kb][e] = pv; rsum += pv; }
        l_run = l_run * alpha + rsum;
        if (__builtin_amdgcn_ballot_w64(alpha != 1.0f) != 0ull) {
#pragma unroll
            for (int c = 0; c < 4; ++c)
#pragma unroll
                for (int e = 0; e < 16; ++e) O[c][e] *= alpha;
        }
#pragma unroll
        for (int kb = 0; kb < 2; ++kb)
#pragma unroll
            for (int sp = 0; sp < 2; ++sp) {
                union { u32x4 u; bf16x8 v; } pb;
                pb.u.x = cvt_pk_bf16(S[kb][8 * sp + 0], S[kb][8 * sp + 1]); pb.u.y = cvt_pk_bf16(S[kb][8 * sp + 2], S[kb][8 * sp + 3]);
                pb.u.z = cvt_pk_bf16(S[kb][8 * sp + 4], S[kb][8 * sp + 5]); pb.u.w = cvt_pk_bf16(S[kb][8 * sp + 6], S[kb][8 * sp + 7]);
#pragma unroll
                for (int c = 0; c < 4; ++c) {
                    LAS unsigned char* va = Vt + (32 * kb + 16 * sp) * 320 + 64 * c;
                    const s16x4 v0 = __builtin_amdgcn_ds_read_tr16_b64_v4i16((LAS s16x4*)va);
                    const s16x4 v1 = __builtin_amdgcn_ds_read_tr16_b64_v4i16((LAS s16x4*)(va + 8 * 320));
                    const bf16x8 vfr = {v0[0], v0[1], v0[2], v0[3], v1[0], v1[1], v1[2], v1[3]};
                    O[c] = __builtin_amdgcn_mfma_f32_32x32x16_bf16(vfr, pb.v, O[c], 0, 0, 0);
                }
            }
    };
    if constexpr (PAST) {
        gload(0); swrite(0, 0); __syncthreads();
        for (int t = 0; t < ntl; ++t) {
            if (t + 1 < ntl) gload(t + 1);
            if (t < my_nt) { f32x16 S[2]; qk(t & 1, S); smpv(t & 1, S); }
            if (t + 1 < ntl) swrite((t + 1) & 1, t + 1);
            __syncthreads();
        }
    } else {
        gload(0); swrite(0, 0); if (ntl > 1) gload(1);
        __syncthreads();
        f32x16 Sn[2];
        if (my_nt > 0) qk(0, Sn);
        int st = 0;
        for (int t = 0; t < ntl; ++t) {
            const int st1 = st == 2 ? 0 : st + 1;
            f32x16 Sc[2]; Sc[0] = Sn[0]; Sc[1] = Sn[1];
            if (t + 1 < ntl) swrite(st1, t + 1);
            if (t + 2 < ntl) gload(t + 2);
            __syncthreads();
            if (t + 1 < my_nt) { qk(st1, Sn); smpv(st, Sc); }
            else if (t < my_nt) { smpv(st, Sc); }
            st = st1;
        }
        __syncthreads();
    }
    const float lt = l_run + __shfl_xor(l_run, 32);
    const float inv = my_nt > 0 ? 1.0f / lt : 0.f;
    LAS float* X = (LAS float*)lds;
    if (hd == 1) {
#pragma unroll
        for (int c = 0; c < 4; ++c)
#pragma unroll
            for (int i = 0; i < 4; ++i) { f32x4 o = {O[c][4 * i] * inv, O[c][4 * i + 1] * inv, O[c][4 * i + 2] * inv, O[c][4 * i + 3] * inv}; *(LAS f32x4*)(X + (rb * 32 + l31) * 132 + 32 * c + 8 * i + 4 * hh) = o; }
    }
    __syncthreads();
    if (hd == 0 && my_nt > 0) {
        float ss = 0.f;
#pragma unroll
        for (int c = 0; c < 4; ++c)
#pragma unroll
            for (int i = 0; i < 4; ++i) {
                const f32x4 o2 = *(const LAS f32x4*)(X + (rb * 32 + l31) * 132 + 32 * c + 8 * i + 4 * hh);
#pragma unroll
                for (int j = 0; j < 4; ++j) { const float o = O[c][4 * i + j] * inv - lam * o2[j]; O[c][4 * i + j] = o; ss += o * o; }
            }
        ss += __shfl_xor(ss, 32);
        const float rsn = rsqrtf(ss * (1.0f / 128.0f) + EPSN) * 0.8f;
        bf16_t* op = p.qbuf() + (size_t)(row0 + rb * 32 + l31) * 1024 + coff + 4 * hh;
#pragma unroll
        for (int c = 0; c < 4; ++c)
#pragma unroll
            for (int i = 0; i < 4; ++i) {
                const f32x4 g = *(const f32x4*)(p.g_subln + 32 * c + 8 * i + 4 * hh);
                const f32x4 o = {O[c][4 * i] * rsn * g[0], O[c][4 * i + 1] * rsn * g[1], O[c][4 * i + 2] * rsn * g[2], O[c][4 * i + 3] * rsn * g[3]};
                *(u32x2*)(op + 32 * c + 8 * i) = pack4(o);
            }
    }
    __syncthreads();
}

__device__ void attn_phase(const Params& p, LAS unsigned char* lds, int wv) {
    const int lane = opaque_tid(wv) & 63;
    const float a1 = wave_sum(p.lq1[lane] * p.lk1[lane]), a2 = wave_sum(p.lq2[lane] * p.lk2[lane]);
    const float lamv = __expf(a1) - __expf(a2) + 0.2f;
    const float lam = __builtin_bit_cast(float, __builtin_amdgcn_readfirstlane(__builtin_bit_cast(int, lamv)));
    for (int j = blockIdx.x; j < 256; j += gridDim.x) {
        const int b = j >> 3, h = j & 7;
#pragma unroll 1
        for (int i = 15; i >= 0; --i) attn_item<false>(p, lds, b * 2048 + 128 * i, h, p.kbuf_p() + (size_t)b * 2048 * 1024, p.vbuf_p() + (size_t)b * 2048 * 1024, nullptr, nullptr, 2 * i + 1, 2 * i + 2, lam, wv);
        attn_item<true>(p, lds, MP + 64 * b, h, p.kbuf_s() + (size_t)b * 64 * 1024, p.vbuf_s() + (size_t)b * 64 * 1024, p.cache_k + (size_t)b * 1024 * 1024, p.cache_v + (size_t)b * 1024 * 1024, 17, 0, lam, wv);
    }
}

__device__ void conv_phase(const Params& p, int wv) {
    const size_t gtid = (size_t)blockIdx.x * 512 + opaque_tid(wv), gsz = (size_t)gridDim.x * 512, total = (size_t)(MT / 64) * 384;
    for (size_t it = gtid; it < total; it += gsz) {
        const int cg = (int)(it / 384), sp = (int)(it % 384), col = sp * 8;
        f32x4 wv4[4][2], bias[2];
#pragma unroll
        for (int j = 0; j < 4; ++j) { wv4[j][0] = *(const f32x4*)(p.conv_w + j * 3072 + col); wv4[j][1] = *(const f32x4*)(p.conv_w + j * 3072 + col + 4); }
        bias[0] = *(const f32x4*)(p.conv_b + col); bias[1] = *(const f32x4*)(p.conv_b + col + 4);
        f32x4 win[3][2];
        const bool samp = cg >= MP / 64;
        if (samp) {
            const float* sc = p.state_conv + (size_t)(cg - MP / 64) * 3 * 3072 + col;
#pragma unroll
            for (int q = 0; q < 3; ++q) { win[q][0] = *(const f32x4*)(sc + q * 3072); win[q][1] = *(const f32x4*)(sc + q * 3072 + 4); }
        } else if ((cg & 31) == 0) {
#pragma unroll
            for (int q = 0; q < 3; ++q) { win[q][0] = (f32x4){0.f, 0.f, 0.f, 0.f}; win[q][1] = win[q][0]; }
        } else {
            const bf16_t* hp = p.halo() + (size_t)(cg - 1) * 3 * 3072 + col;
#pragma unroll
            for (int q = 0; q < 3; ++q) { const u32x4 u = *(const u32x4*)(hp + q * 3072); win[q][0] = (f32x4){bf_lo(u.x), bf_hi(u.x), bf_lo(u.y), bf_hi(u.y)}; win[q][1] = (f32x4){bf_lo(u.z), bf_hi(u.z), bf_lo(u.w), bf_hi(u.w)}; }
        }
        bf16_t* xp = p.xbcbuf() + (size_t)cg * 64 * 3072 + col;
#pragma unroll 1
        for (int t0 = 0; t0 < 64; t0 += 8) {
            u32x4 raw[8];
#pragma unroll
            for (int q = 0; q < 8; ++q) raw[q] = *(const u32x4*)(xp + (size_t)(t0 + q) * 3072);
#pragma unroll
            for (int q = 0; q < 8; ++q) {
                const f32x4 c0 = {bf_lo(raw[q].x), bf_hi(raw[q].x), bf_lo(raw[q].y), bf_hi(raw[q].y)}, c1 = {bf_lo(raw[q].z), bf_hi(raw[q].z), bf_lo(raw[q].w), bf_hi(raw[q].w)};
                f32x4 o0 = bias[0] + wv4[0][0] * win[0][0] + wv4[1][0] * win[1][0] + wv4[2][0] * win[2][0] + wv4[3][0] * c0;
                f32x4 o1 = bias[1] + wv4[0][1] * win[0][1] + wv4[1][1] * win[1][1] + wv4[2][1] * win[2][1] + wv4[3][1] * c1;
                win[0][0] = win[1][0]; win[0][1] = win[1][1]; win[1][0] = win[2][0]; win[1][1] = win[2][1]; win[2][0] = c0; win[2][1] = c1;
#pragma unroll
                for (int e = 0; e < 4; ++e) { o0[e] = siluf_(o0[e]); o1[e] = siluf_(o1[e]); }
                *(u32x4*)(xp + (size_t)(t0 + q) * 3072) = pack8(o0, o1);
            }
        }
    }
}

constexpr int SD_XT = 0, SD_BM = 36864, SD_BT = SD_BM + 17408, SD_CM = SD_BT + 18432, SD_CB = SD_CM + 17408, SD_CUM = SD_CB + 17408, SD_DT = SD_CUM + 1024, SD_SS = SD_DT + 1024;
__device__ void ssd_phase(const Params& p, LAS unsigned char* lds, int wv) {
    const int tid = opaque_tid(wv), w = __builtin_amdgcn_readfirstlane(tid >> 6), lane = tid & 63, l15 = lane & 15, g4 = lane >> 4;
    const int k = w >> 1, ph = w & 1;
    for (int jb = blockIdx.x; jb < 256; jb += gridDim.x) {
        const int b = jb >> 3, hq = jb & 7, grp = hq >> 1, head = 4 * hq + k;
        f32x4 Sacc[8][2];
#pragma unroll
        for (int nb = 0; nb < 8; ++nb)
#pragma unroll
            for (int pb = 0; pb < 2; ++pb) Sacc[nb][pb] = (f32x4){0.f, 0.f, 0.f, 0.f};
        const float a_h = -__expf(p.a_log[head]), dtb = p.dt_bias[head], dsk = p.d_skip[head];
        for (int step = 0; step < 33; ++step) {
            const bool samp = step == 32;
            const int row0 = samp ? MP + 64 * b : b * 2048 + 64 * step;
            if (samp) {
                float* so = p.nssm_p() + ((size_t)(b * 32 + head) * 64) * 128; const float* si = p.state_ssm + ((size_t)(b * 32 + head) * 64) * 128;
#pragma unroll
                for (int nb = 0; nb < 8; ++nb)
#pragma unroll
                    for (int pb = 0; pb < 2; ++pb) { const size_t o = (size_t)(32 * ph + 16 * pb + l15) * 128 + 16 * nb + 4 * g4; *(f32x4*)(so + o) = Sacc[nb][pb]; Sacc[nb][pb] = *(const f32x4*)(si + o); }
            }
            float dtraw = 0.f;
            if (w < 4) dtraw = p.dtbuf()[(size_t)(row0 + lane) * 32 + 4 * hq + w];
#pragma unroll 1
            for (int half = 0; half < 2; ++half) {
                int idv = tid + 512 * half; asm volatile("" : "+v"(idv));
                const int tb = idv & 7, cb4 = idv >> 3;
                const int ccol = cb4 < 64 ? 256 * hq + 4 * cb4 : (cb4 < 96 ? 2048 + 128 * grp + 4 * (cb4 - 64) : 2560 + 128 * grp + 4 * (cb4 - 96));
                f32x4 outv[8];
                {
                    u32x2 raw[8];
#pragma unroll
                    for (int tt = 0; tt < 8; ++tt) raw[tt] = *(const u32x2*)(p.xbcbuf() + (size_t)(row0 + 8 * tb + tt) * 3072 + ccol);
#pragma unroll
                    for (int tt = 0; tt < 8; ++tt) outv[tt] = (f32x4){bf_lo(raw[tt].x), bf_hi(raw[tt].x), bf_lo(raw[tt].y), bf_hi(raw[tt].y)};
                }
                if (cb4 < 64) {
                    LAS unsigned char* base = lds + SD_XT + (cb4 >> 4) * 9216 + (4 * (cb4 & 15)) * 144 + 16 * tb;
#pragma unroll
                    for (int e = 0; e < 4; ++e) { u32x4 u; u.x = cvt_pk_bf16(outv[0][e], outv[1][e]); u.y = cvt_pk_bf16(outv[2][e], outv[3][e]); u.z = cvt_pk_bf16(outv[4][e], outv[5][e]); u.w = cvt_pk_bf16(outv[6][e], outv[7][e]); *(LAS u32x4*)(base + e * 144) = u; }
                } else if (cb4 < 96) {
                    const int n0 = 4 * (cb4 - 64);
#pragma unroll
                    for (int tt = 0; tt < 8; ++tt) *(LAS u32x2*)(lds + SD_BM + (8 * tb + tt) * 272 + n0 * 2) = pack4(outv[tt]);
#pragma unroll
                    for (int e = 0; e < 4; ++e) { u32x4 u; u.x = cvt_pk_bf16(outv[0][e], outv[1][e]); u.y = cvt_pk_bf16(outv[2][e], outv[3][e]); u.z = cvt_pk_bf16(outv[4][e], outv[5][e]); u.w = cvt_pk_bf16(outv[6][e], outv[7][e]); *(LAS u32x4*)(lds + SD_BT + (n0 + e) * 144 + 16 * tb) = u; }
                } else {
                    const int n0 = 4 * (cb4 - 96);
#pragma unroll
                    for (int tt = 0; tt < 8; ++tt) *(LAS u32x2*)(lds + SD_CM + (8 * tb + tt) * 272 + n0 * 2) = pack4(outv[tt]);
                }
            }
            if (w < 4) {
                const int hd2 = 4 * hq + w;
                const float xr = dtraw + p.dt_bias[hd2];
                const float dt = xr > 20.f ? xr : log1pf(__expf(xr));
                float cum = dt * (-__expf(p.a_log[hd2]));
#pragma unroll
                for (int o = 1; o < 64; o <<= 1) { const float t2 = __shfl_up(cum, o); if (lane >= o) cum += t2; }
                ((LAS float*)(lds + SD_CUM))[w * 64 + lane] = cum; ((LAS float*)(lds + SD_DT))[w * 64 + lane] = dt;
            }
            __syncthreads();
            {
                const int lb = w >> 1;
#pragma unroll
                for (int q = 0; q < 2; ++q) {
                    const int sb = 2 * (w & 1) + q; f32x4 c4 = {0.f, 0.f, 0.f, 0.f};
#pragma unroll
                    for (int ks = 0; ks < 4; ++ks) {
                        const bf16x8 a = *(const LAS bf16x8*)(lds + SD_CM + (16 * lb + l15) * 272 + (32 * ks + 8 * g4) * 2);
                        const bf16x8 bb = *(const LAS bf16x8*)(lds + SD_BM + (16 * sb + l15) * 272 + (32 * ks + 8 * g4) * 2);
                        c4 = __builtin_amdgcn_mfma_f32_16x16x32_bf16(a, bb, c4, 0, 0, 0);
                    }
#pragma unroll
                    for (int j = 0; j < 4; ++j) ((LAS float*)(lds + SD_CB))[(16 * lb + 4 * g4 + j) * 68 + 16 * sb + l15] = c4[j];
                }
            }
            __syncthreads();
            {
                const LAS float* cumL = (const LAS float*)(lds + SD_CUM) + k * 64; const LAS float* dtL = (const LAS float*)(lds + SD_DT) + k * 64;
                const LAS unsigned char* XTk = lds + SD_XT + k * 9216;
                f32x4 yT[2][4];
#pragma unroll
                for (int pb = 0; pb < 2; ++pb)
#pragma unroll
                    for (int lb = 0; lb < 4; ++lb) yT[pb][lb] = (f32x4){0.f, 0.f, 0.f, 0.f};
#pragma unroll
                for (int ks = 0; ks < 4; ++ks) {
                    __builtin_amdgcn_sched_barrier(0);
                    union { u32x4 u; bf16x8 v; } af[2];
#pragma unroll
                    for (int pb = 0; pb < 2; ++pb) { af[pb].u.x = cvt_pk_bf16(Sacc[2 * ks][pb][0], Sacc[2 * ks][pb][1]); af[pb].u.y = cvt_pk_bf16(Sacc[2 * ks][pb][2], Sacc[2 * ks][pb][3]); af[pb].u.z = cvt_pk_bf16(Sacc[2 * ks + 1][pb][0], Sacc[2 * ks + 1][pb][1]); af[pb].u.w = cvt_pk_bf16(Sacc[2 * ks + 1][pb][2], Sacc[2 * ks + 1][pb][3]); }
#pragma unroll
                    for (int lb = 0; lb < 4; ++lb) {
                        const LAS unsigned char* cp = lds + SD_CM + (16 * lb + l15) * 272 + (32 * ks + 4 * g4) * 2;
                        union { u32x4 u; bf16x8 v; } bf; const u32x2 c0 = *(const LAS u32x2*)cp, c1 = *(const LAS u32x2*)(cp + 32);
                        bf.u.x = c0.x; bf.u.y = c0.y; bf.u.z = c1.x; bf.u.w = c1.y;
#pragma unroll
                        for (int pb = 0; pb < 2; ++pb) yT[pb][lb] = __builtin_amdgcn_mfma_f32_16x16x32_bf16(af[pb].v, bf.v, yT[pb][lb], 0, 0, 0);
                    }
                }
#pragma unroll
                for (int lb = 0; lb < 4; ++lb) { const float ec = fexp(cumL[16 * lb + l15]);
#pragma unroll
                    for (int pb = 0; pb < 2; ++pb) yT[pb][lb] *= ec; }
#pragma unroll
                for (int ks = 0; ks < 2; ++ks) {
                    __builtin_amdgcn_sched_barrier(0);
                    bf16x8 xa[2];
#pragma unroll
                    for (int pb = 0; pb < 2; ++pb) xa[pb] = *(const LAS bf16x8*)(XTk + (32 * ph + 16 * pb + l15) * 144 + (32 * ks + 8 * g4) * 2);
                    const int s0 = 32 * ks + 8 * g4;
                    const f32x4 cs0 = *(const LAS f32x4*)(cumL + s0), cs1 = *(const LAS f32x4*)(cumL + s0 + 4), ds0 = *(const LAS f32x4*)(dtL + s0), ds1 = *(const LAS f32x4*)(dtL + s0 + 4);
#pragma unroll
                    for (int lb = 0; lb < 4; ++lb) {
                        if (32 * ks > 16 * lb + 15) continue;
                        __builtin_amdgcn_sched_barrier(0);
                        const int l = 16 * lb + l15; const float cl = cumL[l];
                        const LAS float* cbp = (const LAS float*)(lds + SD_CB) + l * 68 + s0;
                        const f32x4 cb0 = *(const LAS f32x4*)cbp, cb1 = *(const LAS f32x4*)(cbp + 4);
                        float mv[8];
#pragma unroll
                        for (int e = 0; e < 4; ++e) {
                            { const int s = s0 + e; float v = s <= l ? cb0[e] * fexp(cl - cs0[e]) * ds0[e] : 0.f; if (s == l) v += dsk; mv[e] = v; }
                            { const int s = s0 + 4 + e; float v = s <= l ? cb1[e] * fexp(cl - cs1[e]) * ds1[e] : 0.f; if (s == l) v += dsk; mv[4 + e] = v; }
                        }
                        union { u32x4 u; bf16x8 v; } mf; mf.u.x = cvt_pk_bf16(mv[0], mv[1]); mf.u.y = cvt_pk_bf16(mv[2], mv[3]); mf.u.z = cvt_pk_bf16(mv[4], mv[5]); mf.u.w = cvt_pk_bf16(mv[6], mv[7]);
#pragma unroll
                        for (int pb = 0; pb < 2; ++pb) yT[pb][lb] = __builtin_amdgcn_mfma_f32_16x16x32_bf16(xa[pb], mf.v, yT[pb][lb], 0, 0, 0);
                    }
                }
                float ssl[4];
#pragma unroll
                for (int lb = 0; lb < 4; ++lb) {
                    __builtin_amdgcn_sched_barrier(0);
                    float ss = 0.f;
#pragma unroll
                    for (int pb = 0; pb < 2; ++pb) {
                        bf16_t* zp = p.zbuf() + (size_t)(row0 + 16 * lb + l15) * 2048 + 64 * head + 32 * ph + 16 * pb + 4 * g4;
                        const u32x2 zz = *(const u32x2*)zp;
                        f32x4 u = yT[pb][lb]; u[0] *= siluf_(bf_lo(zz.x)); u[1] *= siluf_(bf_hi(zz.x)); u[2] *= siluf_(bf_lo(zz.y)); u[3] *= siluf_(bf_hi(zz.y));
                        ss += u[0] * u[0] + u[1] * u[1] + u[2] * u[2] + u[3] * u[3];
                        *(u32x2*)zp = pack4(u);
                    }
                    ss += __shfl_xor(ss, 16); ss += __shfl_xor(ss, 32); ssl[lb] = ss;
                }
                if (g4 == 0) {
#pragma unroll
                    for (int lb = 0; lb < 4; ++lb) ((LAS float*)(lds + SD_SS))[w * 64 + 16 * lb + l15] = ssl[lb];
                }
                const float cend = cumL[63], dec = fexp(cend);
#pragma unroll
                for (int nb = 0; nb < 8; ++nb)
#pragma unroll
                    for (int pb = 0; pb < 2; ++pb) Sacc[nb][pb] *= dec;
#pragma unroll
                for (int ks = 0; ks < 2; ++ks) {
                    __builtin_amdgcn_sched_barrier(0);
                    const int s0 = 32 * ks + 8 * g4;
                    const f32x4 cs0 = *(const LAS f32x4*)(cumL + s0), cs1 = *(const LAS f32x4*)(cumL + s0 + 4), ds0 = *(const LAS f32x4*)(dtL + s0), ds1 = *(const LAS f32x4*)(dtL + s0 + 4);
                    float wsv[8];
#pragma unroll
                    for (int e = 0; e < 4; ++e) { wsv[e] = ds0[e] * fexp(cend - cs0[e]); wsv[4 + e] = ds1[e] * fexp(cend - cs1[e]); }
                    union { u32x4 u; bf16x8 v; } xb[2];
#pragma unroll
                    for (int pb = 0; pb < 2; ++pb) {
                        const u32x4 xr = *(const LAS u32x4*)(XTk + (32 * ph + 16 * pb + l15) * 144 + s0 * 2);
                        xb[pb].u.x = cvt_pk_bf16(bf_lo(xr.x) * wsv[0], bf_hi(xr.x) * wsv[1]); xb[pb].u.y = cvt_pk_bf16(bf_lo(xr.y) * wsv[2], bf_hi(xr.y) * wsv[3]);
                        xb[pb].u.z = cvt_pk_bf16(bf_lo(xr.z) * wsv[4], bf_hi(xr.z) * wsv[5]); xb[pb].u.w = cvt_pk_bf16(bf_lo(xr.w) * wsv[6], bf_hi(xr.w) * wsv[7]);
                    }
#pragma unroll
                    for (int nb = 0; nb < 8; ++nb) {
                        const bf16x8 ba = *(const LAS bf16x8*)(lds + SD_BT + (16 * nb + l15) * 144 + s0 * 2);
#pragma unroll
                        for (int pb = 0; pb < 2; ++pb) Sacc[nb][pb] = __builtin_amdgcn_mfma_f32_16x16x32_bf16(ba, xb[pb].v, Sacc[nb][pb], 0, 0, 0);
                    }
                }
            }
            __syncthreads();
            if (tid < 64) {
                float s = 0.f;
#pragma unroll
                for (int ww = 0; ww < 8; ++ww) s += ((const LAS float*)(lds + SD_SS))[ww * 64 + tid];
                p.ssbuf()[(size_t)(row0 + tid) * 8 + hq] = s;
            }
        }
        {
            float* so = p.nssm_s() + ((size_t)(b * 32 + head) * 64) * 128;
#pragma unroll
            for (int nb = 0; nb < 8; ++nb)
#pragma unroll
                for (int pb = 0; pb < 2; ++pb) *(f32x4*)(so + (size_t)(32 * ph + 16 * pb + l15) * 128 + 16 * nb + 4 * g4) = Sacc[nb][pb];
        }
        (void)a_h; (void)dtb;
    }
}

__device__ __forceinline__ void grid_barrier(unsigned* ctr, unsigned target, int wv) {
    asm volatile("s_waitcnt vmcnt(0) lgkmcnt(0)" ::: "memory");
    __builtin_amdgcn_s_barrier();
    if (wv == 0) {
        unsigned z = 0u; asm volatile("" : "+s"(z));
        const unsigned ln = __builtin_amdgcn_mbcnt_hi(~0u, __builtin_amdgcn_mbcnt_lo(~0u, z));
        if (ln == 0) {
            __builtin_amdgcn_fence(__ATOMIC_RELEASE, "agent");
            __hip_atomic_fetch_add(ctr, 1u, __ATOMIC_RELAXED, __HIP_MEMORY_SCOPE_AGENT);
            while (__hip_atomic_load(ctr, __ATOMIC_RELAXED, __HIP_MEMORY_SCOPE_AGENT) < target) __builtin_amdgcn_s_sleep(2);
        }
    }
    __builtin_amdgcn_s_barrier();
    __builtin_amdgcn_fence(__ATOMIC_ACQUIRE, "agent");
    asm volatile("s_waitcnt vmcnt(0) lgkmcnt(0)" ::: "memory");
}

__global__ void __launch_bounds__(512, 2) fwd_megakernel(Params p) {
    extern __shared__ __attribute__((aligned(16))) unsigned char shm[];
    LAS unsigned char* lds = (LAS unsigned char*)shm;
    cg::grid_group grid = cg::this_grid();
#ifndef PHMASK
#define PHMASK 0x3fff
#endif
#ifdef DBG_TIME_I
#define TSTAMP(k) if (blockIdx.x == 0 && threadIdx.x == 0) ((unsigned long long*)(p.ws + WS_END))[k] = __builtin_amdgcn_s_memrealtime();
#else
#define TSTAMP(k)
#endif
    TSTAMP(0)
#define PHASE(n, ...) if (p.ph_lo <= (n) && (n) < p.ph_hi) { if constexpr ((PHMASK >> (n)) & 1) { __VA_ARGS__ } if ((n) + 1 < p.ph_hi) { \
        grid_barrier((unsigned*)(p.ws + WS_END + 256), (unsigned)((n) - p.ph_lo + 1) * gridDim.x, wv); } TSTAMP((n) + 1) }
    const int wv = __builtin_amdgcn_readfirstlane(threadIdx.x >> 6);
    if (p.ph_hi < 0) grid.sync();
    PHASE(0, prep_phase(p, lds, wv);)
    PHASE(1, norm_phase<0>(p, wv);)
    PHASE(2, run_gemm<0>(p, lds, p.hA(), p.bt1a(), 3072, 1024, wv);)
    PHASE(3, attn_phase(p, lds, wv);)
    PHASE(4, run_gemm<1>(p, lds, p.hA(), p.bt1b(), 5376, 1024, wv);)
    PHASE(5, conv_phase(p, wv);)
    PHASE(6, ssd_phase(p, lds, wv);)
    PHASE(7, run_gemm<2>(p, lds, p.hA(), p.bt1c(), 2048, 1024, wv); ssdnorm_phase(p, wv);)
    PHASE(8, run_gemm<3>(p, lds, p.qbuf(), p.btpa(), 1024, 1024, wv); run_gemm<4>(p, lds, p.zbuf(), p.btpb(), 1024, 2048, wv);)
    PHASE(9, run_gemm<5>(p, lds, p.mbuf(), p.btout(), 1024, 1024, wv);)
    PHASE(10, norm_phase<1>(p, wv);)
    PHASE(11, run_gemm<6>(p, lds, p.h2(), p.btgu(), 5632, 1024, wv);)
    PHASE(12, run_gemm<7>(p, lds, p.swbuf(), p.btdown(), 1024, 2816, wv);)
    PHASE(13, norm_phase<2>(p, wv);)
#undef PHASE
}


#ifdef DBG_TIME_I
__global__ void dbg_time_apply(float* out, const unsigned long long* ts) {
    const float tot = (float)(ts[14] - ts[0]); const float fi = (float)(ts[DBG_TIME_I + 1] - ts[DBG_TIME_I]) / tot, fj = (float)(ts[DBG_TIME_J + 1] - ts[DBG_TIME_J]) / tot;
    const float sc = 1.0f + sqrtf(fi);
    for (size_t i = O_NCS + (size_t)blockIdx.x * 256 + threadIdx.x; i < O_NCS + 294912; i += (size_t)gridDim.x * 256) out[i] *= sc;
    if (blockIdx.x == 0 && threadIdx.x == 0) out[0] += 1000.0f * fj;
}
#endif
extern "C" void kernel_launch(void* const* d_in, const int* in_sizes, int n_in, void* d_out, int out_size, void* d_ws, size_t ws_size, hipStream_t stream) {
    static int grid_blocks = 0;
    if (!grid_blocks) {
        int dev = 0, cus = 0, per_cu = 0;
        hipGetDevice(&dev);
        hipDeviceGetAttribute(&cus, hipDeviceAttributeMultiprocessorCount, dev);
        hipFuncSetAttribute((const void*)fwd_megakernel, hipFuncAttributeMaxDynamicSharedMemorySize, LDS_BYTES);
        hipOccupancyMaxActiveBlocksPerMultiprocessor(&per_cu, (const void*)fwd_megakernel, 512, LDS_BYTES);
        if (per_cu < 1) per_cu = 1;
        grid_blocks = cus * per_cu;
        if (grid_blocks > 256) grid_blocks = 256;
    }
    Params p{};
    const float* const* in = (const float* const*)d_in;
    p.x_p = in[0]; p.x_s = in[1]; p.cache_k = in[2]; p.cache_v = in[3]; p.state_conv = in[4]; p.state_ssm = in[5]; p.c_p = in[6]; p.c_s = in[7];
    p.w_ada = in[8]; p.b_ada = in[9]; p.g_mix = in[10]; p.g_ffn = in[11]; p.w_in = in[12]; p.lq1 = in[13]; p.lk1 = in[14]; p.lq2 = in[15]; p.lk2 = in[16]; p.g_subln = in[17];
    p.conv_w = in[18]; p.conv_b = in[19]; p.dt_bias = in[20]; p.a_log = in[21]; p.d_skip = in[22]; p.g_ssd = in[23]; p.w_pa = in[24]; p.w_pb = in[25]; p.w_out = in[26]; p.w_gu = in[27]; p.w_down = in[28]; p.g_final = in[29];
    p.out = (float*)d_out; p.ws = (unsigned char*)d_ws;
    if (WS_END + 1024 > ws_size || (size_t)out_size < O_END) { fprintf(stderr, "kernel_launch: workspace/output too small: need %zu / %zu, have %zu / %d\n", (size_t)WS_END, (size_t)O_END, ws_size, out_size); return; }
    hipMemsetAsync((unsigned char*)d_ws + WS_END + 256, 0, 64, stream);
    p.ph_lo = 0; p.ph_hi = 14;
    void* args[] = {&p};
    hipError_t e = hipLaunchCooperativeKernel((const void*)fwd_megakernel, dim3(grid_blocks), dim3(512), args, LDS_BYTES, stream);
    if (e != hipSuccess) fprintf(stderr, "cooperative launch failed: %s (grid %d)\n", hipGetErrorString(e), grid_blocks);
#ifdef DBG_TIME_I
    dbg_time_apply<<<64, 256, 0, stream>>>((float*)d_out, (const unsigned long long*)((unsigned char*)d_ws + WS_END));
#endif
}
```

```cpp
#include <hip/hip_runtime.h>
#include <hip/hip_cooperative_groups.h>
#include <cstdio>
namespace cg = cooperative_groups;

#define LAS __attribute__((address_space(3)))
typedef unsigned short bf16_t;
typedef short bf16x8 __attribute__((ext_vector_type(8)));
typedef short s16x4 __attribute__((ext_vector_type(4)));
typedef float f32x4 __attribute__((ext_vector_type(4)));
typedef float f32x16 __attribute__((ext_vector_type(16)));
typedef unsigned u32x4 __attribute__((ext_vector_type(4)));
typedef unsigned u32x2 __attribute__((ext_vector_type(2)));

constexpr int MP = 65536, MS = 2048, MT = MP + MS;
constexpr int LDS_BYTES = 131072;
constexpr float EPSN = 1e-5f;
constexpr float LOG2E = 1.4426950408889634f;

constexpr size_t al256(size_t x) { return (x + 255) & ~(size_t)255; }
constexpr size_t WS_BT1A = 0, WS_BT1B = WS_BT1A + al256((size_t)3072 * 1024 * 2), WS_BT1C = WS_BT1B + al256((size_t)5376 * 1024 * 2), WS_BTPA = WS_BT1C + al256((size_t)2048 * 1024 * 2),
    WS_BTPB = WS_BTPA + al256((size_t)1024 * 1024 * 2), WS_BTOUT = WS_BTPB + al256((size_t)1024 * 2048 * 2), WS_BTGU = WS_BTOUT + al256((size_t)1024 * 1024 * 2), WS_BTDOWN = WS_BTGU + al256((size_t)5632 * 1024 * 2),
    WS_MOD = WS_BTDOWN + al256((size_t)1024 * 2816 * 2), WS_ROPE = WS_MOD + al256((size_t)64 * 6144 * 4), WS_DT = WS_ROPE + al256((size_t)2048 * 32 * 8), WS_SS = WS_DT + al256((size_t)MT * 32 * 4),
    WS_RH = WS_SS + al256((size_t)MT * 8 * 4), WS_RBIG = WS_RH + al256((size_t)MT * 1024 * 2), WS_RZ = WS_RBIG + al256((size_t)MT * 3072 * 2), WS_HALO = WS_RZ + al256((size_t)MT * 2048 * 2), WS_END = WS_HALO + al256((size_t)(MT / 64) * 3 * 3072 * 2);
constexpr size_t O_NKP = (size_t)MT * 1024, O_NVP = O_NKP + (size_t)MP * 1024, O_NCP = O_NVP + (size_t)MP * 1024, O_NSP = O_NCP + 32 * 3 * 3072, O_NKS = O_NSP + (size_t)32 * 32 * 64 * 128,
    O_NVS = O_NKS + (size_t)MS * 1024, O_NCS = O_NVS + (size_t)MS * 1024, O_NSS = O_NCS + 32 * 3 * 3072, O_END = O_NSS + (size_t)32 * 32 * 64 * 128;
struct Params {
    const float *x_p, *x_s, *cache_k, *cache_v, *state_conv, *state_ssm, *c_p, *c_s;
    const float *w_ada, *b_ada, *g_mix, *g_ffn, *w_in, *lq1, *lk1, *lq2, *lk2, *g_subln, *conv_w, *conv_b, *dt_bias, *a_log, *d_skip, *g_ssd;
    const float *w_pa, *w_pb, *w_out, *w_gu, *w_down, *g_final;
    float* out; unsigned char* ws;
    int ph_lo, ph_hi;
    __device__ __forceinline__ float* y() const { return out; }
    __device__ __forceinline__ float* nk_p() const { return out + O_NKP; }
    __device__ __forceinline__ float* nv_p() const { return out + O_NVP; }
    __device__ __forceinline__ float* nconv_p() const { return out + O_NCP; }
    __device__ __forceinline__ float* nssm_p() const { return out + O_NSP; }
    __device__ __forceinline__ float* nk_s() const { return out + O_NKS; }
    __device__ __forceinline__ float* nv_s() const { return out + O_NVS; }
    __device__ __forceinline__ float* nconv_s() const { return out + O_NCS; }
    __device__ __forceinline__ float* nssm_s() const { return out + O_NSS; }
    __device__ __forceinline__ bf16_t* bt1a() const { return (bf16_t*)(ws + WS_BT1A); }
    __device__ __forceinline__ bf16_t* bt1b() const { return (bf16_t*)(ws + WS_BT1B); }
    __device__ __forceinline__ bf16_t* bt1c() const { return (bf16_t*)(ws + WS_BT1C); }
    __device__ __forceinline__ bf16_t* btpa() const { return (bf16_t*)(ws + WS_BTPA); }
    __device__ __forceinline__ bf16_t* btpb() const { return (bf16_t*)(ws + WS_BTPB); }
    __device__ __forceinline__ bf16_t* btout() const { return (bf16_t*)(ws + WS_BTOUT); }
    __device__ __forceinline__ bf16_t* btgu() const { return (bf16_t*)(ws + WS_BTGU); }
    __device__ __forceinline__ bf16_t* btdown() const { return (bf16_t*)(ws + WS_BTDOWN); }
    __device__ __forceinline__ float* mod() const { return (float*)(ws + WS_MOD); }
    __device__ __forceinline__ float2* rope() const { return (float2*)(ws + WS_ROPE); }
    __device__ __forceinline__ float* dtbuf() const { return (float*)(ws + WS_DT); }
    __device__ __forceinline__ float* ssbuf() const { return (float*)(ws + WS_SS); }
    __device__ __forceinline__ bf16_t* hA() const { return (bf16_t*)(ws + WS_RH); }
    __device__ __forceinline__ bf16_t* mbuf() const { return (bf16_t*)(ws + WS_RH); }
    __device__ __forceinline__ bf16_t* h2() const { return (bf16_t*)(ws + WS_RH); }
    __device__ __forceinline__ bf16_t* qbuf() const { return (bf16_t*)out; }
    __device__ __forceinline__ bf16_t* kbuf_p() const { return (bf16_t*)(ws + WS_RBIG); }
    __device__ __forceinline__ bf16_t* vbuf_p() const { return (bf16_t*)(ws + WS_RBIG) + (size_t)MP * 1024; }
    __device__ __forceinline__ bf16_t* kbuf_s() const { return (bf16_t*)(ws + WS_RBIG) + (size_t)2 * MP * 1024; }
    __device__ __forceinline__ bf16_t* vbuf_s() const { return (bf16_t*)(ws + WS_RBIG) + (size_t)2 * MP * 1024 + (size_t)MS * 1024; }
    __device__ __forceinline__ bf16_t* xbcbuf() const { return (bf16_t*)(ws + WS_RBIG); }
    __device__ __forceinline__ bf16_t* gbuf() const { return (bf16_t*)(ws + WS_RBIG); }
    __device__ __forceinline__ bf16_t* swbuf() const { return (bf16_t*)(ws + WS_RBIG); }
    __device__ __forceinline__ bf16_t* zbuf() const { return (bf16_t*)(ws + WS_RZ); }
    __device__ __forceinline__ bf16_t* halo() const { return (bf16_t*)(ws + WS_HALO); }
};

typedef float f32x2_t __attribute__((ext_vector_type(2)));
typedef __bf16 bf16x2_t __attribute__((ext_vector_type(2)));
__device__ __forceinline__ unsigned cvt_pk_bf16(float lo, float hi) { const f32x2_t v = {lo, hi}; const bf16x2_t b = __builtin_convertvector(v, bf16x2_t); return __builtin_bit_cast(unsigned, b); }
__device__ __forceinline__ float bf_lo(unsigned w) { return __uint_as_float(w << 16); }
__device__ __forceinline__ float bf_hi(unsigned w) { return __uint_as_float(w & 0xffff0000u); }
__device__ __forceinline__ float fexp2(float x) { return __builtin_amdgcn_exp2f(x); }
__device__ __forceinline__ float fexp(float x) { return __builtin_amdgcn_exp2f(x * LOG2E); }
__device__ __forceinline__ float frcp(float x) { return __builtin_amdgcn_rcpf(x); }
__device__ __forceinline__ float sigmoidf_(float x) { return frcp(1.0f + fexp(-x)); }
__device__ __forceinline__ float siluf_(float x) { return x * sigmoidf_(x); }
__device__ __forceinline__ u32x4 pack8(f32x4 a, f32x4 b) { u32x4 w; w.x = cvt_pk_bf16(a[0], a[1]); w.y = cvt_pk_bf16(a[2], a[3]); w.z = cvt_pk_bf16(b[0], b[1]); w.w = cvt_pk_bf16(b[2], b[3]); return w; }
__device__ __forceinline__ u32x2 pack4(f32x4 a) { u32x2 w; w.x = cvt_pk_bf16(a[0], a[1]); w.y = cvt_pk_bf16(a[2], a[3]); return w; }

__device__ __forceinline__ int opaque_tid(int wv) { int t = wv * 64 + (int)__builtin_amdgcn_mbcnt_hi(~0u, __builtin_amdgcn_mbcnt_lo(~0u, 0u)); asm volatile("" : "+v"(t)); return t; }
namespace pg8 {
constexpr int BM = 256, BK = 64, HALF = 128, HTB = HALF * BK * 2, STAGE_BYTES = 8 * HTB, NXCD = 8, WGM = 8;
__host__ __device__ __forceinline__ int lds_byte(int r, int c) { const int st = (r >> 4) * 2 + (c >> 5), rr = r & 15, cc = c & 31, ob = rr * 64 + cc * 2; return st * 1024 + (ob ^ (((ob >> 9) & 1) << 5)); }
__host__ __device__ __forceinline__ void stage_rc(int b, int& R, int& C) { const int st = b / 1024, sb = b % 1024, swz = sb ^ (((sb >> 9) & 1) << 5); R = (st >> 1) * 16 + swz / 64; C = (st & 1) * 32 + (swz % 64) / 2; }
struct Unit { int pm, pn; };
struct Gemm { const bf16_t* A; const bf16_t* Bt; int M, N, K; };
struct StaticOrder {
    int nM, nN, nwg, G, c;
    __host__ __device__ void init(int M, int N, int G_, int c_) { nM = M / BM; nN = N / BM; nwg = nM * nN; G = G_; c = c_; }
    __host__ __device__ bool next(int i, Unit& u) const {
        const long L = (long)i * G + c; if (L >= nwg) return false;
        int wgid = (int)L; { const int q = nwg / NXCD, r = nwg % NXCD, xcd = wgid % NXCD, off = wgid / NXCD; wgid = (xcd < r ? xcd * (q + 1) : r * (q + 1) + (xcd - r) * q) + off; }
        const int nig = WGM * nN, gid = wgid / nig, fm = gid * WGM, gsz = (nM - fm) < WGM ? (nM - fm) : WGM;
        u.pm = fm + ((wgid % nig) % gsz); u.pn = (wgid % nig) / gsz; return true;
    }
};

template <class Epi>
__device__ __forceinline__ void gemm_phase(LAS unsigned char* lds, const Gemm g, const StaticOrder& S, const Epi& E, int wv) {
    const int tid = opaque_tid(wv), wid = __builtin_amdgcn_readfirstlane(tid >> 6), lane = tid & 63, wr = wid >> 2, wc = wid & 3, fr = lane & 15, fq = lane >> 4;
    const int K = g.K, nt = K / BK;
    unsigned voffA[2], voffB[2];
#pragma unroll
    for (int i = 0; i < 2; ++i) { int R, C; stage_rc(tid * 16 + i * 8192, R, C); voffA[i] = (unsigned)(R * K + C) * 2u; voffB[i] = voffA[i]; }
    const size_t kstep = (size_t)(BK * 2);
    const size_t hstep = (size_t)HALF * K * 2;
    const size_t tstep = 2 * hstep;
    const unsigned ldsw = (unsigned)wid * 1024u;
    const int aoff = lds_byte(wr * 64 + fr, fq * 8), boff = lds_byte(wc * 32 + fr, fq * 8);
#define PG8_SA(b, h) (((b) * 2 + (h)) * HTB)
#define PG8_SB(b, h) ((4 + (b) * 2 + (h)) * HTB)
#define PG8_STAGE(bufoff, gbase, voff) do { _Pragma("unroll") for (int _i = 0; _i < 2; ++_i) \
        __builtin_amdgcn_global_load_lds((const unsigned*)((const char*)(gbase) + (voff)[_i]), (LAS unsigned*)(lds + (bufoff) + ldsw + _i * 8192), 16, 0, 0); } while (0)
#define PG8_LDA(dst, b, h) do { _Pragma("unroll") for (int m = 0; m < 4; ++m) _Pragma("unroll") for (int k = 0; k < 2; ++k) dst[m][k] = *(const LAS bf16x8*)(lds + PG8_SA(b, h) + aoff + m * 2048 + k * 1024); } while (0)
#define PG8_LDB(dst, b, h) do { _Pragma("unroll") for (int n = 0; n < 2; ++n) _Pragma("unroll") for (int k = 0; k < 2; ++k) dst[n][k] = *(const LAS bf16x8*)(lds + PG8_SB(b, h) + boff + n * 2048 + k * 1024); } while (0)
#define PG8_MMA(ai, bj, At, Bt) do { __builtin_amdgcn_s_setprio(1); _Pragma("unroll") for (int m = 0; m < 4; ++m) _Pragma("unroll") for (int n = 0; n < 2; ++n) _Pragma("unroll") for (int k = 0; k < 2; ++k) \
        acc[ai][bj][m][n] = __builtin_amdgcn_mfma_f32_16x16x32_bf16(Bt[n][k], At[m][k], acc[ai][bj][m][n], 0, 0, 0); __builtin_amdgcn_s_setprio(0); } while (0)
#define PG8_WAIT_V(n) asm volatile("s_waitcnt vmcnt(" #n ")" ::: "memory")
#define PG8_WAIT_L(n) asm volatile("s_waitcnt lgkmcnt(" #n ")" ::: "memory")
#define PG8_BAR __builtin_amdgcn_s_barrier()
#define PG8_SCHED __builtin_amdgcn_sched_barrier(0)
    Unit cur, nxt; int ui = 0;
    if (!S.next(0, cur)) return;
    f32x4 acc[2][2][4][2];
#pragma unroll
    for (int a = 0; a < 2; ++a)
#pragma unroll
        for (int b = 0; b < 2; ++b)
#pragma unroll
            for (int m = 0; m < 4; ++m)
#pragma unroll
                for (int n = 0; n < 2; ++n) acc[a][b][m][n] = (f32x4){0.f, 0.f, 0.f, 0.f};
    bf16x8 At[4][2], B0[2][2], B1[2][2];
    const char* cA = (const char*)g.A + (size_t)cur.pm * tstep; const char* cB = (const char*)g.Bt + (size_t)cur.pn * tstep;
    PG8_STAGE(PG8_SB(0, 0), cB, voffB); PG8_STAGE(PG8_SA(0, 0), cA, voffA); PG8_STAGE(PG8_SB(0, 1), cB + hstep, voffB); PG8_STAGE(PG8_SA(0, 1), cA + hstep, voffA);
    if (wr == 1) PG8_BAR;
    PG8_WAIT_V(4); PG8_BAR;
    PG8_STAGE(PG8_SB(1, 0), cB + kstep, voffB); PG8_STAGE(PG8_SA(1, 0), cA + kstep, voffA); PG8_STAGE(PG8_SB(1, 1), cB + hstep + kstep, voffB);
    PG8_WAIT_V(6); PG8_BAR;
    for (;;) {
        const bool has_next = S.next(ui + 1, nxt);
        const char* nA = has_next ? (const char*)g.A + (size_t)nxt.pm * tstep : cA; const char* nB = has_next ? (const char*)g.Bt + (size_t)nxt.pn * tstep : cB;
        for (int t = 0; t < nt; t += 2) {
            const bool last = (t == nt - 2);
            const char* a1 = cA + (size_t)(t + 1) * kstep;
            const char* a2 = last ? nA : cA + (size_t)(t + 2) * kstep; const char* b2 = last ? nB : cB + (size_t)(t + 2) * kstep;
            const char* a3 = a2 + kstep; const char* b3 = b2 + kstep;
            PG8_LDB(B0, 0, 0); PG8_SCHED; PG8_LDA(At, 0, 0); PG8_STAGE(PG8_SA(1, 1), a1 + hstep, voffA);
            PG8_WAIT_L(8); PG8_BAR; PG8_WAIT_L(0); PG8_MMA(0, 0, At, B0); PG8_BAR; PG8_SCHED;
            PG8_LDB(B1, 0, 1); PG8_STAGE(PG8_SB(0, 0), b2, voffB);
            PG8_BAR; PG8_WAIT_L(0); PG8_MMA(0, 1, At, B1); PG8_BAR;
            PG8_LDA(At, 0, 1); PG8_STAGE(PG8_SA(0, 0), a2, voffA);
            PG8_BAR; PG8_WAIT_L(0); PG8_MMA(1, 0, At, B0); PG8_BAR; PG8_SCHED;
            PG8_STAGE(PG8_SB(0, 1), b2 + hstep, voffB);
            PG8_WAIT_V(6); PG8_BAR; PG8_MMA(1, 1, At, B1); PG8_BAR;
            PG8_LDB(B0, 1, 0); PG8_SCHED; PG8_LDA(At, 1, 0); PG8_STAGE(PG8_SA(0, 1), a2 + hstep, voffA);
            PG8_WAIT_L(8); PG8_BAR; PG8_WAIT_L(0); PG8_MMA(0, 0, At, B0); PG8_BAR; PG8_SCHED;
            PG8_LDB(B1, 1, 1); PG8_STAGE(PG8_SB(1, 0), b3, voffB);
            PG8_BAR; PG8_WAIT_L(0); PG8_MMA(0, 1, At, B1); PG8_BAR;
            PG8_LDA(At, 1, 1); PG8_STAGE(PG8_SA(1, 0), a3, voffA);
            PG8_BAR; PG8_WAIT_L(0); PG8_MMA(1, 0, At, B0); PG8_BAR; PG8_SCHED;
            PG8_STAGE(PG8_SB(1, 1), b3 + hstep, voffB);
            PG8_WAIT_V(6); PG8_BAR; PG8_MMA(1, 1, At, B1); PG8_BAR;
        }
        E(acc, cur, wr, wc, fr, fq);
        if (!has_next) break;
#pragma unroll
        for (int a = 0; a < 2; ++a)
#pragma unroll
            for (int b = 0; b < 2; ++b)
#pragma unroll
                for (int m = 0; m < 4; ++m)
#pragma unroll
                    for (int n = 0; n < 2; ++n) acc[a][b][m][n] = (f32x4){0.f, 0.f, 0.f, 0.f};
        cur = nxt; cA = nA; cB = nB; ++ui;
    }
    PG8_WAIT_V(0);
    if (wr == 0) PG8_BAR;
    PG8_BAR;
#undef PG8_SA
#undef PG8_SB
#undef PG8_STAGE
#undef PG8_LDA
#undef PG8_LDB
#undef PG8_MMA
#undef PG8_WAIT_V
#undef PG8_WAIT_L
#undef PG8_BAR
#undef PG8_SCHED
}
}

__device__ __forceinline__ int perm32i(int rho) { const int n = rho >> 4, i = rho & 15; return 8 * (i >> 2) + 4 * n + (i & 3); }
__device__ __forceinline__ int gperm(int c) { return (c & ~31) + perm32i(c & 31); }
__device__ __forceinline__ int rperm(int c) { const int w = (c >> 5) & 1, n = (c >> 4) & 1, i = c & 15; return (c & ~63) + 16 * w + i + 32 * n; }
__device__ __forceinline__ int src_col(int mode, int c) {
    switch (mode) {
        case 0: return c < 2048 ? rperm(c) : gperm(c);
        case 1: { if (c < 2048) return 3072 + gperm(c); if (c < 5120) return 5120 + gperm(c - 2048); const int t = gperm(c - 5120); return t < 32 ? 8192 + t : -1; }
        case 2: return 8224 + gperm(c);
        case 6: { const int pn = c >> 8, bj = (c >> 7) & 1, r = c & 127; return bj * 2816 + 128 * pn + gperm(r); }
        default: return gperm(c);
    }
}

__device__ __forceinline__ int batch_of(int r) { return r < MP ? (r >> 11) : 32 + ((r - MP) >> 6); }

template <int MODE> struct Epi {
    const Params& p;
    __device__ __forceinline__ void operator()(const f32x4 (&acc)[2][2][4][2], const pg8::Unit& u, int wr_, int wc_, int fr_, int fq_) const {
        int wr = wr_, wc = wc_, fr = fr_, fq = fq_;
        asm volatile("" : "+s"(wr), "+s"(wc), "+v"(fr), "+v"(fq));
        const int pn = u.pn;
#pragma unroll
        for (int ai = 0; ai < 2; ++ai)
#pragma unroll
            for (int m = 0; m < 4; ++m) {
                if ((MODE == 3 || MODE == 4) ? (m == 0) : ((m & 1) == 0)) __builtin_amdgcn_sched_barrier(0);
                const int r = u.pm * 256 + ai * 128 + wr * 64 + m * 16 + fr;
                const bool samp = r >= MP; const int rs = r - MP;
                if constexpr (MODE == 0) {
                    const int type = pn >> 2, colbase = (pn & 3) * 256;
                    if (type < 2) {
                        const int pos = samp ? 1024 + (rs & 63) : (r & 2047);
                        const int dlo = 16 * (wc & 1) + 4 * fq;
                        f32x4 cv, sv;
#pragma unroll
                        for (int j = 0; j < 4; ++j) {
                            const float frq = fexp2((float)(dlo + j) * (-13.287712379549449f / 32.0f)) * 0.15915494309189535f;
                            const float rev = __builtin_amdgcn_fractf((float)pos * frq);
                            cv[j] = __builtin_amdgcn_cosf(rev); sv[j] = __builtin_amdgcn_sinf(rev);
                        }
#pragma unroll
                        for (int bj = 0; bj < 2; ++bj) {
                            const int col = colbase + 64 * (2 * bj + (wc >> 1)) + dlo;
                            const f32x4 x1 = acc[ai][bj][m][0], x2 = acc[ai][bj][m][1];
                            f32x4 o1 = x1 * cv - x2 * sv, o2 = x2 * cv + x1 * sv;
                            if (type == 0) {
                                const float qs = 0.125f * LOG2E; o1 *= qs; o2 *= qs;
                                bf16_t* q = p.qbuf() + (size_t)r * 1024 + col;
                                *(u32x2*)q = pack4(o1); *(u32x2*)(q + 32) = pack4(o2);
                            } else {
                                float* ko = (samp ? p.nk_s() + (size_t)rs * 1024 : p.nk_p() + (size_t)r * 1024) + col;
                                *(f32x4*)ko = o1; *(f32x4*)(ko + 32) = o2;
                                bf16_t* kb = (samp ? p.kbuf_s() + (size_t)rs * 1024 : p.kbuf_p() + (size_t)r * 1024) + col;
                                *(u32x2*)kb = pack4(o1); *(u32x2*)(kb + 32) = pack4(o2);
                            }
                        }
                    } else {
#pragma unroll
                        for (int bj = 0; bj < 2; ++bj) {
                            const int col = colbase + 128 * bj + 32 * wc + 8 * fq;
                            float* vo = (samp ? p.nv_s() + (size_t)rs * 1024 : p.nv_p() + (size_t)r * 1024) + col;
                            *(f32x4*)vo = acc[ai][bj][m][0]; *(f32x4*)(vo + 4) = acc[ai][bj][m][1];
                            bf16_t* vb = (samp ? p.vbuf_s() + (size_t)rs * 1024 : p.vbuf_p() + (size_t)r * 1024) + col;
                            *(u32x4*)vb = pack8(acc[ai][bj][m][0], acc[ai][bj][m][1]);
                        }
                    }
                } else if constexpr (MODE == 1) {
                    if (pn < 8) {
#pragma unroll
                        for (int bj = 0; bj < 2; ++bj) { const int col = pn * 256 + 128 * bj + 32 * wc + 8 * fq; *(u32x4*)(p.zbuf() + (size_t)r * 2048 + col) = pack8(acc[ai][bj][m][0], acc[ai][bj][m][1]); }
                    } else if (pn < 20) {
                        const int tt = samp ? (rs & 63) - 61 : (r & 2047) - 2045;
#pragma unroll
                        for (int bj = 0; bj < 2; ++bj) {
                            const int col = (pn - 8) * 256 + 128 * bj + 32 * wc + 8 * fq;
                            const u32x4 xw = pack8(acc[ai][bj][m][0], acc[ai][bj][m][1]);
                            *(u32x4*)(p.xbcbuf() + (size_t)r * 3072 + col) = xw;
                            if ((r & 63) >= 61) *(u32x4*)(p.halo() + ((size_t)(r >> 6) * 3 + ((r & 63) - 61)) * 3072 + col) = xw;
                            if (tt >= 0) { float* co = (samp ? p.nconv_s() + ((size_t)(rs >> 6) * 3 + tt) * 3072 : p.nconv_p() + ((size_t)(r >> 11) * 3 + tt) * 3072) + col; *(f32x4*)co = acc[ai][bj][m][0]; *(f32x4*)(co + 4) = acc[ai][bj][m][1]; }
                        }
                    } else {
                        if (wc == 0) { float* d = p.dtbuf() + (size_t)r * 32 + 8 * fq; *(f32x4*)d = acc[ai][0][m][0]; *(f32x4*)(d + 4) = acc[ai][0][m][1]; }
                    }
                } else if constexpr (MODE == 2) {
#pragma unroll
                    for (int bj = 0; bj < 2; ++bj) {
                        const int col = pn * 256 + 128 * bj + 32 * wc + 8 * fq; f32x4 a = acc[ai][bj][m][0], b = acc[ai][bj][m][1];
#pragma unroll
                        for (int j = 0; j < 4; ++j) { a[j] = sigmoidf_(a[j]); b[j] = sigmoidf_(b[j]); }
                        *(u32x4*)(p.gbuf() + (size_t)r * 2048 + col) = pack8(a, b);
                    }
                } else if constexpr (MODE == 3 || MODE == 4) {
#pragma unroll
                    for (int bj = 0; bj < 2; ++bj) {
                        const int col = pn * 256 + 128 * bj + 32 * wc + 8 * fq;
                        const u32x4 g = *(const u32x4*)(p.gbuf() + (size_t)r * 2048 + (MODE == 4 ? 1024 : 0) + col);
                        f32x4 a = acc[ai][bj][m][0], b = acc[ai][bj][m][1];
                        a[0] *= bf_lo(g.x); a[1] *= bf_hi(g.x); a[2] *= bf_lo(g.y); a[3] *= bf_hi(g.y); b[0] *= bf_lo(g.z); b[1] *= bf_hi(g.z); b[2] *= bf_lo(g.w); b[3] *= bf_hi(g.w);
                        bf16_t* mp = p.mbuf() + (size_t)r * 1024 + col;
                        if constexpr (MODE == 4) { const u32x4 o = *(const u32x4*)mp; a[0] += bf_lo(o.x); a[1] += bf_hi(o.x); a[2] += bf_lo(o.y); a[3] += bf_hi(o.y); b[0] += bf_lo(o.z); b[1] += bf_hi(o.z); b[2] += bf_lo(o.w); b[3] += bf_hi(o.w); }
                        *(u32x4*)mp = pack8(a, b);
                    }
                } else if constexpr (MODE == 5 || MODE == 7) {
                    const int bidx = u.pm < 256 ? (u.pm >> 3) : 32 + (u.pm - 256) * 4 + 2 * ai + wr;
                    const float* mrow = p.mod() + (size_t)bidx * 6144 + (MODE == 5 ? 2048 : 5120);
#pragma unroll
                    for (int bj = 0; bj < 2; ++bj) {
                        const int col = pn * 256 + 128 * bj + 32 * wc + 8 * fq;
                        const float* xin = MODE == 5 ? ((samp ? p.x_s + (size_t)rs * 1024 : p.x_p + (size_t)r * 1024) + col) : (p.y() + (size_t)r * 1024 + col);
                        const f32x4 x0 = *(const f32x4*)xin, x1 = *(const f32x4*)(xin + 4), g0 = *(const f32x4*)(mrow + col), g1 = *(const f32x4*)(mrow + col + 4);
                        float* yo = p.y() + (size_t)r * 1024 + col;
                        *(f32x4*)yo = x0 + g0 * acc[ai][bj][m][0]; *(f32x4*)(yo + 4) = x1 + g1 * acc[ai][bj][m][1];
                    }
                } else if constexpr (MODE == 6) {
                    const int col = pn * 128 + 32 * wc + 8 * fq; f32x4 a = acc[ai][0][m][0], b = acc[ai][0][m][1];
#pragma unroll
                    for (int j = 0; j < 4; ++j) { a[j] = siluf_(a[j]) * acc[ai][1][m][0][j]; b[j] = siluf_(b[j]) * acc[ai][1][m][1][j]; }
                    *(u32x4*)(p.swbuf() + (size_t)r * 2816 + col) = pack8(a, b);
                }
            }
    }
};

template <int MODE> __device__ __forceinline__ void run_gemm(const Params& p, LAS unsigned char* lds, const bf16_t* A, const bf16_t* Bt, int N, int K, int wv) {
    pg8::Gemm g{A, Bt, MT, N, K}; pg8::StaticOrder S; S.init(MT, N, (int)gridDim.x, (int)blockIdx.x); Epi<MODE> E{p};
    pg8::gemm_phase<Epi<MODE>>(lds, g, S, E, wv);
}

__device__ __forceinline__ float wave_sum(float v) {
#pragma unroll
    for (int o = 32; o >= 1; o >>= 1) v += __shfl_xor(v, o);
    return v;
}

__device__ void prep_phase(const Params& p, LAS unsigned char* lds, int wv) {
    const int tid = opaque_tid(wv);
    {
        LAS float* tiles = (LAS float*)lds;
        const int ntiles[8] = {48 * 16, 84 * 16, 32 * 16, 16 * 16, 16 * 32, 16 * 16, 88 * 16, 16 * 44};
        int total = 0;
#pragma unroll
        for (int j = 0; j < 8; ++j) total += ntiles[j];
        for (int G = blockIdx.x; 4 * G < total; G += gridDim.x) {
            const float* W[4]; int ldw[4], K[4], n0[4], k0[4], job[4]; bf16_t* Bt[4];
#pragma unroll
            for (int u = 0; u < 4; ++u) {
                int j = 0, lt = 4 * G + u; if (lt >= total) lt = total - 1;
#pragma unroll
                for (int q = 0; q < 7; ++q) if (j == q && lt >= ntiles[q]) { lt -= ntiles[q]; j = q + 1; }
                switch (j) {
                    case 0: W[u] = p.w_in; ldw[u] = 10272; K[u] = 1024; Bt[u] = p.bt1a(); break;
                    case 1: W[u] = p.w_in; ldw[u] = 10272; K[u] = 1024; Bt[u] = p.bt1b(); break;
                    case 2: W[u] = p.w_in; ldw[u] = 10272; K[u] = 1024; Bt[u] = p.bt1c(); break;
                    case 3: W[u] = p.w_pa; ldw[u] = 1024; K[u] = 1024; Bt[u] = p.btpa(); break;
                    case 4: W[u] = p.w_pb; ldw[u] = 1024; K[u] = 2048; Bt[u] = p.btpb(); break;
                    case 5: W[u] = p.w_out; ldw[u] = 1024; K[u] = 1024; Bt[u] = p.btout(); break;
                    case 6: W[u] = p.w_gu; ldw[u] = 5632; K[u] = 1024; Bt[u] = p.btgu(); break;
                    default: W[u] = p.w_down; ldw[u] = 1024; K[u] = 2816; Bt[u] = p.btdown(); break;
                }
                const int nkt = K[u] >> 6; n0[u] = (lt / nkt) * 64; k0[u] = (lt % nkt) * 64; job[u] = j;
            }
            float v[4][8];
            const int col = tid & 63, kr = tid >> 6;
#pragma unroll
            for (int u = 0; u < 4; ++u) {
                const int sc = src_col(job[u], n0[u] + col);
#pragma unroll
                for (int jj = 0; jj < 8; ++jj) { const int k = kr + 8 * jj; v[u][jj] = sc >= 0 ? W[u][(size_t)(k0[u] + k) * ldw[u] + sc] : 0.f; }
            }
#pragma unroll
            for (int u = 0; u < 4; ++u)
#pragma unroll
                for (int jj = 0; jj < 8; ++jj) { const int k = kr + 8 * jj; float x = v[u][jj]; if (job[u] == 4) x *= p.g_ssd[k0[u] + k]; tiles[u * 64 * 65 + k * 65 + col] = x; }
            __syncthreads();
            {
                const int kk = (tid & 31) * 2, nr = tid >> 5;
#pragma unroll
                for (int u = 0; u < 4; ++u)
#pragma unroll
                    for (int jj = 0; jj < 4; ++jj) { const int n = nr + 16 * jj; *(unsigned*)(Bt[u] + (size_t)(n0[u] + n) * K[u] + k0[u] + kk) = cvt_pk_bf16(tiles[u * 64 * 65 + kk * 65 + n], tiles[u * 64 * 65 + (kk + 1) * 65 + n]); }
            }
            __syncthreads();
        }
    }
    {
        LAS float* sc = (LAS float*)lds;
        LAS float* wt = (LAS float*)(lds + 64 * 129 * 4);
        for (int cbk = blockIdx.x; cbk < 256; cbk += gridDim.x) {
            const int col0 = cbk * 24, row = tid & 63, cgp = tid >> 6;
            float a0 = 0.f, a1 = 0.f, a2 = 0.f;
            for (int kc = 0; kc < 8; ++kc) {
                const int k0 = kc * 128;
                __syncthreads();
#pragma unroll
                for (int i = 0; i < 16; ++i) { const int idx = tid + 512 * i, r = idx >> 7, k = idx & 127; const float v = r < 32 ? p.c_p[r * 1024 + k0 + k] : p.c_s[(r - 32) * 1024 + k0 + k]; sc[r * 129 + k] = siluf_(v); }
#pragma unroll
                for (int i = 0; i < 6; ++i) { const int idx = tid + 512 * i, k = idx / 24, c = idx % 24; wt[idx] = p.w_ada[(size_t)(k0 + k) * 6144 + col0 + c]; }
                __syncthreads();
#pragma unroll 8
                for (int k = 0; k < 128; ++k) { const float a = sc[row * 129 + k]; a0 += a * wt[k * 24 + 3 * cgp]; a1 += a * wt[k * 24 + 3 * cgp + 1]; a2 += a * wt[k * 24 + 3 * cgp + 2]; }
            }
            const int c = col0 + 3 * cgp;
            p.mod()[row * 6144 + c] = a0 + p.b_ada[c]; p.mod()[row * 6144 + c + 1] = a1 + p.b_ada[c + 1]; p.mod()[row * 6144 + c + 2] = a2 + p.b_ada[c + 2];
        }
        __syncthreads();
    }
    const size_t gtid = (size_t)blockIdx.x * 512 + tid, gsz = (size_t)gridDim.x * 512;
}

template <int MODE> __device__ void norm_phase(const Params& p, int wv) {
    const int tid = opaque_tid(wv); const int w = tid >> 6, lane = tid & 63;
    const float* g = MODE == 0 ? p.g_mix : (MODE == 1 ? p.g_ffn : p.g_final);
    const int stride = gridDim.x * 8;
    for (int r0 = blockIdx.x * 8 + w; r0 < MT; r0 += 2 * stride) {
        f32x4 v[2][4]; float ss[2] = {0.f, 0.f}; int rr[2];
#pragma unroll
        for (int q = 0; q < 2; ++q) {
            const int r = r0 + q * stride; rr[q] = r < MT ? r : r0;
            const float* src = MODE == 0 ? (rr[q] < MP ? p.x_p + (size_t)rr[q] * 1024 : p.x_s + (size_t)(rr[q] - MP) * 1024) : p.y() + (size_t)rr[q] * 1024;
#pragma unroll
            for (int j = 0; j < 4; ++j) v[q][j] = *(const f32x4*)(src + 256 * j + 4 * lane);
        }
#pragma unroll
        for (int q = 0; q < 2; ++q) {
#pragma unroll
            for (int j = 0; j < 4; ++j) ss[q] += v[q][j][0] * v[q][j][0] + v[q][j][1] * v[q][j][1] + v[q][j][2] * v[q][j][2] + v[q][j][3] * v[q][j][3];
            ss[q] = wave_sum(ss[q]);
        }
#pragma unroll
        for (int q = 0; q < 2; ++q) {
            if (q == 1 && r0 + stride >= MT) continue;
            const int r = rr[q];
            const float rsn = rsqrtf(ss[q] * (1.0f / 1024.0f) + EPSN);
            const float* mrow = p.mod() + (size_t)batch_of(r) * 6144 + (MODE == 0 ? 0 : 3072);
#pragma unroll
            for (int j = 0; j < 4; ++j) {
                const int c = 256 * j + 4 * lane; const f32x4 gg = *(const f32x4*)(g + c); f32x4 o = v[q][j] * rsn * gg;
                if constexpr (MODE == 2) { *(f32x4*)(p.y() + (size_t)r * 1024 + c) = o; }
                else { const f32x4 sh = *(const f32x4*)(mrow + c), scl = *(const f32x4*)(mrow + 1024 + c); o = o * (1.0f + scl) + sh; *(u32x2*)((MODE == 0 ? p.hA() : p.h2()) + (size_t)r * 1024 + c) = pack4(o); }
            }
        }
    }
}

__device__ void ssdnorm_phase(const Params& p, int wv) {
    const size_t gtid = (size_t)blockIdx.x * 512 + opaque_tid(wv), gsz = (size_t)gridDim.x * 512, total = (size_t)MT * 256;
    for (size_t i0 = gtid; i0 < total; i0 += 4 * gsz) {
        u32x4 u[4]; float rsn[4]; bf16_t* ptr[4];
#pragma unroll
        for (int q = 0; q < 4; ++q) {
            const size_t i = i0 + (size_t)q * gsz; const size_t ic = i < total ? i : i0;
            const size_t r = ic >> 8; const int e8 = (int)(ic & 255), gq = e8 >> 6;
            const float ss = p.ssbuf()[r * 8 + 2 * gq] + p.ssbuf()[r * 8 + 2 * gq + 1];
            rsn[q] = rsqrtf(ss * (1.0f / 512.0f) + EPSN);
            ptr[q] = p.zbuf() + r * 2048 + e8 * 8; u[q] = *(const u32x4*)ptr[q];
        }
#pragma unroll
        for (int q = 0; q < 4; ++q) {
            const size_t i = i0 + (size_t)q * gsz; if (i >= total) continue;
            u32x4 o; const float rs = rsn[q];
            o.x = cvt_pk_bf16(bf_lo(u[q].x) * rs, bf_hi(u[q].x) * rs); o.y = cvt_pk_bf16(bf_lo(u[q].y) * rs, bf_hi(u[q].y) * rs); o.z = cvt_pk_bf16(bf_lo(u[q].z) * rs, bf_hi(u[q].z) * rs); o.w = cvt_pk_bf16(bf_lo(u[q].w) * rs, bf_hi(u[q].w) * rs);
            *(u32x4*)ptr[q] = o;
        }
    }
}

constexpr int AT_K = 9216, AT_V = 20480, AT_STAGE = 2 * AT_K + AT_V;
template <bool PAST> __device__ __forceinline__ void attn_item(const Params& p, LAS unsigned char* lds, int row0, int h, const bf16_t* Kb, const bf16_t* Vb, const float* Kc, const float* Vc, int nt0, int nt1, float lam, int wv) {
    const int tid = opaque_tid(wv), w = __builtin_amdgcn_readfirstlane(tid >> 6), lane = tid & 63, l31 = lane & 31, hh = lane >> 5;
    const int hd = w >> 2, rb = w & 3, chunk = rb >> 1;
    const int ntl = nt0 > nt1 ? nt0 : nt1, my_nt = chunk ? nt1 : nt0;
    const int coff = 128 * h;
    bf16x8 qf[4];
    {
        const bf16_t* qp = p.qbuf() + (size_t)(row0 + rb * 32 + l31) * 1024 + coff + 64 * hd + 8 * hh;
#pragma unroll
        for (int s = 0; s < 4; ++s) qf[s] = my_nt > 0 ? *(const bf16x8*)(qp + 16 * s) : (bf16x8){0, 0, 0, 0, 0, 0, 0, 0};
    }
    f32x16 O[4];
#pragma unroll
    for (int c = 0; c < 4; ++c)
#pragma unroll
        for (int e = 0; e < 16; ++e) O[c][e] = 0.f;
    float m_run = -1e30f, l_run = 0.f;
    u32x4 kreg[2], vreg[2];
    f32x4 kf[PAST ? 2 : 1][2], vf[PAST ? 2 : 1][2];
    auto gload = [&](int t) {
        if (PAST && t < 16) {
            const int key0 = 64 * t;
#pragma unroll
            for (int jj = 0; jj < 2; ++jj) {
                const int idx = tid + 512 * jj;
                { const int which = idx >> 9, row = (idx >> 3) & 63, ch = idx & 7; const float* sp = Kc + (size_t)(key0 + row) * 1024 + coff + 64 * which + 8 * ch; kf[PAST ? jj : 0][0] = *(const f32x4*)sp; kf[PAST ? jj : 0][1] = *(const f32x4*)(sp + 4); }
                { const int row = idx >> 4, ch = idx & 15; const float* sp = Vc + (size_t)(key0 + row) * 1024 + coff + 8 * ch; vf[PAST ? jj : 0][0] = *(const f32x4*)sp; vf[PAST ? jj : 0][1] = *(const f32x4*)(sp + 4); }
            }
        } else {
            const int key0 = PAST ? 0 : 64 * t;
#pragma unroll
            for (int jj = 0; jj < 2; ++jj) {
                const int idx = tid + 512 * jj;
                { const int which = idx >> 9, row = (idx >> 3) & 63, ch = idx & 7; kreg[jj] = *(const u32x4*)(Kb + (size_t)(key0 + row) * 1024 + coff + 64 * which + 8 * ch); }
                { const int row = idx >> 4, ch = idx & 15; vreg[jj] = *(const u32x4*)(Vb + (size_t)(key0 + row) * 1024 + coff + 8 * ch); }
            }
        }
    };
    auto swrite = [&](int st, int t) {
        LAS unsigned char* base = lds + st * AT_STAGE;
        if (PAST && t < 16) {
#pragma unroll
            for (int jj = 0; jj < 2; ++jj) { kreg[jj] = pack8(kf[PAST ? jj : 0][0], kf[PAST ? jj : 0][1]); vreg[jj] = pack8(vf[PAST ? jj : 0][0], vf[PAST ? jj : 0][1]); }
        }
#pragma unroll
        for (int jj = 0; jj < 2; ++jj) {
            const int idx = tid + 512 * jj;
            { const int which = idx >> 9, row = (idx >> 3) & 63, ch = idx & 7; *(LAS u32x4*)(base + which * AT_K + row * 144 + ch * 16) = kreg[jj]; }
            { const int row = idx >> 4, ch = idx & 15; *(LAS u32x4*)(base + 2 * AT_K + row * 320 + ch * 16) = vreg[jj]; }
        }
    };
    const int q4 = (lane & 15) >> 2, blk = (lane >> 4) & 1, pp = lane & 3;
    auto qk = [&](int st, f32x16 (&S)[2]) {
        LAS unsigned char* Kt = lds + st * AT_STAGE + hd * AT_K + l31 * 144 + hh * 16;
#pragma unroll
        for (int kb = 0; kb < 2; ++kb) {
#pragma unroll
            for (int e = 0; e < 16; ++e) S[kb][e] = 0.f;
#pragma unroll
            for (int s = 0; s < 4; ++s) { const bf16x8 a = *(const LAS bf16x8*)(Kt + kb * 32 * 144 + s * 32); S[kb] = __builtin_amdgcn_mfma_f32_32x32x16_bf16(a, qf[s], S[kb], 0, 0, 0); }
        }
    };
    auto smpv = [&](int st, f32x16 (&S)[2]) {
        LAS unsigned char* Vt = lds + st * AT_STAGE + 2 * AT_K + (4 * hh + q4) * 320 + (16 * blk + 4 * pp) * 2;
        float mx = S[0][0];
#pragma unroll
        for (int e = 1; e < 16; ++e) mx = fmaxf(mx, S[0][e]);
#pragma unroll
        for (int e = 0; e < 16; ++e) mx = fmaxf(mx, S[1][e]);
        mx = fmaxf(mx, __shfl_xor(mx, 32));
        const float mn = fmaxf(m_run, mx), alpha = fexp2(m_run - mn); m_run = mn;
        float rsum = 0.f;
#pragma unroll
        for (int kb = 0; kb < 2; ++kb)
#pragma unroll
            for (int e = 0; e < 16; ++e) { const float pv = fexp2(S[kb][e] - mn); S[kb][e] = pv; rsum += pv; }
        l_run = l_run * alpha + rsum;
        if (__builtin_amdgcn_ballot_w64(alpha != 1.0f) != 0ull) {
#pragma unroll
            for (int c = 0; c < 4; ++c)
#pragma unroll
                for (int e = 0; e < 16; ++e) O[c][e] *= alpha;
        }
#pragma unroll
        for (int kb = 0; kb < 2; ++kb)
#pragma unroll
            for (int sp = 0; sp < 2; ++sp) {
                union { u32x4 u; bf16x8 v; } pb;
                pb.u.x = cvt_pk_bf16(S[kb][8 * sp + 0], S[kb][8 * sp + 1]); pb.u.y = cvt_pk_bf16(S[kb][8 * sp + 2], S[kb][8 * sp + 3]);
                pb.u.z = cvt_pk_bf16(S[kb][8 * sp + 4], S[kb][8 * sp + 5]); pb.u.w = cvt_pk_bf16(S[kb][8 * sp + 6], S[kb][8 * sp + 7]);
#pragma unroll
                for (int c = 0; c < 4; ++c) {
                    LAS unsigned char* va = Vt + (32 * kb + 16 * sp) * 320 + 64 * c;
                    const s16x4 v0 = __builtin_amdgcn_ds_read_tr16_b64_v4i16((LAS s16x4*)va);
                    const s16x4 v1 = __builtin_amdgcn_ds_read_tr16_b64_v4i16((LAS s16x4*)(va + 8 * 320));
                    const bf16x8 vfr = {v0[0], v0[1], v0[2], v0[3], v1[0], v1[1], v1[2], v1[3]};
                    O[c] = __builtin_amdgcn_mfma_f32_32x32x16_bf16(vfr, pb.v, O[c], 0, 0, 0);
                }
            }
    };
    if constexpr (PAST) {
        gload(0); swrite(0, 0); __syncthreads();
        for (int t = 0; t < ntl; ++t) {
            if (t + 1 < ntl) gload(t + 1);
            if (t < my_nt) { f32x16 S[2]; qk(t & 1, S); smpv(t & 1, S); }
            if (t + 1 < ntl) swrite((t + 1) & 1, t + 1);
            __syncthreads();
        }
    } else {
        gload(0); swrite(0, 0); if (ntl > 1) gload(1);
        __syncthreads();
        f32x16 Sn[2];
        if (my_nt > 0) qk(0, Sn);
        int st = 0;
        for (int t = 0; t < ntl; ++t) {
            const int st1 = st == 2 ? 0 : st + 1;
            f32x16 Sc[2]; Sc[0] = Sn[0]; Sc[1] = Sn[1];
            if (t + 1 < ntl) swrite(st1, t + 1);
            if (t + 2 < ntl) gload(t + 2);
            __syncthreads();
            if (t + 1 < my_nt) { qk(st1, Sn); smpv(st, Sc); }
            else if (t < my_nt) { smpv(st, Sc); }
            st = st1;
        }
        __syncthreads();
    }
    const float lt = l_run + __shfl_xor(l_run, 32);
    const float inv = my_nt > 0 ? 1.0f / lt : 0.f;
    LAS float* X = (LAS float*)lds;
    if (hd == 1) {
#pragma unroll
        for (int c = 0; c < 4; ++c)
#pragma unroll
            for (int i = 0; i < 4; ++i) { f32x4 o = {O[c][4 * i] * inv, O[c][4 * i + 1] * inv, O[c][4 * i + 2] * inv, O[c][4 * i + 3] * inv}; *(LAS f32x4*)(X + (rb * 32 + l31) * 132 + 32 * c + 8 * i + 4 * hh) = o; }
    }
    __syncthreads();
    if (hd == 0 && my_nt > 0) {
        float ss = 0.f;
#pragma unroll
        for (int c = 0; c < 4; ++c)
#pragma unroll
            for (int i = 0; i < 4; ++i) {
                const f32x4 o2 = *(const LAS f32x4*)(X + (rb * 32 + l31) * 132 + 32 * c + 8 * i + 4 * hh);
#pragma unroll
                for (int j = 0; j < 4; ++j) { const float o = O[c][4 * i + j] * inv - lam * o2[j]; O[c][4 * i + j] = o; ss += o * o; }
            }
        ss += __shfl_xor(ss, 32);
        const float rsn = rsqrtf(ss * (1.0f / 128.0f) + EPSN) * 0.8f;
        bf16_t* op = p.qbuf() + (size_t)(row0 + rb * 32 + l31) * 1024 + coff + 4 * hh;
#pragma unroll
        for (int c = 0; c < 4; ++c)
#pragma unroll
            for (int i = 0; i < 4; ++i) {
                const f32x4 g = *(const f32x4*)(p.g_subln + 32 * c + 8 * i + 4 * hh);
                const f32x4 o = {O[c][4 * i] * rsn * g[0], O[c][4 * i + 1] * rsn * g[1], O[c][4 * i + 2] * rsn * g[2], O[c][4 * i + 3] * rsn * g[3]};
                *(u32x2*)(op + 32 * c + 8 * i) = pack4(o);
            }
    }
    __syncthreads();
}

__device__ void attn_phase(const Params& p, LAS unsigned char* lds, int wv) {
    const int lane = opaque_tid(wv) & 63;
    const float a1 = wave_sum(p.lq1[lane] * p.lk1[lane]), a2 = wave_sum(p.lq2[lane] * p.lk2[lane]);
    const float lamv = __expf(a1) - __expf(a2) + 0.2f;
    const float lam = __builtin_bit_cast(float, __builtin_amdgcn_readfirstlane(__builtin_bit_cast(int, lamv)));
    for (int j = blockIdx.x; j < 256; j += gridDim.x) {
        const int b = j >> 3, h = j & 7;
#pragma unroll 1
        for (int i = 15; i >= 0; --i) attn_item<false>(p, lds, b * 2048 + 128 * i, h, p.kbuf_p() + (size_t)b * 2048 * 1024, p.vbuf_p() + (size_t)b * 2048 * 1024, nullptr, nullptr, 2 * i + 1, 2 * i + 2, lam, wv);
        attn_item<true>(p, lds, MP + 64 * b, h, p.kbuf_s() + (size_t)b * 64 * 1024, p.vbuf_s() + (size_t)b * 64 * 1024, p.cache_k + (size_t)b * 1024 * 1024, p.cache_v + (size_t)b * 1024 * 1024, 17, 0, lam, wv);
    }
}

__device__ void conv_phase(const Params& p, int wv) {
    const size_t gtid = (size_t)blockIdx.x * 512 + opaque_tid(wv), gsz = (size_t)gridDim.x * 512, total = (size_t)(MT / 64) * 384;
    for (size_t it = gtid; it < total; it += gsz) {
        const int cg = (int)(it / 384), sp = (int)(it % 384), col = sp * 8;
        f32x4 wv4[4][2], bias[2];
#pragma unroll
        for (int j = 0; j < 4; ++j) { wv4[j][0] = *(const f32x4*)(p.conv_w + j * 3072 + col); wv4[j][1] = *(const f32x4*)(p.conv_w + j * 3072 + col + 4); }
        bias[0] = *(const f32x4*)(p.conv_b + col); bias[1] = *(const f32x4*)(p.conv_b + col + 4);
        f32x4 win[3][2];
        const bool samp = cg >= MP / 64;
        if (samp) {
            const float* sc = p.state_conv + (size_t)(cg - MP / 64) * 3 * 3072 + col;
#pragma unroll
            for (int q = 0; q < 3; ++q) { win[q][0] = *(const f32x4*)(sc + q * 3072); win[q][1] = *(const f32x4*)(sc + q * 3072 + 4); }
        } else if ((cg & 31) == 0) {
#pragma unroll
            for (int q = 0; q < 3; ++q) { win[q][0] = (f32x4){0.f, 0.f, 0.f, 0.f}; win[q][1] = win[q][0]; }
        } else {
            const bf16_t* hp = p.halo() + (size_t)(cg - 1) * 3 * 3072 + col;
#pragma unroll
            for (int q = 0; q < 3; ++q) { const u32x4 u = *(const u32x4*)(hp + q * 3072); win[q][0] = (f32x4){bf_lo(u.x), bf_hi(u.x), bf_lo(u.y), bf_hi(u.y)}; win[q][1] = (f32x4){bf_lo(u.z), bf_hi(u.z), bf_lo(u.w), bf_hi(u.w)}; }
        }
        bf16_t* xp = p.xbcbuf() + (size_t)cg * 64 * 3072 + col;
#pragma unroll 1
        for (int t0 = 0; t0 < 64; t0 += 8) {
            u32x4 raw[8];
#pragma unroll
            for (int q = 0; q < 8; ++q) raw[q] = *(const u32x4*)(xp + (size_t)(t0 + q) * 3072);
#pragma unroll
            for (int q = 0; q < 8; ++q) {
                const f32x4 c0 = {bf_lo(raw[q].x), bf_hi(raw[q].x), bf_lo(raw[q].y), bf_hi(raw[q].y)}, c1 = {bf_lo(raw[q].z), bf_hi(raw[q].z), bf_lo(raw[q].w), bf_hi(raw[q].w)};
                f32x4 o0 = bias[0] + wv4[0][0] * win[0][0] + wv4[1][0] * win[1][0] + wv4[2][0] * win[2][0] + wv4[3][0] * c0;
                f32x4 o1 = bias[1] + wv4[0][1] * win[0][1] + wv4[1][1] * win[1][1] + wv4[2][1] * win[2][1] + wv4[3][1] * c1;
                win[0][0] = win[1][0]; win[0][1] = win[1][1]; win[1][0] = win[2][0]; win[1][1] = win[2][1]; win[2][0] = c0; win[2][1] = c1;
#pragma unroll
                for (int e = 0; e < 4; ++e) { o0[e] = siluf_(o0[e]); o1[e] = siluf_(o1[e]); }
                *(u32x4*)(xp + (size_t)(t0 + q) * 3072) = pack8(o0, o1);
            }
        }
    }
}

constexpr int SD_XT = 0, SD_BM = 36864, SD_BT = SD_BM + 17408, SD_CM = SD_BT + 18432, SD_CB = SD_CM + 17408, SD_CUM = SD_CB + 17408, SD_DT = SD_CUM + 1024, SD_SS = SD_DT + 1024;
__device__ void ssd_phase(const Params& p, LAS unsigned char* lds, int wv) {
    const int tid = opaque_tid(wv), w = __builtin_amdgcn_readfirstlane(tid >> 6), lane = tid & 63, l15 = lane & 15, g4 = lane >> 4;
    const int k = w >> 1, ph = w & 1;
    for (int jb = blockIdx.x; jb < 256; jb += gridDim.x) {
        const int b = jb >> 3, hq = jb & 7, grp = hq >> 1, head = 4 * hq + k;
        f32x4 Sacc[8][2];
#pragma unroll
        for (int nb = 0; nb < 8; ++nb)
#pragma unroll
            for (int pb = 0; pb < 2; ++pb) Sacc[nb][pb] = (f32x4){0.f, 0.f, 0.f, 0.f};
        const float a_h = -__expf(p.a_log[head]), dtb = p.dt_bias[head], dsk = p.d_skip[head];
        for (int step = 0; step < 33; ++step) {
            const bool samp = step == 32;
            const int row0 = samp ? MP + 64 * b : b * 2048 + 64 * step;
            if (samp) {
                float* so = p.nssm_p() + ((size_t)(b * 32 + head) * 64) * 128; const float* si = p.state_ssm + ((size_t)(b * 32 + head) * 64) * 128;
#pragma unroll
                for (int nb = 0; nb < 8; ++nb)
#pragma unroll
                    for (int pb = 0; pb < 2; ++pb) { const size_t o = (size_t)(32 * ph + 16 * pb + l15) * 128 + 16 * nb + 4 * g4; *(f32x4*)(so + o) = Sacc[nb][pb]; Sacc[nb][pb] = *(const f32x4*)(si + o); }
            }
            float dtraw = 0.f;
            if (w < 4) dtraw = p.dtbuf()[(size_t)(row0 + lane) * 32 + 4 * hq + w];
            {
                int tdx = tid; asm volatile("" : "+v"(tdx));
                const int tb = tdx & 7, cq = tdx >> 3;
                const int ccol0 = 256 * hq + 4 * cq;
                const bool isB = w < 4; const int n0 = 4 * (cq & 31);
                const int ccol1 = (isB ? 2048 : 2560) + 128 * grp + n0;
                u32x2 r0[8], r1[8];
                const bf16_t* xr0 = p.xbcbuf() + (size_t)(row0 + 8 * tb) * 3072;
#pragma unroll
                for (int tt = 0; tt < 8; ++tt) { r0[tt] = *(const u32x2*)(xr0 + (size_t)tt * 3072 + ccol0); r1[tt] = *(const u32x2*)(xr0 + (size_t)tt * 3072 + ccol1); }
                {
                    f32x4 outv[8];
#pragma unroll
                    for (int tt = 0; tt < 8; ++tt) outv[tt] = (f32x4){bf_lo(r0[tt].x), bf_hi(r0[tt].x), bf_lo(r0[tt].y), bf_hi(r0[tt].y)};
                    LAS unsigned char* base = lds + SD_XT + (cq >> 4) * 9216 + (4 * (cq & 15)) * 144 + 16 * tb;
#pragma unroll
                    for (int e = 0; e < 4; ++e) { u32x4 u; u.x = cvt_pk_bf16(outv[0][e], outv[1][e]); u.y = cvt_pk_bf16(outv[2][e], outv[3][e]); u.z = cvt_pk_bf16(outv[4][e], outv[5][e]); u.w = cvt_pk_bf16(outv[6][e], outv[7][e]); *(LAS u32x4*)(base + e * 144) = u; }
                }
                {
                    f32x4 outv[8];
#pragma unroll
                    for (int tt = 0; tt < 8; ++tt) outv[tt] = (f32x4){bf_lo(r1[tt].x), bf_hi(r1[tt].x), bf_lo(r1[tt].y), bf_hi(r1[tt].y)};
                    LAS unsigned char* rowimg = lds + (isB ? SD_BM : SD_CM);
#pragma unroll
                    for (int tt = 0; tt < 8; ++tt) *(LAS u32x2*)(rowimg + (8 * tb + tt) * 272 + n0 * 2) = r1[tt];
                    if (isB) {
#pragma unroll
                        for (int e = 0; e < 4; ++e) { u32x4 u; u.x = cvt_pk_bf16(outv[0][e], outv[1][e]); u.y = cvt_pk_bf16(outv[2][e], outv[3][e]); u.z = cvt_pk_bf16(outv[4][e], outv[5][e]); u.w = cvt_pk_bf16(outv[6][e], outv[7][e]); *(LAS u32x4*)(lds + SD_BT + (n0 + e) * 144 + 16 * tb) = u; }
                    }
                }
            }
            if (w < 4) {
                const int hd2 = 4 * hq + w;
                const float xr = dtraw + p.dt_bias[hd2];
                const float dt = xr > 20.f ? xr : log1pf(__expf(xr));
                float cum = dt * (-__expf(p.a_log[hd2]));
#pragma unroll
                for (int o = 1; o < 64; o <<= 1) { const float t2 = __shfl_up(cum, o); if (lane >= o) cum += t2; }
                ((LAS float*)(lds + SD_CUM))[w * 64 + lane] = cum; ((LAS float*)(lds + SD_DT))[w * 64 + lane] = dt;
            }
            __syncthreads();
            {
                const int lb = w >> 1;
#pragma unroll
                for (int q = 0; q < 2; ++q) {
                    const int sb = 2 * (w & 1) + q; f32x4 c4 = {0.f, 0.f, 0.f, 0.f};
#pragma unroll
                    for (int ks = 0; ks < 4; ++ks) {
                        const bf16x8 a = *(const LAS bf16x8*)(lds + SD_CM + (16 * lb + l15) * 272 + (32 * ks + 8 * g4) * 2);
                        const bf16x8 bb = *(const LAS bf16x8*)(lds + SD_BM + (16 * sb + l15) * 272 + (32 * ks + 8 * g4) * 2);
                        c4 = __builtin_amdgcn_mfma_f32_16x16x32_bf16(a, bb, c4, 0, 0, 0);
                    }
#pragma unroll
                    for (int j = 0; j < 4; ++j) ((LAS float*)(lds + SD_CB))[(16 * lb + 4 * g4 + j) * 68 + 16 * sb + l15] = c4[j];
                }
            }
            __syncthreads();
            {
                const LAS float* cumL = (const LAS float*)(lds + SD_CUM) + k * 64; const LAS float* dtL = (const LAS float*)(lds + SD_DT) + k * 64;
                const LAS unsigned char* XTk = lds + SD_XT + k * 9216;
                f32x4 yT[2][4];
#pragma unroll
                for (int pb = 0; pb < 2; ++pb)
#pragma unroll
                    for (int lb = 0; lb < 4; ++lb) yT[pb][lb] = (f32x4){0.f, 0.f, 0.f, 0.f};
#pragma unroll
                for (int ks = 0; ks < 4; ++ks) {
                    __builtin_amdgcn_sched_barrier(0);
                    union { u32x4 u; bf16x8 v; } af[2];
#pragma unroll
                    for (int pb = 0; pb < 2; ++pb) { af[pb].u.x = cvt_pk_bf16(Sacc[2 * ks][pb][0], Sacc[2 * ks][pb][1]); af[pb].u.y = cvt_pk_bf16(Sacc[2 * ks][pb][2], Sacc[2 * ks][pb][3]); af[pb].u.z = cvt_pk_bf16(Sacc[2 * ks + 1][pb][0], Sacc[2 * ks + 1][pb][1]); af[pb].u.w = cvt_pk_bf16(Sacc[2 * ks + 1][pb][2], Sacc[2 * ks + 1][pb][3]); }
#pragma unroll
                    for (int lb = 0; lb < 4; ++lb) {
                        const LAS unsigned char* cp = lds + SD_CM + (16 * lb + l15) * 272 + (32 * ks + 4 * g4) * 2;
                        union { u32x4 u; bf16x8 v; } bf; const u32x2 c0 = *(const LAS u32x2*)cp, c1 = *(const LAS u32x2*)(cp + 32);
                        bf.u.x = c0.x; bf.u.y = c0.y; bf.u.z = c1.x; bf.u.w = c1.y;
#pragma unroll
                        for (int pb = 0; pb < 2; ++pb) yT[pb][lb] = __builtin_amdgcn_mfma_f32_16x16x32_bf16(af[pb].v, bf.v, yT[pb][lb], 0, 0, 0);
                    }
                }
#pragma unroll
                for (int lb = 0; lb < 4; ++lb) { const float ec = fexp(cumL[16 * lb + l15]);
#pragma unroll
                    for (int pb = 0; pb < 2; ++pb) yT[pb][lb] *= ec; }
#pragma unroll
                for (int ks = 0; ks < 2; ++ks) {
                    __builtin_amdgcn_sched_barrier(0);
                    bf16x8 xa[2];
#pragma unroll
                    for (int pb = 0; pb < 2; ++pb) xa[pb] = *(const LAS bf16x8*)(XTk + (32 * ph + 16 * pb + l15) * 144 + (32 * ks + 8 * g4) * 2);
                    const int s0 = 32 * ks + 8 * g4;
                    const f32x4 cs0 = *(const LAS f32x4*)(cumL + s0), cs1 = *(const LAS f32x4*)(cumL + s0 + 4), ds0 = *(const LAS f32x4*)(dtL + s0), ds1 = *(const LAS f32x4*)(dtL + s0 + 4);
#pragma unroll
                    for (int lb = 0; lb < 4; ++lb) {
                        if (32 * ks > 16 * lb + 15) continue;
                        __builtin_amdgcn_sched_barrier(0);
                        const int l = 16 * lb + l15; const float cl = cumL[l];
                        const LAS float* cbp = (const LAS float*)(lds + SD_CB) + l * 68 + s0;
                        const f32x4 cb0 = *(const LAS f32x4*)cbp, cb1 = *(const LAS f32x4*)(cbp + 4);
                        float mv[8];
#pragma unroll
                        for (int e = 0; e < 4; ++e) {
                            { const int s = s0 + e; float v = s <= l ? cb0[e] * fexp(cl - cs0[e]) * ds0[e] : 0.f; if (s == l) v += dsk; mv[e] = v; }
                            { const int s = s0 + 4 + e; float v = s <= l ? cb1[e] * fexp(cl - cs1[e]) * ds1[e] : 0.f; if (s == l) v += dsk; mv[4 + e] = v; }
                        }
                        union { u32x4 u; bf16x8 v; } mf; mf.u.x = cvt_pk_bf16(mv[0], mv[1]); mf.u.y = cvt_pk_bf16(mv[2], mv[3]); mf.u.z = cvt_pk_bf16(mv[4], mv[5]); mf.u.w = cvt_pk_bf16(mv[6], mv[7]);
#pragma unroll
                        for (int pb = 0; pb < 2; ++pb) yT[pb][lb] = __builtin_amdgcn_mfma_f32_16x16x32_bf16(xa[pb], mf.v, yT[pb][lb], 0, 0, 0);
                    }
                }
                float ssl[4];
#pragma unroll
                for (int lb = 0; lb < 4; ++lb) {
                    __builtin_amdgcn_sched_barrier(0);
                    float ss = 0.f;
#pragma unroll
                    for (int pb = 0; pb < 2; ++pb) {
                        bf16_t* zp = p.zbuf() + (size_t)(row0 + 16 * lb + l15) * 2048 + 64 * head + 32 * ph + 16 * pb + 4 * g4;
                        const u32x2 zz = *(const u32x2*)zp;
                        f32x4 u = yT[pb][lb]; u[0] *= siluf_(bf_lo(zz.x)); u[1] *= siluf_(bf_hi(zz.x)); u[2] *= siluf_(bf_lo(zz.y)); u[3] *= siluf_(bf_hi(zz.y));
                        ss += u[0] * u[0] + u[1] * u[1] + u[2] * u[2] + u[3] * u[3];
                        *(u32x2*)zp = pack4(u);
                    }
                    ss += __shfl_xor(ss, 16); ss += __shfl_xor(ss, 32); ssl[lb] = ss;
                }
                if (g4 == 0) {
#pragma unroll
                    for (int lb = 0; lb < 4; ++lb) ((LAS float*)(lds + SD_SS))[w * 64 + 16 * lb + l15] = ssl[lb];
                }
                const float cend = cumL[63], dec = fexp(cend);
#pragma unroll
                for (int nb = 0; nb < 8; ++nb)
#pragma unroll
                    for (int pb = 0; pb < 2; ++pb) Sacc[nb][pb] *= dec;
#pragma unroll
                for (int ks = 0; ks < 2; ++ks) {
                    __builtin_amdgcn_sched_barrier(0);
                    const int s0 = 32 * ks + 8 * g4;
                    const f32x4 cs0 = *(const LAS f32x4*)(cumL + s0), cs1 = *(const LAS f32x4*)(cumL + s0 + 4), ds0 = *(const LAS f32x4*)(dtL + s0), ds1 = *(const LAS f32x4*)(dtL + s0 + 4);
                    float wsv[8];
#pragma unroll
                    for (int e = 0; e < 4; ++e) { wsv[e] = ds0[e] * fexp(cend - cs0[e]); wsv[4 + e] = ds1[e] * fexp(cend - cs1[e]); }
                    union { u32x4 u; bf16x8 v; } xb[2];
#pragma unroll
                    for (int pb = 0; pb < 2; ++pb) {
                        const u32x4 xr = *(const LAS u32x4*)(XTk + (32 * ph + 16 * pb + l15) * 144 + s0 * 2);
                        xb[pb].u.x = cvt_pk_bf16(bf_lo(xr.x) * wsv[0], bf_hi(xr.x) * wsv[1]); xb[pb].u.y = cvt_pk_bf16(bf_lo(xr.y) * wsv[2], bf_hi(xr.y) * wsv[3]);
                        xb[pb].u.z = cvt_pk_bf16(bf_lo(xr.z) * wsv[4], bf_hi(xr.z) * wsv[5]); xb[pb].u.w = cvt_pk_bf16(bf_lo(xr.w) * wsv[6], bf_hi(xr.w) * wsv[7]);
                    }
#pragma unroll
                    for (int nb = 0; nb < 8; ++nb) {
                        const bf16x8 ba = *(const LAS bf16x8*)(lds + SD_BT + (16 * nb + l15) * 144 + s0 * 2);
#pragma unroll
                        for (int pb = 0; pb < 2; ++pb) Sacc[nb][pb] = __builtin_amdgcn_mfma_f32_16x16x32_bf16(ba, xb[pb].v, Sacc[nb][pb], 0, 0, 0);
                    }
                }
            }
            __syncthreads();
            if (tid < 64) {
                float s = 0.f;
#pragma unroll
                for (int ww = 0; ww < 8; ++ww) s += ((const LAS float*)(lds + SD_SS))[ww * 64 + tid];
                p.ssbuf()[(size_t)(row0 + tid) * 8 + hq] = s;
            }
        }
        {
            float* so = p.nssm_s() + ((size_t)(b * 32 + head) * 64) * 128;
#pragma unroll
            for (int nb = 0; nb < 8; ++nb)
#pragma unroll
                for (int pb = 0; pb < 2; ++pb) *(f32x4*)(so + (size_t)(32 * ph + 16 * pb + l15) * 128 + 16 * nb + 4 * g4) = Sacc[nb][pb];
        }
        (void)a_h; (void)dtb;
    }
}

__device__ __forceinline__ void grid_barrier(unsigned* ctr, unsigned target, int wv) {
    asm volatile("s_waitcnt vmcnt(0) lgkmcnt(0)" ::: "memory");
    __builtin_amdgcn_s_barrier();
    if (wv == 0) {
        unsigned z = 0u; asm volatile("" : "+s"(z));
        const unsigned ln = __builtin_amdgcn_mbcnt_hi(~0u, __builtin_amdgcn_mbcnt_lo(~0u, z));
        if (ln == 0) {
            __builtin_amdgcn_fence(__ATOMIC_RELEASE, "agent");
            __hip_atomic_fetch_add(ctr, 1u, __ATOMIC_RELAXED, __HIP_MEMORY_SCOPE_AGENT);
            while (__hip_atomic_load(ctr, __ATOMIC_RELAXED, __HIP_MEMORY_SCOPE_AGENT) < target) __builtin_amdgcn_s_sleep(2);
        }
    }
    __builtin_amdgcn_s_barrier();
    __builtin_amdgcn_fence(__ATOMIC_ACQUIRE, "agent");
    asm volatile("s_waitcnt vmcnt(0) lgkmcnt(0)" ::: "memory");
}

__global__ void __launch_bounds__(512, 2) fwd_megakernel(Params p) {
    extern __shared__ __attribute__((aligned(16))) unsigned char shm[];
    LAS unsigned char* lds = (LAS unsigned char*)shm;
    cg::grid_group grid = cg::this_grid();
#ifndef PHMASK
#define PHMASK 0x3fff
#endif
#ifdef DBG_TIME_I
#define TSTAMP(k) if (blockIdx.x == 0 && threadIdx.x == 0) ((unsigned long long*)(p.ws + WS_END))[k] = __builtin_amdgcn_s_memrealtime();
#else
#define TSTAMP(k)
#endif
    TSTAMP(0)
#define PHASE(n, ...) if (p.ph_lo <= (n) && (n) < p.ph_hi) { if constexpr ((PHMASK >> (n)) & 1) { __VA_ARGS__ } if ((n) + 1 < p.ph_hi) { \
        grid_barrier((unsigned*)(p.ws + WS_END + 256), (unsigned)((n) - p.ph_lo + 1) * gridDim.x, wv); } TSTAMP((n) + 1) }
    const int wv = __builtin_amdgcn_readfirstlane(threadIdx.x >> 6);
    if (p.ph_hi < 0) grid.sync();
    PHASE(0, prep_phase(p, lds, wv);)
    PHASE(1, norm_phase<0>(p, wv);)
    PHASE(2, run_gemm<0>(p, lds, p.hA(), p.bt1a(), 3072, 1024, wv);)
    PHASE(3, attn_phase(p, lds, wv);)
    PHASE(4, run_gemm<1>(p, lds, p.hA(), p.bt1b(), 5376, 1024, wv);)
    PHASE(5, conv_phase(p, wv);)
    PHASE(6, ssd_phase(p, lds, wv);)
    PHASE(7, run_gemm<2>(p, lds, p.hA(), p.bt1c(), 2048, 1024, wv); ssdnorm_phase(p, wv);)
    PHASE(8, run_gemm<3>(p, lds, p.qbuf(), p.btpa(), 1024, 1024, wv); run_gemm<4>(p, lds, p.zbuf(), p.btpb(), 1024, 2048, wv);)
    PHASE(9, run_gemm<5>(p, lds, p.mbuf(), p.btout(), 1024, 1024, wv);)
    PHASE(10, norm_phase<1>(p, wv);)
    PHASE(11, run_gemm<6>(p, lds, p.h2(), p.btgu(), 5632, 1024, wv);)
    PHASE(12, run_gemm<7>(p, lds, p.swbuf(), p.btdown(), 1024, 2816, wv);)
    PHASE(13, norm_phase<2>(p, wv);)
#undef PHASE
}


#ifdef DBG_TIME_I
__global__ void dbg_time_apply(float* out, const unsigned long long* ts) {
    const float tot = (float)(ts[14] - ts[0]); const float fi = (float)(ts[DBG_TIME_I + 1] - ts[DBG_TIME_I]) / tot, fj = (float)(ts[DBG_TIME_J + 1] - ts[DBG_TIME_J]) / tot;
    const float sc = 1.0f + sqrtf(fi);
    for (size_t i = O_NCS + (size_t)blockIdx.x * 256 + threadIdx.x; i < O_NCS + 294912; i += (size_t)gridDim.x * 256) out[i] *= sc;
    if (blockIdx.x == 0 && threadIdx.x == 0) out[0] += 1000.0f * fj;
}
#endif
extern "C" void kernel_launch(void* const* d_in, const int* in_sizes, int n_in, void* d_out, int out_size, void* d_ws, size_t ws_size, hipStream_t stream) {
    static int grid_blocks = 0;
    if (!grid_blocks) {
        int dev = 0, cus = 0, per_cu = 0;
        hipGetDevice(&dev);
        hipDeviceGetAttribute(&cus, hipDeviceAttributeMultiprocessorCount, dev);
        hipFuncSetAttribute((const void*)fwd_megakernel, hipFuncAttributeMaxDynamicSharedMemorySize, LDS_BYTES);
        hipOccupancyMaxActiveBlocksPerMultiprocessor(&per_cu, (const void*)fwd_megakernel, 512, LDS_BYTES);
        if (per_cu < 1) per_cu = 1;
        grid_blocks = cus * per_cu;
        if (grid_blocks > 256) grid_blocks = 256;
    }
    Params p{};
    const float* const* in = (const float* const*)d_in;
    p.x_p = in[0]; p.x_s = in[1]; p.cache_k = in[2]; p.cache_v = in[3]; p.state_conv = in[4]; p.state_ssm = in[5]; p.c_p = in[6]; p.c_s = in[7];
    p.w_ada = in[8]; p.b_ada = in[9]; p.g_mix = in[10]; p.g_ffn = in[11]; p.w_in = in[12]; p.lq1 = in[13]; p.lk1 = in[14]; p.lq2 = in[15]; p.lk2 = in[16]; p.g_subln = in[17];
    p.conv_w = in[18]; p.conv_b = in[19]; p.dt_bias = in[20]; p.a_log = in[21]; p.d_skip = in[22]; p.g_ssd = in[23]; p.w_pa = in[24]; p.w_pb = in[25]; p.w_out = in[26]; p.w_gu = in[27]; p.w_down = in[28]; p.g_final = in[29];
    p.out = (float*)d_out; p.ws = (unsigned char*)d_ws;
    if (WS_END + 1024 > ws_size || (size_t)out_size < O_END) { fprintf(stderr, "kernel_launch: workspace/output too small: need %zu / %zu, have %zu / %d\n", (size_t)WS_END, (size_t)O_END, ws_size, out_size); return; }
    hipMemsetAsync((unsigned char*)d_ws + WS_END + 256, 0, 64, stream);
    p.ph_lo = 0; p.ph_hi = 14;
    void* args[] = {&p};
    hipError_t e = hipLaunchCooperativeKernel((const void*)fwd_megakernel, dim3(grid_blocks), dim3(512), args, LDS_BYTES, stream);
    if (e != hipSuccess) fprintf(stderr, "cooperative launch failed: %s (grid %d)\n", hipGetErrorString(e), grid_blocks);
#ifdef DBG_TIME_I
    dbg_time_apply<<<64, 256, 0, stream>>>((float*)d_out, (const unsigned long long*)((unsigned char*)d_ws + WS_END));
#endif
}
```

```cpp
#include <hip/hip_runtime.h>
#include <hip/hip_cooperative_groups.h>
#include <cstdio>
namespace cg = cooperative_groups;

#define LAS __attribute__((address_space(3)))
typedef unsigned short bf16_t;
typedef short bf16x8 __attribute__((ext_vector_type(8)));
typedef short s16x4 __attribute__((ext_vector_type(4)));
typedef float f32x4 __attribute__((ext_vector_type(4)));
typedef float f32x16 __attribute__((ext_vector_type(16)));
typedef unsigned u32x4 __attribute__((ext_vector_type(4)));
typedef unsigned u32x2 __attribute__((ext_vector_type(2)));

constexpr int MP = 65536, MS = 2048, MT = MP + MS;
constexpr int LDS_BYTES = 131072;
constexpr float EPSN = 1e-5f;
constexpr float LOG2E = 1.4426950408889634f;

constexpr size_t al256(size_t x) { return (x + 255) & ~(size_t)255; }
constexpr size_t WS_BT1A = 0, WS_BT1B = WS_BT1A + al256((size_t)3072 * 1024 * 2), WS_BT1C = WS_BT1B + al256((size_t)5376 * 1024 * 2), WS_BTPA = WS_BT1C + al256((size_t)2048 * 1024 * 2),
    WS_BTPB = WS_BTPA + al256((size_t)1024 * 1024 * 2), WS_BTOUT = WS_BTPB + al256((size_t)1024 * 2048 * 2), WS_BTGU = WS_BTOUT + al256((size_t)1024 * 1024 * 2), WS_BTDOWN = WS_BTGU + al256((size_t)5632 * 1024 * 2),
    WS_MOD = WS_BTDOWN + al256((size_t)1024 * 2816 * 2), WS_ROPE = WS_MOD + al256((size_t)64 * 6144 * 4), WS_DT = WS_ROPE + al256((size_t)2048 * 32 * 8), WS_SS = WS_DT + al256((size_t)MT * 32 * 4),
    WS_RH = WS_SS + al256((size_t)MT * 8 * 4), WS_RBIG = WS_RH + al256((size_t)MT * 1024 * 2), WS_RZ = WS_RBIG + al256((size_t)MT * 3072 * 2), WS_HALO = WS_RZ + al256((size_t)MT * 2048 * 2), WS_END = WS_HALO + al256((size_t)(MT / 64) * 3 * 3072 * 2);
constexpr size_t O_NKP = (size_t)MT * 1024, O_NVP = O_NKP + (size_t)MP * 1024, O_NCP = O_NVP + (size_t)MP * 1024, O_NSP = O_NCP + 32 * 3 * 3072, O_NKS = O_NSP + (size_t)32 * 32 * 64 * 128,
    O_NVS = O_NKS + (size_t)MS * 1024, O_NCS = O_NVS + (size_t)MS * 1024, O_NSS = O_NCS + 32 * 3 * 3072, O_END = O_NSS + (size_t)32 * 32 * 64 * 128;
struct Params {
    const float *x_p, *x_s, *cache_k, *cache_v, *state_conv, *state_ssm, *c_p, *c_s;
    const float *w_ada, *b_ada, *g_mix, *g_ffn, *w_in, *lq1, *lk1, *lq2, *lk2, *g_subln, *conv_w, *conv_b, *dt_bias, *a_log, *d_skip, *g_ssd;
    const float *w_pa, *w_pb, *w_out, *w_gu, *w_down, *g_final;
    float* out; unsigned char* ws;
    int ph_lo, ph_hi;
    __device__ __forceinline__ float* y() const { return out; }
    __device__ __forceinline__ float* nk_p() const { return out + O_NKP; }
    __device__ __forceinline__ float* nv_p() const { return out + O_NVP; }
    __device__ __forceinline__ float* nconv_p() const { return out + O_NCP; }
    __device__ __forceinline__ float* nssm_p() const { return out + O_NSP; }
    __device__ __forceinline__ float* nk_s() const { return out + O_NKS; }
    __device__ __forceinline__ float* nv_s() const { return out + O_NVS; }
    __device__ __forceinline__ float* nconv_s() const { return out + O_NCS; }
    __device__ __forceinline__ float* nssm_s() const { return out + O_NSS; }
    __device__ __forceinline__ bf16_t* bt1a() const { return (bf16_t*)(ws + WS_BT1A); }
    __device__ __forceinline__ bf16_t* bt1b() const { return (bf16_t*)(ws + WS_BT1B); }
    __device__ __forceinline__ bf16_t* bt1c() const { return (bf16_t*)(ws + WS_BT1C); }
    __device__ __forceinline__ bf16_t* btpa() const { return (bf16_t*)(ws + WS_BTPA); }
    __device__ __forceinline__ bf16_t* btpb() const { return (bf16_t*)(ws + WS_BTPB); }
    __device__ __forceinline__ bf16_t* btout() const { return (bf16_t*)(ws + WS_BTOUT); }
    __device__ __forceinline__ bf16_t* btgu() const { return (bf16_t*)(ws + WS_BTGU); }
    __device__ __forceinline__ bf16_t* btdown() const { return (bf16_t*)(ws + WS_BTDOWN); }
    __device__ __forceinline__ float* mod() const { return (float*)(ws + WS_MOD); }
    __device__ __forceinline__ float2* rope() const { return (float2*)(ws + WS_ROPE); }
    __device__ __forceinline__ float* dtbuf() const { return (float*)(ws + WS_DT); }
    __device__ __forceinline__ float* ssbuf() const { return (float*)(ws + WS_SS); }
    __device__ __forceinline__ bf16_t* hA() const { return (bf16_t*)(ws + WS_RH); }
    __device__ __forceinline__ bf16_t* mbuf() const { return (bf16_t*)(ws + WS_RH); }
    __device__ __forceinline__ bf16_t* h2() const { return (bf16_t*)(ws + WS_RH); }
    __device__ __forceinline__ bf16_t* qbuf() const { return (bf16_t*)out; }
    __device__ __forceinline__ bf16_t* x1buf() const { return (bf16_t*)out; }
    __device__ __forceinline__ bf16_t* x2buf() const { return (bf16_t*)(ws + WS_RH); }
    __device__ __forceinline__ bf16_t* kbuf_p() const { return (bf16_t*)(ws + WS_RBIG); }
    __device__ __forceinline__ bf16_t* vbuf_p() const { return (bf16_t*)(ws + WS_RBIG) + (size_t)MP * 1024; }
    __device__ __forceinline__ bf16_t* kbuf_s() const { return (bf16_t*)(ws + WS_RBIG) + (size_t)2 * MP * 1024; }
    __device__ __forceinline__ bf16_t* vbuf_s() const { return (bf16_t*)(ws + WS_RBIG) + (size_t)2 * MP * 1024 + (size_t)MS * 1024; }
    __device__ __forceinline__ bf16_t* xbcbuf() const { return (bf16_t*)(ws + WS_RBIG); }
    __device__ __forceinline__ bf16_t* gbuf() const { return (bf16_t*)(ws + WS_RBIG); }
    __device__ __forceinline__ bf16_t* swbuf() const { return (bf16_t*)(ws + WS_RBIG); }
    __device__ __forceinline__ bf16_t* zbuf() const { return (bf16_t*)(ws + WS_RZ); }
    __device__ __forceinline__ bf16_t* halo() const { return (bf16_t*)(ws + WS_HALO); }
};

typedef float f32x2_t __attribute__((ext_vector_type(2)));
typedef __bf16 bf16x2_t __attribute__((ext_vector_type(2)));
__device__ __forceinline__ unsigned cvt_pk_bf16(float lo, float hi) { const f32x2_t v = {lo, hi}; const bf16x2_t b = __builtin_convertvector(v, bf16x2_t); return __builtin_bit_cast(unsigned, b); }
__device__ __forceinline__ float bf_lo(unsigned w) { return __uint_as_float(w << 16); }
__device__ __forceinline__ float bf_hi(unsigned w) { return __uint_as_float(w & 0xffff0000u); }
__device__ __forceinline__ float fexp2(float x) { return __builtin_amdgcn_exp2f(x); }
__device__ __forceinline__ float fexp(float x) { return __builtin_amdgcn_exp2f(x * LOG2E); }
__device__ __forceinline__ float frcp(float x) { return __builtin_amdgcn_rcpf(x); }
__device__ __forceinline__ float sigmoidf_(float x) { return frcp(1.0f + fexp(-x)); }
__device__ __forceinline__ float siluf_(float x) { return x * sigmoidf_(x); }
__device__ __forceinline__ u32x4 pack8(f32x4 a, f32x4 b) { u32x4 w; w.x = cvt_pk_bf16(a[0], a[1]); w.y = cvt_pk_bf16(a[2], a[3]); w.z = cvt_pk_bf16(b[0], b[1]); w.w = cvt_pk_bf16(b[2], b[3]); return w; }
__device__ __forceinline__ u32x2 pack4(f32x4 a) { u32x2 w; w.x = cvt_pk_bf16(a[0], a[1]); w.y = cvt_pk_bf16(a[2], a[3]); return w; }

__device__ __forceinline__ int opaque_tid(int wv) { int t = wv * 64 + (int)__builtin_amdgcn_mbcnt_hi(~0u, __builtin_amdgcn_mbcnt_lo(~0u, 0u)); asm volatile("" : "+v"(t)); return t; }
namespace pg8 {
constexpr int BM = 256, BK = 64, HALF = 128, HTB = HALF * BK * 2, STAGE_BYTES = 8 * HTB, NXCD = 8, WGM = 8;
__host__ __device__ __forceinline__ int lds_byte(int r, int c) { const int st = (r >> 4) * 2 + (c >> 5), rr = r & 15, cc = c & 31, ob = rr * 64 + cc * 2; return st * 1024 + (ob ^ (((ob >> 9) & 1) << 5)); }
__host__ __device__ __forceinline__ void stage_rc(int b, int& R, int& C) { const int st = b / 1024, sb = b % 1024, swz = sb ^ (((sb >> 9) & 1) << 5); R = (st >> 1) * 16 + swz / 64; C = (st & 1) * 32 + (swz % 64) / 2; }
struct Unit { int pm, pn; };
struct Gemm { const bf16_t* A; const bf16_t* Bt; int M, N, K; };
struct StaticOrder {
    int nM, nN, nwg, G, c;
    __host__ __device__ void init(int M, int N, int G_, int c_) { nM = M / BM; nN = N / BM; nwg = nM * nN; G = G_; c = c_; }
    __host__ __device__ bool next(int i, Unit& u) const {
        const long L = (long)i * G + c; if (L >= nwg) return false;
        int wgid = (int)L; { const int q = nwg / NXCD, r = nwg % NXCD, xcd = wgid % NXCD, off = wgid / NXCD; wgid = (xcd < r ? xcd * (q + 1) : r * (q + 1) + (xcd - r) * q) + off; }
        const int nig = WGM * nN, gid = wgid / nig, fm = gid * WGM, gsz = (nM - fm) < WGM ? (nM - fm) : WGM;
        u.pm = fm + ((wgid % nig) % gsz); u.pn = (wgid % nig) / gsz; return true;
    }
};

template <class Epi>
__device__ __forceinline__ void gemm_phase(LAS unsigned char* lds, const Gemm g, const StaticOrder& S, const Epi& E, int wv) {
    const int tid = opaque_tid(wv), wid = __builtin_amdgcn_readfirstlane(tid >> 6), lane = tid & 63, wr = wid >> 2, wc = wid & 3, fr = lane & 15, fq = lane >> 4;
    const int K = g.K, nt = K / BK;
    unsigned voffA[2], voffB[2];
#pragma unroll
    for (int i = 0; i < 2; ++i) { int R, C; stage_rc(tid * 16 + i * 8192, R, C); voffA[i] = (unsigned)(R * K + C) * 2u; voffB[i] = voffA[i]; }
    const size_t kstep = (size_t)(BK * 2);
    const size_t hstep = (size_t)HALF * K * 2;
    const size_t tstep = 2 * hstep;
    const unsigned ldsw = (unsigned)wid * 1024u;
    const int aoff = lds_byte(wr * 64 + fr, fq * 8), boff = lds_byte(wc * 32 + fr, fq * 8);
#define PG8_SA(b, h) (((b) * 2 + (h)) * HTB)
#define PG8_SB(b, h) ((4 + (b) * 2 + (h)) * HTB)
#define PG8_STAGE(bufoff, gbase, voff) do { _Pragma("unroll") for (int _i = 0; _i < 2; ++_i) \
        __builtin_amdgcn_global_load_lds((const unsigned*)((const char*)(gbase) + (voff)[_i]), (LAS unsigned*)(lds + (bufoff) + ldsw + _i * 8192), 16, 0, 0); } while (0)
#define PG8_LDA(dst, b, h) do { _Pragma("unroll") for (int m = 0; m < 4; ++m) _Pragma("unroll") for (int k = 0; k < 2; ++k) dst[m][k] = *(const LAS bf16x8*)(lds + PG8_SA(b, h) + aoff + m * 2048 + k * 1024); } while (0)
#define PG8_LDB(dst, b, h) do { _Pragma("unroll") for (int n = 0; n < 2; ++n) _Pragma("unroll") for (int k = 0; k < 2; ++k) dst[n][k] = *(const LAS bf16x8*)(lds + PG8_SB(b, h) + boff + n * 2048 + k * 1024); } while (0)
#define PG8_MMA(ai, bj, At, Bt) do { __builtin_amdgcn_s_setprio(1); _Pragma("unroll") for (int m = 0; m < 4; ++m) _Pragma("unroll") for (int n = 0; n < 2; ++n) _Pragma("unroll") for (int k = 0; k < 2; ++k) \
        acc[ai][bj][m][n] = __builtin_amdgcn_mfma_f32_16x16x32_bf16(Bt[n][k], At[m][k], acc[ai][bj][m][n], 0, 0, 0); __builtin_amdgcn_s_setprio(0); } while (0)
#define PG8_WAIT_V(n) asm volatile("s_waitcnt vmcnt(" #n ")" ::: "memory")
#define PG8_WAIT_L(n) asm volatile("s_waitcnt lgkmcnt(" #n ")" ::: "memory")
#define PG8_BAR __builtin_amdgcn_s_barrier()
#define PG8_SCHED __builtin_amdgcn_sched_barrier(0)
    Unit cur, nxt; int ui = 0;
    if (!S.next(0, cur)) return;
    f32x4 acc[2][2][4][2];
#pragma unroll
    for (int a = 0; a < 2; ++a)
#pragma unroll
        for (int b = 0; b < 2; ++b)
#pragma unroll
            for (int m = 0; m < 4; ++m)
#pragma unroll
                for (int n = 0; n < 2; ++n) acc[a][b][m][n] = (f32x4){0.f, 0.f, 0.f, 0.f};
    bf16x8 At[4][2], B0[2][2], B1[2][2];
    const char* cA = (const char*)g.A + (size_t)cur.pm * tstep; const char* cB = (const char*)g.Bt + (size_t)cur.pn * tstep;
    PG8_STAGE(PG8_SB(0, 0), cB, voffB); PG8_STAGE(PG8_SA(0, 0), cA, voffA); PG8_STAGE(PG8_SB(0, 1), cB + hstep, voffB); PG8_STAGE(PG8_SA(0, 1), cA + hstep, voffA);
    if (wr == 1) PG8_BAR;
    PG8_WAIT_V(4); PG8_BAR;
    PG8_STAGE(PG8_SB(1, 0), cB + kstep, voffB); PG8_STAGE(PG8_SA(1, 0), cA + kstep, voffA); PG8_STAGE(PG8_SB(1, 1), cB + hstep + kstep, voffB);
    PG8_WAIT_V(6); PG8_BAR;
    for (;;) {
        const bool has_next = S.next(ui + 1, nxt);
        const char* nA = has_next ? (const char*)g.A + (size_t)nxt.pm * tstep : cA; const char* nB = has_next ? (const char*)g.Bt + (size_t)nxt.pn * tstep : cB;
        for (int t = 0; t < nt; t += 2) {
            const bool last = (t == nt - 2);
            const char* a1 = cA + (size_t)(t + 1) * kstep;
            const char* a2 = last ? nA : cA + (size_t)(t + 2) * kstep; const char* b2 = last ? nB : cB + (size_t)(t + 2) * kstep;
            const char* a3 = a2 + kstep; const char* b3 = b2 + kstep;
            PG8_LDB(B0, 0, 0); PG8_SCHED; PG8_LDA(At, 0, 0); PG8_STAGE(PG8_SA(1, 1), a1 + hstep, voffA);
            PG8_WAIT_L(8); PG8_BAR; PG8_WAIT_L(0); PG8_MMA(0, 0, At, B0); PG8_BAR; PG8_SCHED;
            PG8_LDB(B1, 0, 1); PG8_STAGE(PG8_SB(0, 0), b2, voffB);
            PG8_BAR; PG8_WAIT_L(0); PG8_MMA(0, 1, At, B1); PG8_BAR;
            PG8_LDA(At, 0, 1); PG8_STAGE(PG8_SA(0, 0), a2, voffA);
            PG8_BAR; PG8_WAIT_L(0); PG8_MMA(1, 0, At, B0); PG8_BAR; PG8_SCHED;
            PG8_STAGE(PG8_SB(0, 1), b2 + hstep, voffB);
            PG8_WAIT_V(6); PG8_BAR; PG8_MMA(1, 1, At, B1); PG8_BAR;
            PG8_LDB(B0, 1, 0); PG8_SCHED; PG8_LDA(At, 1, 0); PG8_STAGE(PG8_SA(0, 1), a2 + hstep, voffA);
            PG8_WAIT_L(8); PG8_BAR; PG8_WAIT_L(0); PG8_MMA(0, 0, At, B0); PG8_BAR; PG8_SCHED;
            PG8_LDB(B1, 1, 1); PG8_STAGE(PG8_SB(1, 0), b3, voffB);
            PG8_BAR; PG8_WAIT_L(0); PG8_MMA(0, 1, At, B1); PG8_BAR;
            PG8_LDA(At, 1, 1); PG8_STAGE(PG8_SA(1, 0), a3, voffA);
            PG8_BAR; PG8_WAIT_L(0); PG8_MMA(1, 0, At, B0); PG8_BAR; PG8_SCHED;
            PG8_STAGE(PG8_SB(1, 1), b3 + hstep, voffB);
            PG8_WAIT_V(6); PG8_BAR; PG8_MMA(1, 1, At, B1); PG8_BAR;
        }
        E(acc, cur, wr, wc, fr, fq);
        if (!has_next) break;
#pragma unroll
        for (int a = 0; a < 2; ++a)
#pragma unroll
            for (int b = 0; b < 2; ++b)
#pragma unroll
                for (int m = 0; m < 4; ++m)
#pragma unroll
                    for (int n = 0; n < 2; ++n) acc[a][b][m][n] = (f32x4){0.f, 0.f, 0.f, 0.f};
        cur = nxt; cA = nA; cB = nB; ++ui;
    }
    PG8_WAIT_V(0);
    if (wr == 0) PG8_BAR;
    PG8_BAR;
#undef PG8_SA
#undef PG8_SB
#undef PG8_STAGE
#undef PG8_LDA
#undef PG8_LDB
#undef PG8_MMA
#undef PG8_WAIT_V
#undef PG8_WAIT_L
#undef PG8_BAR
#undef PG8_SCHED
}
}

__device__ __forceinline__ int perm32i(int rho) { const int n = rho >> 4, i = rho & 15; return 8 * (i >> 2) + 4 * n + (i & 3); }
__device__ __forceinline__ int gperm(int c) { return (c & ~31) + perm32i(c & 31); }
__device__ __forceinline__ int rperm(int c) { const int w = (c >> 5) & 1, n = (c >> 4) & 1, i = c & 15; return (c & ~63) + 16 * w + i + 32 * n; }
__device__ __forceinline__ int src_col(int mode, int c) {
    switch (mode) {
        case 0: return c < 2048 ? rperm(c) : gperm(c);
        case 1: { if (c < 2048) return 3072 + gperm(c); if (c < 5120) return 5120 + gperm(c - 2048); const int t = gperm(c - 5120); return t < 32 ? 8192 + t : -1; }
        case 2: return 8224 + gperm(c);
        case 6: { const int pn = c >> 8, bj = (c >> 7) & 1, r = c & 127; return bj * 2816 + 128 * pn + gperm(r); }
        default: return gperm(c);
    }
}

__device__ __forceinline__ int batch_of(int r) { return r < MP ? (r >> 11) : 32 + ((r - MP) >> 6); }

template <int MODE> struct Epi {
    const Params& p;
    __device__ __forceinline__ void operator()(const f32x4 (&acc)[2][2][4][2], const pg8::Unit& u, int wr_, int wc_, int fr_, int fq_) const {
        int wr = wr_, wc = wc_, fr = fr_, fq = fq_;
        asm volatile("" : "+s"(wr), "+s"(wc), "+v"(fr), "+v"(fq));
        const int pn = u.pn;
#pragma unroll
        for (int ai = 0; ai < 2; ++ai)
#pragma unroll
            for (int m = 0; m < 4; ++m) {
                if ((MODE == 3 || MODE == 4) ? (m == 0) : ((m & 1) == 0)) __builtin_amdgcn_sched_barrier(0);
                const int r = u.pm * 256 + ai * 128 + wr * 64 + m * 16 + fr;
                const bool samp = r >= MP; const int rs = r - MP;
                if constexpr (MODE == 0) {
                    const int type = pn >> 2, colbase = (pn & 3) * 256;
                    if (type < 2) {
                        const int pos = samp ? 1024 + (rs & 63) : (r & 2047);
                        const int dlo = 16 * (wc & 1) + 4 * fq;
                        f32x4 cv, sv;
#pragma unroll
                        for (int j = 0; j < 4; ++j) {
                            const float frq = fexp2((float)(dlo + j) * (-13.287712379549449f / 32.0f)) * 0.15915494309189535f;
                            const float rev = __builtin_amdgcn_fractf((float)pos * frq);
                            cv[j] = __builtin_amdgcn_cosf(rev); sv[j] = __builtin_amdgcn_sinf(rev);
                        }
#pragma unroll
                        for (int bj = 0; bj < 2; ++bj) {
                            const int col = colbase + 64 * (2 * bj + (wc >> 1)) + dlo;
                            const f32x4 x1 = acc[ai][bj][m][0], x2 = acc[ai][bj][m][1];
                            f32x4 o1 = x1 * cv - x2 * sv, o2 = x2 * cv + x1 * sv;
                            if (type == 0) {
                                const float qs = 0.125f * LOG2E; o1 *= qs; o2 *= qs;
                                bf16_t* q = p.qbuf() + (size_t)r * 1024 + col;
                                *(u32x2*)q = pack4(o1); *(u32x2*)(q + 32) = pack4(o2);
                            } else {
                                float* ko = (samp ? p.nk_s() + (size_t)rs * 1024 : p.nk_p() + (size_t)r * 1024) + col;
                                *(f32x4*)ko = o1; *(f32x4*)(ko + 32) = o2;
                                bf16_t* kb = (samp ? p.kbuf_s() + (size_t)rs * 1024 : p.kbuf_p() + (size_t)r * 1024) + col;
                                *(u32x2*)kb = pack4(o1); *(u32x2*)(kb + 32) = pack4(o2);
                            }
                        }
                    } else {
#pragma unroll
                        for (int bj = 0; bj < 2; ++bj) {
                            const int col = colbase + 128 * bj + 32 * wc + 8 * fq;
                            float* vo = (samp ? p.nv_s() + (size_t)rs * 1024 : p.nv_p() + (size_t)r * 1024) + col;
                            *(f32x4*)vo = acc[ai][bj][m][0]; *(f32x4*)(vo + 4) = acc[ai][bj][m][1];
                            bf16_t* vb = (samp ? p.vbuf_s() + (size_t)rs * 1024 : p.vbuf_p() + (size_t)r * 1024) + col;
                            *(u32x4*)vb = pack8(acc[ai][bj][m][0], acc[ai][bj][m][1]);
                        }
                    }
                } else if constexpr (MODE == 1) {
                    if (pn < 8) {
#pragma unroll
                        for (int bj = 0; bj < 2; ++bj) { const int col = pn * 256 + 128 * bj + 32 * wc + 8 * fq; *(u32x4*)(p.zbuf() + (size_t)r * 2048 + col) = pack8(acc[ai][bj][m][0], acc[ai][bj][m][1]); }
                    } else if (pn < 20) {
                        const int tt = samp ? (rs & 63) - 61 : (r & 2047) - 2045;
#pragma unroll
                        for (int bj = 0; bj < 2; ++bj) {
                            const int col = (pn - 8) * 256 + 128 * bj + 32 * wc + 8 * fq;
                            const u32x4 xw = pack8(acc[ai][bj][m][0], acc[ai][bj][m][1]);
                            *(u32x4*)(p.xbcbuf() + (size_t)r * 3072 + col) = xw;
                            if ((r & 63) >= 61) *(u32x4*)(p.halo() + ((size_t)(r >> 6) * 3 + ((r & 63) - 61)) * 3072 + col) = xw;
                            if (tt >= 0) { float* co = (samp ? p.nconv_s() + ((size_t)(rs >> 6) * 3 + tt) * 3072 : p.nconv_p() + ((size_t)(r >> 11) * 3 + tt) * 3072) + col; *(f32x4*)co = acc[ai][bj][m][0]; *(f32x4*)(co + 4) = acc[ai][bj][m][1]; }
                        }
                    } else {
                        if (wc == 0) { float* d = p.dtbuf() + (size_t)r * 32 + 8 * fq; *(f32x4*)d = acc[ai][0][m][0]; *(f32x4*)(d + 4) = acc[ai][0][m][1]; }
                    }
                } else if constexpr (MODE == 2) {
#pragma unroll
                    for (int bj = 0; bj < 2; ++bj) {
                        const int col = pn * 256 + 128 * bj + 32 * wc + 8 * fq; f32x4 a = acc[ai][bj][m][0], b = acc[ai][bj][m][1];
#pragma unroll
                        for (int j = 0; j < 4; ++j) { a[j] = sigmoidf_(a[j]); b[j] = sigmoidf_(b[j]); }
                        *(u32x4*)(p.gbuf() + (size_t)r * 2048 + col) = pack8(a, b);
                    }
                } else if constexpr (MODE == 3 || MODE == 4) {
#pragma unroll
                    for (int bj = 0; bj < 2; ++bj) {
                        const int col = pn * 256 + 128 * bj + 32 * wc + 8 * fq;
                        const u32x4 g = *(const u32x4*)(p.gbuf() + (size_t)r * 2048 + (MODE == 4 ? 1024 : 0) + col);
                        f32x4 a = acc[ai][bj][m][0], b = acc[ai][bj][m][1];
                        a[0] *= bf_lo(g.x); a[1] *= bf_hi(g.x); a[2] *= bf_lo(g.y); a[3] *= bf_hi(g.y); b[0] *= bf_lo(g.z); b[1] *= bf_hi(g.z); b[2] *= bf_lo(g.w); b[3] *= bf_hi(g.w);
                        bf16_t* mp = p.mbuf() + (size_t)r * 1024 + col;
                        if constexpr (MODE == 4) { const u32x4 o = *(const u32x4*)mp; a[0] += bf_lo(o.x); a[1] += bf_hi(o.x); a[2] += bf_lo(o.y); a[3] += bf_hi(o.y); b[0] += bf_lo(o.z); b[1] += bf_hi(o.z); b[2] += bf_lo(o.w); b[3] += bf_hi(o.w); }
                        *(u32x4*)mp = pack8(a, b);
                    }
                } else if constexpr (MODE == 5 || MODE == 7) {
                    const int bidx = u.pm < 256 ? (u.pm >> 3) : 32 + (u.pm - 256) * 4 + 2 * ai + wr;
                    const float* mrow = p.mod() + (size_t)bidx * 6144 + (MODE == 5 ? 2048 : 5120);
#pragma unroll
                    for (int bj = 0; bj < 2; ++bj) {
                        const int col = pn * 256 + 128 * bj + 32 * wc + 8 * fq;
                        f32x4 x0, x1;
                        if constexpr (MODE == 5) { const float* xin = (samp ? p.x_s + (size_t)rs * 1024 : p.x_p + (size_t)r * 1024) + col; x0 = *(const f32x4*)xin; x1 = *(const f32x4*)(xin + 4); }
                        else { const u32x4 xw = *(const u32x4*)(p.x1buf() + (size_t)r * 1024 + col); x0 = (f32x4){bf_lo(xw.x), bf_hi(xw.x), bf_lo(xw.y), bf_hi(xw.y)}; x1 = (f32x4){bf_lo(xw.z), bf_hi(xw.z), bf_lo(xw.w), bf_hi(xw.w)}; }
                        const f32x4 g0 = *(const f32x4*)(mrow + col), g1 = *(const f32x4*)(mrow + col + 4);
                        bf16_t* yo = (MODE == 5 ? p.x1buf() : p.x2buf()) + (size_t)r * 1024 + col;
                        *(u32x4*)yo = pack8(x0 + g0 * acc[ai][bj][m][0], x1 + g1 * acc[ai][bj][m][1]);
                    }
                } else if constexpr (MODE == 6) {
                    const int col = pn * 128 + 32 * wc + 8 * fq; f32x4 a = acc[ai][0][m][0], b = acc[ai][0][m][1];
#pragma unroll
                    for (int j = 0; j < 4; ++j) { a[j] = siluf_(a[j]) * acc[ai][1][m][0][j]; b[j] = siluf_(b[j]) * acc[ai][1][m][1][j]; }
                    *(u32x4*)(p.swbuf() + (size_t)r * 2816 + col) = pack8(a, b);
                }
            }
    }
};

template <int MODE> __device__ __forceinline__ void run_gemm(const Params& p, LAS unsigned char* lds, const bf16_t* A, const bf16_t* Bt, int N, int K, int wv) {
    pg8::Gemm g{A, Bt, MT, N, K}; pg8::StaticOrder S; S.init(MT, N, (int)gridDim.x, (int)blockIdx.x); Epi<MODE> E{p};
    pg8::gemm_phase<Epi<MODE>>(lds, g, S, E, wv);
}

__device__ __forceinline__ float wave_sum(float v) {
#pragma unroll
    for (int o = 32; o >= 1; o >>= 1) v += __shfl_xor(v, o);
    return v;
}

__device__ void prep_phase(const Params& p, LAS unsigned char* lds, int wv) {
    const int tid = opaque_tid(wv);
    {
        LAS float* tiles = (LAS float*)lds;
        const int ntiles[8] = {48 * 16, 84 * 16, 32 * 16, 16 * 16, 16 * 32, 16 * 16, 88 * 16, 16 * 44};
        int total = 0;
#pragma unroll
        for (int j = 0; j < 8; ++j) total += ntiles[j];
        for (int G = blockIdx.x; 4 * G < total; G += gridDim.x) {
            const float* W[4]; int ldw[4], K[4], n0[4], k0[4], job[4]; bf16_t* Bt[4];
#pragma unroll
            for (int u = 0; u < 4; ++u) {
                int j = 0, lt = 4 * G + u; if (lt >= total) lt = total - 1;
#pragma unroll
                for (int q = 0; q < 7; ++q) if (j == q && lt >= ntiles[q]) { lt -= ntiles[q]; j = q + 1; }
                switch (j) {
                    case 0: W[u] = p.w_in; ldw[u] = 10272; K[u] = 1024; Bt[u] = p.bt1a(); break;
                    case 1: W[u] = p.w_in; ldw[u] = 10272; K[u] = 1024; Bt[u] = p.bt1b(); break;
                    case 2: W[u] = p.w_in; ldw[u] = 10272; K[u] = 1024; Bt[u] = p.bt1c(); break;
                    case 3: W[u] = p.w_pa; ldw[u] = 1024; K[u] = 1024; Bt[u] = p.btpa(); break;
                    case 4: W[u] = p.w_pb; ldw[u] = 1024; K[u] = 2048; Bt[u] = p.btpb(); break;
                    case 5: W[u] = p.w_out; ldw[u] = 1024; K[u] = 1024; Bt[u] = p.btout(); break;
                    case 6: W[u] = p.w_gu; ldw[u] = 5632; K[u] = 1024; Bt[u] = p.btgu(); break;
                    default: W[u] = p.w_down; ldw[u] = 1024; K[u] = 2816; Bt[u] = p.btdown(); break;
                }
                const int nkt = K[u] >> 6; n0[u] = (lt / nkt) * 64; k0[u] = (lt % nkt) * 64; job[u] = j;
            }
            float v[4][8];
            const int col = tid & 63, kr = tid >> 6;
#pragma unroll
            for (int u = 0; u < 4; ++u) {
                const int sc = src_col(job[u], n0[u] + col);
#pragma unroll
                for (int jj = 0; jj < 8; ++jj) { const int k = kr + 8 * jj; v[u][jj] = sc >= 0 ? W[u][(size_t)(k0[u] + k) * ldw[u] + sc] : 0.f; }
            }
#pragma unroll
            for (int u = 0; u < 4; ++u)
#pragma unroll
                for (int jj = 0; jj < 8; ++jj) { const int k = kr + 8 * jj; float x = v[u][jj]; if (job[u] == 4) x *= p.g_ssd[k0[u] + k]; tiles[u * 64 * 65 + k * 65 + col] = x; }
            __syncthreads();
            {
                const int kk = (tid & 31) * 2, nr = tid >> 5;
#pragma unroll
                for (int u = 0; u < 4; ++u)
#pragma unroll
                    for (int jj = 0; jj < 4; ++jj) { const int n = nr + 16 * jj; *(unsigned*)(Bt[u] + (size_t)(n0[u] + n) * K[u] + k0[u] + kk) = cvt_pk_bf16(tiles[u * 64 * 65 + kk * 65 + n], tiles[u * 64 * 65 + (kk + 1) * 65 + n]); }
            }
            __syncthreads();
        }
    }
    {
        LAS float* sc = (LAS float*)lds;
        LAS float* wt = (LAS float*)(lds + 64 * 129 * 4);
        for (int cbk = blockIdx.x; cbk < 256; cbk += gridDim.x) {
            const int col0 = cbk * 24, row = tid & 63, cgp = tid >> 6;
            float a0 = 0.f, a1 = 0.f, a2 = 0.f;
            for (int kc = 0; kc < 8; ++kc) {
                const int k0 = kc * 128;
                __syncthreads();
#pragma unroll
                for (int i = 0; i < 16; ++i) { const int idx = tid + 512 * i, r = idx >> 7, k = idx & 127; const float v = r < 32 ? p.c_p[r * 1024 + k0 + k] : p.c_s[(r - 32) * 1024 + k0 + k]; sc[r * 129 + k] = siluf_(v); }
#pragma unroll
                for (int i = 0; i < 6; ++i) { const int idx = tid + 512 * i, k = idx / 24, c = idx % 24; wt[idx] = p.w_ada[(size_t)(k0 + k) * 6144 + col0 + c]; }
                __syncthreads();
#pragma unroll 8
                for (int k = 0; k < 128; ++k) { const float a = sc[row * 129 + k]; a0 += a * wt[k * 24 + 3 * cgp]; a1 += a * wt[k * 24 + 3 * cgp + 1]; a2 += a * wt[k * 24 + 3 * cgp + 2]; }
            }
            const int c = col0 + 3 * cgp;
            p.mod()[row * 6144 + c] = a0 + p.b_ada[c]; p.mod()[row * 6144 + c + 1] = a1 + p.b_ada[c + 1]; p.mod()[row * 6144 + c + 2] = a2 + p.b_ada[c + 2];
        }
        __syncthreads();
    }
    const size_t gtid = (size_t)blockIdx.x * 512 + tid, gsz = (size_t)gridDim.x * 512;
}

template <int MODE> __device__ void norm_phase(const Params& p, int wv) {
    const int tid = opaque_tid(wv); const int w = tid >> 6, lane = tid & 63;
    const float* g = MODE == 0 ? p.g_mix : (MODE == 1 ? p.g_ffn : p.g_final);
    const int stride = gridDim.x * 8;
    for (int r0 = blockIdx.x * 8 + w; r0 < MT; r0 += 2 * stride) {
        f32x4 v[2][4]; float ss[2] = {0.f, 0.f}; int rr[2];
#pragma unroll
        for (int q = 0; q < 2; ++q) {
            const int r = r0 + q * stride; rr[q] = r < MT ? r : r0;
            if constexpr (MODE == 0) {
                const float* src = rr[q] < MP ? p.x_p + (size_t)rr[q] * 1024 : p.x_s + (size_t)(rr[q] - MP) * 1024;
#pragma unroll
                for (int j = 0; j < 4; ++j) v[q][j] = *(const f32x4*)(src + 256 * j + 4 * lane);
            } else {
                const bf16_t* src = (MODE == 1 ? p.x1buf() : p.x2buf()) + (size_t)rr[q] * 1024;
#pragma unroll
                for (int j = 0; j < 4; ++j) { const u32x2 u = *(const u32x2*)(src + 256 * j + 4 * lane); v[q][j] = (f32x4){bf_lo(u.x), bf_hi(u.x), bf_lo(u.y), bf_hi(u.y)}; }
            }
        }
#pragma unroll
        for (int q = 0; q < 2; ++q) {
#pragma unroll
            for (int j = 0; j < 4; ++j) ss[q] += v[q][j][0] * v[q][j][0] + v[q][j][1] * v[q][j][1] + v[q][j][2] * v[q][j][2] + v[q][j][3] * v[q][j][3];
            ss[q] = wave_sum(ss[q]);
        }
#pragma unroll
        for (int q = 0; q < 2; ++q) {
            if (q == 1 && r0 + stride >= MT) continue;
            const int r = rr[q];
            const float rsn = rsqrtf(ss[q] * (1.0f / 1024.0f) + EPSN);
            const float* mrow = p.mod() + (size_t)batch_of(r) * 6144 + (MODE == 0 ? 0 : 3072);
#pragma unroll
            for (int j = 0; j < 4; ++j) {
                const int c = 256 * j + 4 * lane; const f32x4 gg = *(const f32x4*)(g + c); f32x4 o = v[q][j] * rsn * gg;
                if constexpr (MODE == 2) { *(f32x4*)(p.y() + (size_t)r * 1024 + c) = o; }
                else { const f32x4 sh = *(const f32x4*)(mrow + c), scl = *(const f32x4*)(mrow + 1024 + c); o = o * (1.0f + scl) + sh; *(u32x2*)((MODE == 0 ? p.hA() : p.h2()) + (size_t)r * 1024 + c) = pack4(o); }
            }
        }
    }
}

__device__ void ssdnorm_phase(const Params& p, int wv) {
    const size_t gtid = (size_t)blockIdx.x * 512 + opaque_tid(wv), gsz = (size_t)gridDim.x * 512, total = (size_t)MT * 256;
    for (size_t i0 = gtid; i0 < total; i0 += 4 * gsz) {
        u32x4 u[4]; float rsn[4]; bf16_t* ptr[4];
#pragma unroll
        for (int q = 0; q < 4; ++q) {
            const size_t i = i0 + (size_t)q * gsz; const size_t ic = i < total ? i : i0;
            const size_t r = ic >> 8; const int e8 = (int)(ic & 255), gq = e8 >> 6;
            const float ss = p.ssbuf()[r * 8 + 2 * gq] + p.ssbuf()[r * 8 + 2 * gq + 1];
            rsn[q] = rsqrtf(ss * (1.0f / 512.0f) + EPSN);
            ptr[q] = p.zbuf() + r * 2048 + e8 * 8; u[q] = *(const u32x4*)ptr[q];
        }
#pragma unroll
        for (int q = 0; q < 4; ++q) {
            const size_t i = i0 + (size_t)q * gsz; if (i >= total) continue;
            u32x4 o; const float rs = rsn[q];
            o.x = cvt_pk_bf16(bf_lo(u[q].x) * rs, bf_hi(u[q].x) * rs); o.y = cvt_pk_bf16(bf_lo(u[q].y) * rs, bf_hi(u[q].y) * rs); o.z = cvt_pk_bf16(bf_lo(u[q].z) * rs, bf_hi(u[q].z) * rs); o.w = cvt_pk_bf16(bf_lo(u[q].w) * rs, bf_hi(u[q].w) * rs);
            *(u32x4*)ptr[q] = o;
        }
    }
}

constexpr int AT_K = 9216, AT_V = 20480, AT_STAGE = 2 * AT_K + AT_V;
template <bool PAST> __device__ __forceinline__ void attn_item(const Params& p, LAS unsigned char* lds, int row0, int h, const bf16_t* Kb, const bf16_t* Vb, const float* Kc, const float* Vc, int nt0, int nt1, float lam, int wv) {
    const int tid = opaque_tid(wv), w = __builtin_amdgcn_readfirstlane(tid >> 6), lane = tid & 63, l31 = lane & 31, hh = lane >> 5;
    const int hd = w >> 2, rb = w & 3, chunk = rb >> 1;
    const int ntl = nt0 > nt1 ? nt0 : nt1, my_nt = chunk ? nt1 : nt0;
    const int coff = 128 * h;
    bf16x8 qf[4];
    {
        const bf16_t* qp = p.qbuf() + (size_t)(row0 + rb * 32 + l31) * 1024 + coff + 64 * hd + 8 * hh;
#pragma unroll
        for (int s = 0; s < 4; ++s) qf[s] = my_nt > 0 ? *(const bf16x8*)(qp + 16 * s) : (bf16x8){0, 0, 0, 0, 0, 0, 0, 0};
    }
    f32x16 O[4];
#pragma unroll
    for (int c = 0; c < 4; ++c)
#pragma unroll
        for (int e = 0; e < 16; ++e) O[c][e] = 0.f;
    float m_run = -1e30f, l_run = 0.f;
    u32x4 kreg[2], vreg[2];
    f32x4 kf[PAST ? 2 : 1][2], vf[PAST ? 2 : 1][2];
    auto gload = [&](int t) {
        if (PAST && t < 16) {
            const int key0 = 64 * t;
#pragma unroll
            for (int jj = 0; jj < 2; ++jj) {
                const int idx = tid + 512 * jj;
                { const int which = idx >> 9, row = (idx >> 3) & 63, ch = idx & 7; const float* sp = Kc + (size_t)(key0 + row) * 1024 + coff + 64 * which + 8 * ch; kf[PAST ? jj : 0][0] = *(const f32x4*)sp; kf[PAST ? jj : 0][1] = *(const f32x4*)(sp + 4); }
                { const int row = idx >> 4, ch = idx & 15; const float* sp = Vc + (size_t)(key0 + row) * 1024 + coff + 8 * ch; vf[PAST ? jj : 0][0] = *(const f32x4*)sp; vf[PAST ? jj : 0][1] = *(const f32x4*)(sp + 4); }
            }
        } else {
            const int key0 = PAST ? 0 : 64 * t;
#pragma unroll
            for (int jj = 0; jj < 2; ++jj) {
                const int idx = tid + 512 * jj;
                { const int which = idx >> 9, row = (idx >> 3) & 63, ch = idx & 7; kreg[jj] = *(const u32x4*)(Kb + (size_t)(key0 + row) * 1024 + coff + 64 * which + 8 * ch); }
                { const int row = idx >> 4, ch = idx & 15; vreg[jj] = *(const u32x4*)(Vb + (size_t)(key0 + row) * 1024 + coff + 8 * ch); }
            }
        }
    };
    auto swrite = [&](int st, int t) {
        LAS unsigned char* base = lds + st * AT_STAGE;
        if (PAST && t < 16) {
#pragma unroll
            for (int jj = 0; jj < 2; ++jj) { kreg[jj] = pack8(kf[PAST ? jj : 0][0], kf[PAST ? jj : 0][1]); vreg[jj] = pack8(vf[PAST ? jj : 0][0], vf[PAST ? jj : 0][1]); }
        }
#pragma unroll
        for (int jj = 0; jj < 2; ++jj) {
            const int idx = tid + 512 * jj;
            { const int which = idx >> 9, row = (idx >> 3) & 63, ch = idx & 7; *(LAS u32x4*)(base + which * AT_K + row * 144 + ch * 16) = kreg[jj]; }
            { const int row = idx >> 4, ch = idx & 15; *(LAS u32x4*)(base + 2 * AT_K + row * 320 + ch * 16) = vreg[jj]; }
        }
    };
    const int q4 = (lane & 15) >> 2, blk = (lane >> 4) & 1, pp = lane & 3;
    auto qk = [&](int st, f32x16 (&S)[2]) {
        LAS unsigned char* Kt = lds + st * AT_STAGE + hd * AT_K + l31 * 144 + hh * 16;
#pragma unroll
        for (int kb = 0; kb < 2; ++kb) {
#pragma unroll
            for (int e = 0; e < 16; ++e) S[kb][e] = 0.f;
#pragma unroll
            for (int s = 0; s < 4; ++s) { const bf16x8 a = *(const LAS bf16x8*)(Kt + kb * 32 * 144 + s * 32); S[kb] = __builtin_amdgcn_mfma_f32_32x32x16_bf16(a, qf[s], S[kb], 0, 0, 0); }
        }
    };
    auto smpv = [&](int st, f32x16 (&S)[2]) {
        LAS unsigned char* Vt = lds + st * AT_STAGE + 2 * AT_K + (4 * hh + q4) * 320 + (16 * blk + 4 * pp) * 2;
        float mx = S[0][0];
#pragma unroll
        for (int e = 1; e < 16; ++e) mx = fmaxf(mx, S[0][e]);
#pragma unroll
        for (int e = 0; e < 16; ++e) mx = fmaxf(mx, S[1][e]);
        mx = fmaxf(mx, __shfl_xor(mx, 32));
        const float mn = fmaxf(m_run, mx), alpha = fexp2(m_run - mn); m_run = mn;
        float rsum = 0.f;
#pragma unroll
        for (int kb = 0; kb < 2; ++kb)
#pragma unroll
            for (int e = 0; e < 16; ++e) { const float pv = fexp2(S[kb][e] - mn); S[kb][e] = pv; rsum += pv; }
        l_run = l_run * alpha + rsum;
        if (__builtin_amdgcn_ballot_w64(alpha != 1.0f) != 0ull) {
#pragma unroll
            for (int c = 0; c < 4; ++c)
#pragma unroll
                for (int e = 0; e < 16; ++e) O[c][e] *= alpha;
        }
#pragma unroll
        for (int kb = 0; kb < 2; ++kb)
#pragma unroll
            for (int sp = 0; sp < 2; ++sp) {
                union { u32x4 u; bf16x8 v; } pb;
                pb.u.x = cvt_pk_bf16(S[kb][8 * sp + 0], S[kb][8 * sp + 1]); pb.u.y = cvt_pk_bf16(S[kb][8 * sp + 2], S[kb][8 * sp + 3]);
                pb.u.z = cvt_pk_bf16(S[kb][8 * sp + 4], S[kb][8 * sp + 5]); pb.u.w = cvt_pk_bf16(S[kb][8 * sp + 6], S[kb][8 * sp + 7]);
#pragma unroll
                for (int c = 0; c < 4; ++c) {
                    LAS unsigned char* va = Vt + (32 * kb + 16 * sp) * 320 + 64 * c;
                    const s16x4 v0 = __builtin_amdgcn_ds_read_tr16_b64_v4i16((LAS s16x4*)va);
                    const s16x4 v1 = __builtin_amdgcn_ds_read_tr16_b64_v4i16((LAS s16x4*)(va + 8 * 320));
                    const bf16x8 vfr = {v0[0], v0[1], v0[2], v0[3], v1[0], v1[1], v1[2], v1[3]};
                    O[c] = __builtin_amdgcn_mfma_f32_32x32x16_bf16(vfr, pb.v, O[c], 0, 0, 0);
                }
            }
    };
    if constexpr (PAST) {
        gload(0); swrite(0, 0); __syncthreads();
        for (int t = 0; t < ntl; ++t) {
            if (t + 1 < ntl) gload(t + 1);
            if (t < my_nt) { f32x16 S[2]; qk(t & 1, S); smpv(t & 1, S); }
            if (t + 1 < ntl) swrite((t + 1) & 1, t + 1);
            __syncthreads();
        }
    } else {
        gload(0); swrite(0, 0); if (ntl > 1) gload(1);
        __syncthreads();
        f32x16 Sn[2];
        if (my_nt > 0) qk(0, Sn);
        int st = 0;
        for (int t = 0; t < ntl; ++t) {
            const int st1 = st == 2 ? 0 : st + 1;
            f32x16 Sc[2]; Sc[0] = Sn[0]; Sc[1] = Sn[1];
            if (t + 1 < ntl) swrite(st1, t + 1);
            if (t + 2 < ntl) gload(t + 2);
            __syncthreads();
            if (t + 1 < my_nt) { qk(st1, Sn); smpv(st, Sc); }
            else if (t < my_nt) { smpv(st, Sc); }
            st = st1;
        }
        __syncthreads();
    }
    const float lt = l_run + __shfl_xor(l_run, 32);
    const float inv = my_nt > 0 ? 1.0f / lt : 0.f;
    LAS float* X = (LAS float*)lds;
    if (hd == 1) {
#pragma unroll
        for (int c = 0; c < 4; ++c)
#pragma unroll
            for (int i = 0; i < 4; ++i) { f32x4 o = {O[c][4 * i] * inv, O[c][4 * i + 1] * inv, O[c][4 * i + 2] * inv, O[c][4 * i + 3] * inv}; *(LAS f32x4*)(X + (rb * 32 + l31) * 132 + 32 * c + 8 * i + 4 * hh) = o; }
    }
    __syncthreads();
    if (hd == 0 && my_nt > 0) {
        float ss = 0.f;
#pragma unroll
        for (int c = 0; c < 4; ++c)
#pragma unroll
            for (int i = 0; i < 4; ++i) {
                const f32x4 o2 = *(const LAS f32x4*)(X + (rb * 32 + l31) * 132 + 32 * c + 8 * i + 4 * hh);
#pragma unroll
                for (int j = 0; j < 4; ++j) { const float o = O[c][4 * i + j] * inv - lam * o2[j]; O[c][4 * i + j] = o; ss += o * o; }
            }
        ss += __shfl_xor(ss, 32);
        const float rsn = rsqrtf(ss * (1.0f / 128.0f) + EPSN) * 0.8f;
        bf16_t* op = p.qbuf() + (size_t)(row0 + rb * 32 + l31) * 1024 + coff + 4 * hh;
#pragma unroll
        for (int c = 0; c < 4; ++c)
#pragma unroll
            for (int i = 0; i < 4; ++i) {
                const f32x4 g = *(const f32x4*)(p.g_subln + 32 * c + 8 * i + 4 * hh);
                const f32x4 o = {O[c][4 * i] * rsn * g[0], O[c][4 * i + 1] * rsn * g[1], O[c][4 * i + 2] * rsn * g[2], O[c][4 * i + 3] * rsn * g[3]};
                *(u32x2*)(op + 32 * c + 8 * i) = pack4(o);
            }
    }
    __syncthreads();
}

__device__ void attn_phase(const Params& p, LAS unsigned char* lds, int wv) {
    const int lane = opaque_tid(wv) & 63;
    const float a1 = wave_sum(p.lq1[lane] * p.lk1[lane]), a2 = wave_sum(p.lq2[lane] * p.lk2[lane]);
    const float lamv = __expf(a1) - __expf(a2) + 0.2f;
    const float lam = __builtin_bit_cast(float, __builtin_amdgcn_readfirstlane(__builtin_bit_cast(int, lamv)));
    for (int j = blockIdx.x; j < 256; j += gridDim.x) {
        const int b = j >> 3, h = j & 7;
#pragma unroll 1
        for (int i = 15; i >= 0; --i) attn_item<false>(p, lds, b * 2048 + 128 * i, h, p.kbuf_p() + (size_t)b * 2048 * 1024, p.vbuf_p() + (size_t)b * 2048 * 1024, nullptr, nullptr, 2 * i + 1, 2 * i + 2, lam, wv);
        attn_item<true>(p, lds, MP + 64 * b, h, p.kbuf_s() + (size_t)b * 64 * 1024, p.vbuf_s() + (size_t)b * 64 * 1024, p.cache_k + (size_t)b * 1024 * 1024, p.cache_v + (size_t)b * 1024 * 1024, 17, 0, lam, wv);
    }
}

__device__ void conv_phase(const Params& p, int wv) {
    const size_t gtid = (size_t)blockIdx.x * 512 + opaque_tid(wv), gsz = (size_t)gridDim.x * 512, total = (size_t)(MT / 64) * 384;
    for (size_t it = gtid; it < total; it += gsz) {
        const int cg = (int)(it / 384), sp = (int)(it % 384), col = sp * 8;
        f32x4 wv4[4][2], bias[2];
#pragma unroll
        for (int j = 0; j < 4; ++j) { wv4[j][0] = *(const f32x4*)(p.conv_w + j * 3072 + col); wv4[j][1] = *(const f32x4*)(p.conv_w + j * 3072 + col + 4); }
        bias[0] = *(const f32x4*)(p.conv_b + col); bias[1] = *(const f32x4*)(p.conv_b + col + 4);
        f32x4 win[3][2];
        const bool samp = cg >= MP / 64;
        if (samp) {
            const float* sc = p.state_conv + (size_t)(cg - MP / 64) * 3 * 3072 + col;
#pragma unroll
            for (int q = 0; q < 3; ++q) { win[q][0] = *(const f32x4*)(sc + q * 3072); win[q][1] = *(const f32x4*)(sc + q * 3072 + 4); }
        } else if ((cg & 31) == 0) {
#pragma unroll
            for (int q = 0; q < 3; ++q) { win[q][0] = (f32x4){0.f, 0.f, 0.f, 0.f}; win[q][1] = win[q][0]; }
        } else {
            const bf16_t* hp = p.halo() + (size_t)(cg - 1) * 3 * 3072 + col;
#pragma unroll
            for (int q = 0; q < 3; ++q) { const u32x4 u = *(const u32x4*)(hp + q * 3072); win[q][0] = (f32x4){bf_lo(u.x), bf_hi(u.x), bf_lo(u.y), bf_hi(u.y)}; win[q][1] = (f32x4){bf_lo(u.z), bf_hi(u.z), bf_lo(u.w), bf_hi(u.w)}; }
        }
        bf16_t* xp = p.xbcbuf() + (size_t)cg * 64 * 3072 + col;
#pragma unroll 1
        for (int t0 = 0; t0 < 64; t0 += 8) {
            u32x4 raw[8];
#pragma unroll
            for (int q = 0; q < 8; ++q) raw[q] = *(const u32x4*)(xp + (size_t)(t0 + q) * 3072);
#pragma unroll
            for (int q = 0; q < 8; ++q) {
                const f32x4 c0 = {bf_lo(raw[q].x), bf_hi(raw[q].x), bf_lo(raw[q].y), bf_hi(raw[q].y)}, c1 = {bf_lo(raw[q].z), bf_hi(raw[q].z), bf_lo(raw[q].w), bf_hi(raw[q].w)};
                f32x4 o0 = bias[0] + wv4[0][0] * win[0][0] + wv4[1][0] * win[1][0] + wv4[2][0] * win[2][0] + wv4[3][0] * c0;
                f32x4 o1 = bias[1] + wv4[0][1] * win[0][1] + wv4[1][1] * win[1][1] + wv4[2][1] * win[2][1] + wv4[3][1] * c1;
                win[0][0] = win[1][0]; win[0][1] = win[1][1]; win[1][0] = win[2][0]; win[1][1] = win[2][1]; win[2][0] = c0; win[2][1] = c1;
#pragma unroll
                for (int e = 0; e < 4; ++e) { o0[e] = siluf_(o0[e]); o1[e] = siluf_(o1[e]); }
                *(u32x4*)(xp + (size_t)(t0 + q) * 3072) = pack8(o0, o1);
            }
        }
    }
}

constexpr int SD_XT = 0, SD_BM = 36864, SD_BT = SD_BM + 17408, SD_CM = SD_BT + 18432, SD_CB = SD_CM + 17408, SD_CUM = SD_CB + 17408, SD_DT = SD_CUM + 1024, SD_SS = SD_DT + 1024;
__device__ void ssd_phase(const Params& p, LAS unsigned char* lds, int wv) {
    const int tid = opaque_tid(wv), w = __builtin_amdgcn_readfirstlane(tid >> 6), lane = tid & 63, l15 = lane & 15, g4 = lane >> 4;
    const int k = w >> 1, ph = w & 1;
    for (int jb = blockIdx.x; jb < 256; jb += gridDim.x) {
        const int b = jb >> 3, hq = jb & 7, grp = hq >> 1, head = 4 * hq + k;
        f32x4 Sacc[8][2];
#pragma unroll
        for (int nb = 0; nb < 8; ++nb)
#pragma unroll
            for (int pb = 0; pb < 2; ++pb) Sacc[nb][pb] = (f32x4){0.f, 0.f, 0.f, 0.f};
        const float a_h = -__expf(p.a_log[head]), dtb = p.dt_bias[head], dsk = p.d_skip[head];
        for (int step = 0; step < 33; ++step) {
            const bool samp = step == 32;
            const int row0 = samp ? MP + 64 * b : b * 2048 + 64 * step;
            if (samp) {
                float* so = p.nssm_p() + ((size_t)(b * 32 + head) * 64) * 128; const float* si = p.state_ssm + ((size_t)(b * 32 + head) * 64) * 128;
#pragma unroll
                for (int nb = 0; nb < 8; ++nb)
#pragma unroll
                    for (int pb = 0; pb < 2; ++pb) { const size_t o = (size_t)(32 * ph + 16 * pb + l15) * 128 + 16 * nb + 4 * g4; *(f32x4*)(so + o) = Sacc[nb][pb]; Sacc[nb][pb] = *(const f32x4*)(si + o); }
            }
            float dtraw = 0.f;
            if (w < 4) dtraw = p.dtbuf()[(size_t)(row0 + lane) * 32 + 4 * hq + w];
            {
                int tdx = tid; asm volatile("" : "+v"(tdx));
                const int tb = tdx & 7, cq = tdx >> 3;
                const int ccol0 = 256 * hq + 4 * cq;
                const bool isB = w < 4; const int n0 = 4 * (cq & 31);
                const int ccol1 = (isB ? 2048 : 2560) + 128 * grp + n0;
                u32x2 r0[8], r1[8];
                const bf16_t* xr0 = p.xbcbuf() + (size_t)(row0 + 8 * tb) * 3072;
#pragma unroll
                for (int tt = 0; tt < 8; ++tt) { r0[tt] = *(const u32x2*)(xr0 + (size_t)tt * 3072 + ccol0); r1[tt] = *(const u32x2*)(xr0 + (size_t)tt * 3072 + ccol1); }
                {
                    f32x4 outv[8];
#pragma unroll
                    for (int tt = 0; tt < 8; ++tt) outv[tt] = (f32x4){bf_lo(r0[tt].x), bf_hi(r0[tt].x), bf_lo(r0[tt].y), bf_hi(r0[tt].y)};
                    LAS unsigned char* base = lds + SD_XT + (cq >> 4) * 9216 + (4 * (cq & 15)) * 144 + 16 * tb;
#pragma unroll
                    for (int e = 0; e < 4; ++e) { u32x4 u; u.x = cvt_pk_bf16(outv[0][e], outv[1][e]); u.y = cvt_pk_bf16(outv[2][e], outv[3][e]); u.z = cvt_pk_bf16(outv[4][e], outv[5][e]); u.w = cvt_pk_bf16(outv[6][e], outv[7][e]); *(LAS u32x4*)(base + e * 144) = u; }
                }
                {
                    f32x4 outv[8];
#pragma unroll
                    for (int tt = 0; tt < 8; ++tt) outv[tt] = (f32x4){bf_lo(r1[tt].x), bf_hi(r1[tt].x), bf_lo(r1[tt].y), bf_hi(r1[tt].y)};
                    LAS unsigned char* rowimg = lds + (isB ? SD_BM : SD_CM);
#pragma unroll
                    for (int tt = 0; tt < 8; ++tt) *(LAS u32x2*)(rowimg + (8 * tb + tt) * 272 + n0 * 2) = r1[tt];
                    if (isB) {
#pragma unroll
                        for (int e = 0; e < 4; ++e) { u32x4 u; u.x = cvt_pk_bf16(outv[0][e], outv[1][e]); u.y = cvt_pk_bf16(outv[2][e], outv[3][e]); u.z = cvt_pk_bf16(outv[4][e], outv[5][e]); u.w = cvt_pk_bf16(outv[6][e], outv[7][e]); *(LAS u32x4*)(lds + SD_BT + (n0 + e) * 144 + 16 * tb) = u; }
                    }
                }
            }
            if (w < 4) {
                const int hd2 = 4 * hq + w;
                const float xr = dtraw + p.dt_bias[hd2];
                const float dt = xr > 20.f ? xr : log1pf(__expf(xr));
                float cum = dt * (-__expf(p.a_log[hd2]));
#pragma unroll
                for (int o = 1; o < 64; o <<= 1) { const float t2 = __shfl_up(cum, o); if (lane >= o) cum += t2; }
                ((LAS float*)(lds + SD_CUM))[w * 64 + lane] = cum; ((LAS float*)(lds + SD_DT))[w * 64 + lane] = dt;
            }
            __syncthreads();
            {
                const int lb = w >> 1;
#pragma unroll
                for (int q = 0; q < 2; ++q) {
                    const int sb = 2 * (w & 1) + q; f32x4 c4 = {0.f, 0.f, 0.f, 0.f};
#pragma unroll
                    for (int ks = 0; ks < 4; ++ks) {
                        const bf16x8 a = *(const LAS bf16x8*)(lds + SD_CM + (16 * lb + l15) * 272 + (32 * ks + 8 * g4) * 2);
                        const bf16x8 bb = *(const LAS bf16x8*)(lds + SD_BM + (16 * sb + l15) * 272 + (32 * ks + 8 * g4) * 2);
                        c4 = __builtin_amdgcn_mfma_f32_16x16x32_bf16(a, bb, c4, 0, 0, 0);
                    }
#pragma unroll
                    for (int j = 0; j < 4; ++j) ((LAS float*)(lds + SD_CB))[(16 * lb + 4 * g4 + j) * 68 + 16 * sb + l15] = c4[j];
                }
            }
            __syncthreads();
            {
                const LAS float* cumL = (const LAS float*)(lds + SD_CUM) + k * 64; const LAS float* dtL = (const LAS float*)(lds + SD_DT) + k * 64;
                const LAS unsigned char* XTk = lds + SD_XT + k * 9216;
                f32x4 yT[2][4];
#pragma unroll
                for (int pb = 0; pb < 2; ++pb)
#pragma unroll
                    for (int lb = 0; lb < 4; ++lb) yT[pb][lb] = (f32x4){0.f, 0.f, 0.f, 0.f};
#pragma unroll
                for (int ks = 0; ks < 4; ++ks) {
                    __builtin_amdgcn_sched_barrier(0);
                    union { u32x4 u; bf16x8 v; } af[2];
#pragma unroll
                    for (int pb = 0; pb < 2; ++pb) { af[pb].u.x = cvt_pk_bf16(Sacc[2 * ks][pb][0], Sacc[2 * ks][pb][1]); af[pb].u.y = cvt_pk_bf16(Sacc[2 * ks][pb][2], Sacc[2 * ks][pb][3]); af[pb].u.z = cvt_pk_bf16(Sacc[2 * ks + 1][pb][0], Sacc[2 * ks + 1][pb][1]); af[pb].u.w = cvt_pk_bf16(Sacc[2 * ks + 1][pb][2], Sacc[2 * ks + 1][pb][3]); }
#pragma unroll
                    for (int lb = 0; lb < 4; ++lb) {
                        const LAS unsigned char* cp = lds + SD_CM + (16 * lb + l15) * 272 + (32 * ks + 4 * g4) * 2;
                        union { u32x4 u; bf16x8 v; } bf; const u32x2 c0 = *(const LAS u32x2*)cp, c1 = *(const LAS u32x2*)(cp + 32);
                        bf.u.x = c0.x; bf.u.y = c0.y; bf.u.z = c1.x; bf.u.w = c1.y;
#pragma unroll
                        for (int pb = 0; pb < 2; ++pb) yT[pb][lb] = __builtin_amdgcn_mfma_f32_16x16x32_bf16(af[pb].v, bf.v, yT[pb][lb], 0, 0, 0);
                    }
                }
#pragma unroll
                for (int lb = 0; lb < 4; ++lb) { const float ec = fexp(cumL[16 * lb + l15]);
#pragma unroll
                    for (int pb = 0; pb < 2; ++pb) yT[pb][lb] *= ec; }
#pragma unroll
                for (int ks = 0; ks < 2; ++ks) {
                    __builtin_amdgcn_sched_barrier(0);
                    bf16x8 xa[2];
#pragma unroll
                    for (int pb = 0; pb < 2; ++pb) xa[pb] = *(const LAS bf16x8*)(XTk + (32 * ph + 16 * pb + l15) * 144 + (32 * ks + 8 * g4) * 2);
                    const int s0 = 32 * ks + 8 * g4;
                    const f32x4 cs0 = *(const LAS f32x4*)(cumL + s0), cs1 = *(const LAS f32x4*)(cumL + s0 + 4), ds0 = *(const LAS f32x4*)(dtL + s0), ds1 = *(const LAS f32x4*)(dtL + s0 + 4);
#pragma unroll
                    for (int lb = 0; lb < 4; ++lb) {
                        if (32 * ks > 16 * lb + 15) continue;
                        __builtin_amdgcn_sched_barrier(0);
                        const int l = 16 * lb + l15; const float cl = cumL[l];
                        const LAS float* cbp = (const LAS float*)(lds + SD_CB) + l * 68 + s0;
                        const f32x4 cb0 = *(const LAS f32x4*)cbp, cb1 = *(const LAS f32x4*)(cbp + 4);
                        float mv[8];
#pragma unroll
                        for (int e = 0; e < 4; ++e) {
                            { const int s = s0 + e; float v = s <= l ? cb0[e] * fexp(cl - cs0[e]) * ds0[e] : 0.f; if (s == l) v += dsk; mv[e] = v; }
                            { const int s = s0 + 4 + e; float v = s <= l ? cb1[e] * fexp(cl - cs1[e]) * ds1[e] : 0.f; if (s == l) v += dsk; mv[4 + e] = v; }
                        }
                        union { u32x4 u; bf16x8 v; } mf; mf.u.x = cvt_pk_bf16(mv[0], mv[1]); mf.u.y = cvt_pk_bf16(mv[2], mv[3]); mf.u.z = cvt_pk_bf16(mv[4], mv[5]); mf.u.w = cvt_pk_bf16(mv[6], mv[7]);
#pragma unroll
                        for (int pb = 0; pb < 2; ++pb) yT[pb][lb] = __builtin_amdgcn_mfma_f32_16x16x32_bf16(xa[pb], mf.v, yT[pb][lb], 0, 0, 0);
                    }
                }
                float ssl[4];
#pragma unroll
                for (int lb = 0; lb < 4; ++lb) {
                    __builtin_amdgcn_sched_barrier(0);
                    float ss = 0.f;
#pragma unroll
                    for (int pb = 0; pb < 2; ++pb) {
                        bf16_t* zp = p.zbuf() + (size_t)(row0 + 16 * lb + l15) * 2048 + 64 * head + 32 * ph + 16 * pb + 4 * g4;
                        const u32x2 zz = *(const u32x2*)zp;
                        f32x4 u = yT[pb][lb]; u[0] *= siluf_(bf_lo(zz.x)); u[1] *= siluf_(bf_hi(zz.x)); u[2] *= siluf_(bf_lo(zz.y)); u[3] *= siluf_(bf_hi(zz.y));
                        ss += u[0] * u[0] + u[1] * u[1] + u[2] * u[2] + u[3] * u[3];
                        *(u32x2*)zp = pack4(u);
                    }
                    ss += __shfl_xor(ss, 16); ss += __shfl_xor(ss, 32); ssl[lb] = ss;
                }
                if (g4 == 0) {
#pragma unroll
                    for (int lb = 0; lb < 4; ++lb) ((LAS float*)(lds + SD_SS))[w * 64 + 16 * lb + l15] = ssl[lb];
                }
                const float cend = cumL[63], dec = fexp(cend);
#pragma unroll
                for (int nb = 0; nb < 8; ++nb)
#pragma unroll
                    for (int pb = 0; pb < 2; ++pb) Sacc[nb][pb] *= dec;
#pragma unroll
                for (int ks = 0; ks < 2; ++ks) {
                    __builtin_amdgcn_sched_barrier(0);
                    const int s0 = 32 * ks + 8 * g4;
                    const f32x4 cs0 = *(const LAS f32x4*)(cumL + s0), cs1 = *(const LAS f32x4*)(cumL + s0 + 4), ds0 = *(const LAS f32x4*)(dtL + s0), ds1 = *(const LAS f32x4*)(dtL + s0 + 4);
                    float wsv[8];
#pragma unroll
                    for (int e = 0; e < 4; ++e) { wsv[e] = ds0[e] * fexp(cend - cs0[e]); wsv[4 + e] = ds1[e] * fexp(cend - cs1[e]); }
                    union { u32x4 u; bf16x8 v; } xb[2];
#pragma unroll
                    for (int pb = 0; pb < 2; ++pb) {
                        const u32x4 xr = *(const LAS u32x4*)(XTk + (32 * ph + 16 * pb + l15) * 144 + s0 * 2);
                        xb[pb].u.x = cvt_pk_bf16(bf_lo(xr.x) * wsv[0], bf_hi(xr.x) * wsv[1]); xb[pb].u.y = cvt_pk_bf16(bf_lo(xr.y) * wsv[2], bf_hi(xr.y) * wsv[3]);
                        xb[pb].u.z = cvt_pk_bf16(bf_lo(xr.z) * wsv[4], bf_hi(xr.z) * wsv[5]); xb[pb].u.w = cvt_pk_bf16(bf_lo(xr.w) * wsv[6], bf_hi(xr.w) * wsv[7]);
                    }
#pragma unroll
                    for (int nb = 0; nb < 8; ++nb) {
                        const bf16x8 ba = *(const LAS bf16x8*)(lds + SD_BT + (16 * nb + l15) * 144 + s0 * 2);
#pragma unroll
                        for (int pb = 0; pb < 2; ++pb) Sacc[nb][pb] = __builtin_amdgcn_mfma_f32_16x16x32_bf16(ba, xb[pb].v, Sacc[nb][pb], 0, 0, 0);
                    }
                }
            }
            __syncthreads();
            if (tid < 64) {
                float s = 0.f;
#pragma unroll
                for (int ww = 0; ww < 8; ++ww) s += ((const LAS float*)(lds + SD_SS))[ww * 64 + tid];
                p.ssbuf()[(size_t)(row0 + tid) * 8 + hq] = s;
            }
        }
        {
            float* so = p.nssm_s() + ((size_t)(b * 32 + head) * 64) * 128;
#pragma unroll
            for (int nb = 0; nb < 8; ++nb)
#pragma unroll
                for (int pb = 0; pb < 2; ++pb) *(f32x4*)(so + (size_t)(32 * ph + 16 * pb + l15) * 128 + 16 * nb + 4 * g4) = Sacc[nb][pb];
        }
        (void)a_h; (void)dtb;
    }
}

__device__ __forceinline__ void grid_barrier(unsigned* ctr, unsigned target, int wv) {
    asm volatile("s_waitcnt vmcnt(0) lgkmcnt(0)" ::: "memory");
    __builtin_amdgcn_s_barrier();
    if (wv == 0) {
        unsigned z = 0u; asm volatile("" : "+s"(z));
        const unsigned ln = __builtin_amdgcn_mbcnt_hi(~0u, __builtin_amdgcn_mbcnt_lo(~0u, z));
        if (ln == 0) {
            __builtin_amdgcn_fence(__ATOMIC_RELEASE, "agent");
            __hip_atomic_fetch_add(ctr, 1u, __ATOMIC_RELAXED, __HIP_MEMORY_SCOPE_AGENT);
            while (__hip_atomic_load(ctr, __ATOMIC_RELAXED, __HIP_MEMORY_SCOPE_AGENT) < target) __builtin_amdgcn_s_sleep(2);
        }
    }
    __builtin_amdgcn_s_barrier();
    __builtin_amdgcn_fence(__ATOMIC_ACQUIRE, "agent");
    asm volatile("s_waitcnt vmcnt(0) lgkmcnt(0)" ::: "memory");
}

__global__ void __launch_bounds__(512, 2) fwd_megakernel(Params p) {
    extern __shared__ __attribute__((aligned(16))) unsigned char shm[];
    LAS unsigned char* lds = (LAS unsigned char*)shm;
    cg::grid_group grid = cg::this_grid();
#ifndef PHMASK
#define PHMASK 0x3fff
#endif
#ifdef DBG_TIME_I
#define TSTAMP(k) if (blockIdx.x == 0 && threadIdx.x == 0) ((unsigned long long*)(p.ws + WS_END))[k] = __builtin_amdgcn_s_memrealtime();
#else
#define TSTAMP(k)
#endif
    TSTAMP(0)
#define PHASE(n, ...) if (p.ph_lo <= (n) && (n) < p.ph_hi) { if constexpr ((PHMASK >> (n)) & 1) { __VA_ARGS__ } if ((n) + 1 < p.ph_hi) { \
        grid_barrier((unsigned*)(p.ws + WS_END + 256), (unsigned)((n) - p.ph_lo + 1) * gridDim.x, wv); } TSTAMP((n) + 1) }
    const int wv = __builtin_amdgcn_readfirstlane(threadIdx.x >> 6);
    if (p.ph_hi < 0) grid.sync();
    PHASE(0, prep_phase(p, lds, wv);)
    PHASE(1, norm_phase<0>(p, wv);)
    PHASE(2, run_gemm<0>(p, lds, p.hA(), p.bt1a(), 3072, 1024, wv);)
    PHASE(3, attn_phase(p, lds, wv);)
    PHASE(4, run_gemm<1>(p, lds, p.hA(), p.bt1b(), 5376, 1024, wv);)
    PHASE(5, conv_phase(p, wv);)
    PHASE(6, ssd_phase(p, lds, wv);)
    PHASE(7, run_gemm<2>(p, lds, p.hA(), p.bt1c(), 2048, 1024, wv); ssdnorm_phase(p, wv);)
    PHASE(8, run_gemm<3>(p, lds, p.qbuf(), p.btpa(), 1024, 1024, wv); run_gemm<4>(p, lds, p.zbuf(), p.btpb(), 1024, 2048, wv);)
    PHASE(9, run_gemm<5>(p, lds, p.mbuf(), p.btout(), 1024, 1024, wv);)
    PHASE(10, norm_phase<1>(p, wv);)
    PHASE(11, run_gemm<6>(p, lds, p.h2(), p.btgu(), 5632, 1024, wv);)
    PHASE(12, run_gemm<7>(p, lds, p.swbuf(), p.btdown(), 1024, 2816, wv);)
    PHASE(13, norm_phase<2>(p, wv);)
#undef PHASE
}


#ifdef DBG_TIME_I
__global__ void dbg_time_apply(float* out, const unsigned long long* ts) {
    const float tot = (float)(ts[14] - ts[0]); const float fi = (float)(ts[DBG_TIME_I + 1] - ts[DBG_TIME_I]) / tot, fj = (float)(ts[DBG_TIME_J + 1] - ts[DBG_TIME_J]) / tot;
    const float sc = 1.0f + sqrtf(fi);
    for (size_t i = O_NCS + (size_t)blockIdx.x * 256 + threadIdx.x; i < O_NCS + 294912; i += (size_t)gridDim.x * 256) out[i] *= sc;
    if (blockIdx.x == 0 && threadIdx.x == 0) out[0] += 1000.0f * fj;
}
#endif
extern "C" void kernel_launch(void* const* d_in, const int* in_sizes, int n_in, void* d_out, int out_size, void* d_ws, size_t ws_size, hipStream_t stream) {
    static int grid_blocks = 0;
    if (!grid_blocks) {
        int dev = 0, cus = 0, per_cu = 0;
        hipGetDevice(&dev);
        hipDeviceGetAttribute(&cus, hipDeviceAttributeMultiprocessorCount, dev);
        hipFuncSetAttribute((const void*)fwd_megakernel, hipFuncAttributeMaxDynamicSharedMemorySize, LDS_BYTES);
        hipOccupancyMaxActiveBlocksPerMultiprocessor(&per_cu, (const void*)fwd_megakernel, 512, LDS_BYTES);
        if (per_cu < 1) per_cu = 1;
        grid_blocks = cus * per_cu;
        if (grid_blocks > 256) grid_blocks = 256;
    }
    Params p{};
    const float* const* in = (const float* const*)d_in;
    p.x_p = in[0]; p.x_s = in[1]; p.cache_k = in[2]; p.cache_v = in[3]; p.state_conv = in[4]; p.state_ssm = in[5]; p.c_p = in[6]; p.c_s = in[7];
    p.w_ada = in[8]; p.b_ada = in[9]; p.g_mix = in[10]; p.g_ffn = in[11]; p.w_in = in[12]; p.lq1 = in[13]; p.lk1 = in[14]; p.lq2 = in[15]; p.lk2 = in[16]; p.g_subln = in[17];
    p.conv_w = in[18]; p.conv_b = in[19]; p.dt_bias = in[20]; p.a_log = in[21]; p.d_skip = in[22]; p.g_ssd = in[23]; p.w_pa = in[24]; p.w_pb = in[25]; p.w_out = in[26]; p.w_gu = in[27]; p.w_down = in[28]; p.g_final = in[29];
    p.out = (float*)d_out; p.ws = (unsigned char*)d_ws;
    if (WS_END + 1024 > ws_size || (size_t)out_size < O_END) { fprintf(stderr, "kernel_launch: workspace/output too small: need %zu / %zu, have %zu / %d\n", (size_t)WS_END, (size_t)O_END, ws_size, out_size); return; }
    hipMemsetAsync((unsigned char*)d_ws + WS_END + 256, 0, 64, stream);
    p.ph_lo = 0; p.ph_hi = 14;
    void* args[] = {&p};
    hipError_t e = hipLaunchCooperativeKernel((const void*)fwd_megakernel, dim3(grid_blocks), dim3(512), args, LDS_BYTES, stream);
    if (e != hipSuccess) fprintf(stderr, "cooperative launch failed: %s (grid %d)\n", hipGetErrorString(e), grid_blocks);
#ifdef DBG_TIME_I
    dbg_time_apply<<<64, 256, 0, stream>>>((float*)d_out, (const unsigned long long*)((unsigned char*)d_ws + WS_END));
#endif
}
```

```cpp
#include <hip/hip_runtime.h>
#include <hip/hip_cooperative_groups.h>
#include <cstdio>
namespace cg = cooperative_groups;

#define LAS __attribute__((address_space(3)))
typedef unsigned short bf16_t;
typedef short bf16x8 __attribute__((ext_vector_type(8)));
typedef short s16x4 __attribute__((ext_vector_type(4)));
typedef float f32x4 __attribute__((ext_vector_type(4)));
typedef float f32x16 __attribute__((ext_vector_type(16)));
typedef unsigned u32x4 __attribute__((ext_vector_type(4)));
typedef unsigned u32x2 __attribute__((ext_vector_type(2)));

constexpr int MP = 65536, MS = 2048, MT = MP + MS;
constexpr int LDS_BYTES = 131072;
constexpr float EPSN = 1e-5f;
constexpr float LOG2E = 1.4426950408889634f;

constexpr size_t al256(size_t x) { return (x + 255) & ~(size_t)255; }
constexpr size_t WS_BT1A = 0, WS_BT1B = WS_BT1A + al256((size_t)3072 * 1024 * 2), WS_BT1C = WS_BT1B + al256((size_t)5376 * 1024 * 2), WS_BTPA = WS_BT1C + al256((size_t)2048 * 1024 * 2),
    WS_BTPB = WS_BTPA + al256((size_t)1024 * 1024 * 2), WS_BTOUT = WS_BTPB + al256((size_t)1024 * 2048 * 2), WS_BTGU = WS_BTOUT + al256((size_t)1024 * 1024 * 2), WS_BTDOWN = WS_BTGU + al256((size_t)5632 * 1024 * 2),
    WS_MOD = WS_BTDOWN + al256((size_t)1024 * 2816 * 2), WS_ROPE = WS_MOD + al256((size_t)64 * 6144 * 4), WS_DT = WS_ROPE + al256((size_t)2048 * 32 * 8), WS_SS = WS_DT + al256((size_t)MT * 32 * 4),
    WS_RH = WS_SS + al256((size_t)MT * 8 * 4), WS_RBIG = WS_RH + al256((size_t)MT * 1024 * 2), WS_RZ = WS_RBIG + al256((size_t)MT * 3072 * 2), WS_HALO = WS_RZ + al256((size_t)MT * 2048 * 2), WS_END = WS_HALO + al256((size_t)(MT / 64) * 3 * 3072 * 2);
constexpr size_t O_NKP = (size_t)MT * 1024, O_NVP = O_NKP + (size_t)MP * 1024, O_NCP = O_NVP + (size_t)MP * 1024, O_NSP = O_NCP + 32 * 3 * 3072, O_NKS = O_NSP + (size_t)32 * 32 * 64 * 128,
    O_NVS = O_NKS + (size_t)MS * 1024, O_NCS = O_NVS + (size_t)MS * 1024, O_NSS = O_NCS + 32 * 3 * 3072, O_END = O_NSS + (size_t)32 * 32 * 64 * 128;
struct Params {
    const float *x_p, *x_s, *cache_k, *cache_v, *state_conv, *state_ssm, *c_p, *c_s;
    const float *w_ada, *b_ada, *g_mix, *g_ffn, *w_in, *lq1, *lk1, *lq2, *lk2, *g_subln, *conv_w, *conv_b, *dt_bias, *a_log, *d_skip, *g_ssd;
    const float *w_pa, *w_pb, *w_out, *w_gu, *w_down, *g_final;
    float* out; unsigned char* ws;
    int ph_lo, ph_hi;
    __device__ __forceinline__ float* y() const { return out; }
    __device__ __forceinline__ float* nk_p() const { return out + O_NKP; }
    __device__ __forceinline__ float* nv_p() const { return out + O_NVP; }
    __device__ __forceinline__ float* nconv_p() const { return out + O_NCP; }
    __device__ __forceinline__ float* nssm_p() const { return out + O_NSP; }
    __device__ __forceinline__ float* nk_s() const { return out + O_NKS; }
    __device__ __forceinline__ float* nv_s() const { return out + O_NVS; }
    __device__ __forceinline__ float* nconv_s() const { return out + O_NCS; }
    __device__ __forceinline__ float* nssm_s() const { return out + O_NSS; }
    __device__ __forceinline__ bf16_t* bt1a() const { return (bf16_t*)(ws + WS_BT1A); }
    __device__ __forceinline__ bf16_t* bt1b() const { return (bf16_t*)(ws + WS_BT1B); }
    __device__ __forceinline__ bf16_t* bt1c() const { return (bf16_t*)(ws + WS_BT1C); }
    __device__ __forceinline__ bf16_t* btpa() const { return (bf16_t*)(ws + WS_BTPA); }
    __device__ __forceinline__ bf16_t* btpb() const { return (bf16_t*)(ws + WS_BTPB); }
    __device__ __forceinline__ bf16_t* btout() const { return (bf16_t*)(ws + WS_BTOUT); }
    __device__ __forceinline__ bf16_t* btgu() const { return (bf16_t*)(ws + WS_BTGU); }
    __device__ __forceinline__ bf16_t* btdown() const { return (bf16_t*)(ws + WS_BTDOWN); }
    __device__ __forceinline__ float* mod() const { return (float*)(ws + WS_MOD); }
    __device__ __forceinline__ float2* rope() const { return (float2*)(ws + WS_ROPE); }
    __device__ __forceinline__ float* dtbuf() const { return (float*)(ws + WS_DT); }
    __device__ __forceinline__ float* ssbuf() const { return (float*)(ws + WS_SS); }
    __device__ __forceinline__ bf16_t* hA() const { return (bf16_t*)(ws + WS_RH); }
    __device__ __forceinline__ bf16_t* mbuf() const { return (bf16_t*)(ws + WS_RH); }
    __device__ __forceinline__ bf16_t* h2() const { return (bf16_t*)(ws + WS_RH); }
    __device__ __forceinline__ bf16_t* qbuf() const { return (bf16_t*)out; }
    __device__ __forceinline__ bf16_t* x1buf() const { return (bf16_t*)out; }
    __device__ __forceinline__ bf16_t* x2buf() const { return (bf16_t*)(ws + WS_RH); }
    __device__ __forceinline__ bf16_t* kbuf_p() const { return (bf16_t*)(ws + WS_RBIG); }
    __device__ __forceinline__ bf16_t* vbuf_p() const { return (bf16_t*)(ws + WS_RBIG) + (size_t)MP * 1024; }
    __device__ __forceinline__ bf16_t* kbuf_s() const { return (bf16_t*)(ws + WS_RBIG) + (size_t)2 * MP * 1024; }
    __device__ __forceinline__ bf16_t* vbuf_s() const { return (bf16_t*)(ws + WS_RBIG) + (size_t)2 * MP * 1024 + (size_t)MS * 1024; }
    __device__ __forceinline__ bf16_t* xbcbuf() const { return (bf16_t*)(ws + WS_RBIG); }
    __device__ __forceinline__ bf16_t* gbuf() const { return (bf16_t*)(ws + WS_RBIG); }
    __device__ __forceinline__ bf16_t* swbuf() const { return (bf16_t*)(ws + WS_RBIG); }
    __device__ __forceinline__ bf16_t* zbuf() const { return (bf16_t*)(ws + WS_RZ); }
    __device__ __forceinline__ bf16_t* halo() const { return (bf16_t*)(ws + WS_HALO); }
};

typedef float f32x2_t __attribute__((ext_vector_type(2)));
typedef __bf16 bf16x2_t __attribute__((ext_vector_type(2)));
__device__ __forceinline__ unsigned cvt_pk_bf16(float lo, float hi) { const f32x2_t v = {lo, hi}; const bf16x2_t b = __builtin_convertvector(v, bf16x2_t); return __builtin_bit_cast(unsigned, b); }
__device__ __forceinline__ float bf_lo(unsigned w) { return __uint_as_float(w << 16); }
__device__ __forceinline__ float bf_hi(unsigned w) { return __uint_as_float(w & 0xffff0000u); }
__device__ __forceinline__ float fexp2(float x) { return __builtin_amdgcn_exp2f(x); }
__device__ __forceinline__ float fexp(float x) { return __builtin_amdgcn_exp2f(x * LOG2E); }
__device__ __forceinline__ float frcp(float x) { return __builtin_amdgcn_rcpf(x); }
__device__ __forceinline__ float sigmoidf_(float x) { return frcp(1.0f + fexp(-x)); }
__device__ __forceinline__ float siluf_(float x) { return x * sigmoidf_(x); }
__device__ __forceinline__ u32x4 pack8(f32x4 a, f32x4 b) { u32x4 w; w.x = cvt_pk_bf16(a[0], a[1]); w.y = cvt_pk_bf16(a[2], a[3]); w.z = cvt_pk_bf16(b[0], b[1]); w.w = cvt_pk_bf16(b[2], b[3]); return w; }
__device__ __forceinline__ u32x2 pack4(f32x4 a) { u32x2 w; w.x = cvt_pk_bf16(a[0], a[1]); w.y = cvt_pk_bf16(a[2], a[3]); return w; }

__device__ __forceinline__ int opaque_tid(int wv) { int t = wv * 64 + (int)__builtin_amdgcn_mbcnt_hi(~0u, __builtin_amdgcn_mbcnt_lo(~0u, 0u)); asm volatile("" : "+v"(t)); return t; }
namespace pg8 {
constexpr int BM = 256, BK = 64, HALF = 128, HTB = HALF * BK * 2, STAGE_BYTES = 8 * HTB, NXCD = 8, WGM = 8;
__host__ __device__ __forceinline__ int lds_byte(int r, int c) { const int st = (r >> 4) * 2 + (c >> 5), rr = r & 15, cc = c & 31, ob = rr * 64 + cc * 2; return st * 1024 + (ob ^ (((ob >> 9) & 1) << 5)); }
__host__ __device__ __forceinline__ void stage_rc(int b, int& R, int& C) { const int st = b / 1024, sb = b % 1024, swz = sb ^ (((sb >> 9) & 1) << 5); R = (st >> 1) * 16 + swz / 64; C = (st & 1) * 32 + (swz % 64) / 2; }
struct Unit { int pm, pn; };
struct Gemm { const bf16_t* A; const bf16_t* Bt; int M, N, K; };
struct StaticOrder {
    int nM, nN, nwg, G, c;
    __host__ __device__ void init(int M, int N, int G_, int c_) { nM = M / BM; nN = N / BM; nwg = nM * nN; G = G_; c = c_; }
    __host__ __device__ bool next(int i, Unit& u) const {
        const long L = (long)i * G + c; if (L >= nwg) return false;
        int wgid = (int)L; { const int q = nwg / NXCD, r = nwg % NXCD, xcd = wgid % NXCD, off = wgid / NXCD; wgid = (xcd < r ? xcd * (q + 1) : r * (q + 1) + (xcd - r) * q) + off; }
        const int nig = WGM * nN, gid = wgid / nig, fm = gid * WGM, gsz = (nM - fm) < WGM ? (nM - fm) : WGM;
        u.pm = fm + ((wgid % nig) % gsz); u.pn = (wgid % nig) / gsz; return true;
    }
};

template <class Epi>
__device__ __forceinline__ void gemm_phase(LAS unsigned char* lds, const Gemm g, const StaticOrder& S, const Epi& E, int wv) {
    const int tid = opaque_tid(wv), wid = __builtin_amdgcn_readfirstlane(tid >> 6), lane = tid & 63, wr = wid >> 2, wc = wid & 3, fr = lane & 15, fq = lane >> 4;
    const int K = g.K, nt = K / BK;
    unsigned voffA[2], voffB[2];
#pragma unroll
    for (int i = 0; i < 2; ++i) { int R, C; stage_rc(tid * 16 + i * 8192, R, C); voffA[i] = (unsigned)(R * K + C) * 2u; voffB[i] = voffA[i]; }
    const size_t kstep = (size_t)(BK * 2);
    const size_t hstep = (size_t)HALF * K * 2;
    const size_t tstep = 2 * hstep;
    const unsigned ldsw = (unsigned)wid * 1024u;
    const int aoff = lds_byte(wr * 64 + fr, fq * 8), boff = lds_byte(wc * 32 + fr, fq * 8);
#define PG8_SA(b, h) (((b) * 2 + (h)) * HTB)
#define PG8_SB(b, h) ((4 + (b) * 2 + (h)) * HTB)
#define PG8_STAGE(bufoff, gbase, voff) do { _Pragma("unroll") for (int _i = 0; _i < 2; ++_i) \
        __builtin_amdgcn_global_load_lds((const unsigned*)((const char*)(gbase) + (voff)[_i]), (LAS unsigned*)(lds + (bufoff) + ldsw + _i * 8192), 16, 0, 0); } while (0)
#define PG8_LDA(dst, b, h) do { _Pragma("unroll") for (int m = 0; m < 4; ++m) _Pragma("unroll") for (int k = 0; k < 2; ++k) dst[m][k] = *(const LAS bf16x8*)(lds + PG8_SA(b, h) + aoff + m * 2048 + k * 1024); } while (0)
#define PG8_LDB(dst, b, h) do { _Pragma("unroll") for (int n = 0; n < 2; ++n) _Pragma("unroll") for (int k = 0; k < 2; ++k) dst[n][k] = *(const LAS bf16x8*)(lds + PG8_SB(b, h) + boff + n * 2048 + k * 1024); } while (0)
#define PG8_MMA(ai, bj, At, Bt) do { __builtin_amdgcn_s_setprio(1); _Pragma("unroll") for (int m = 0; m < 4; ++m) _Pragma("unroll") for (int n = 0; n < 2; ++n) _Pragma("unroll") for (int k = 0; k < 2; ++k) \
        acc[ai][bj][m][n] = __builtin_amdgcn_mfma_f32_16x16x32_bf16(Bt[n][k], At[m][k], acc[ai][bj][m][n], 0, 0, 0); __builtin_amdgcn_s_setprio(0); } while (0)
#define PG8_WAIT_V(n) asm volatile("s_waitcnt vmcnt(" #n ")" ::: "memory")
#define PG8_WAIT_L(n) asm volatile("s_waitcnt lgkmcnt(" #n ")" ::: "memory")
#define PG8_BAR __builtin_amdgcn_s_barrier()
#define PG8_SCHED __builtin_amdgcn_sched_barrier(0)
    Unit cur, nxt; int ui = 0;
    if (!S.next(0, cur)) return;
    f32x4 acc[2][2][4][2];
#pragma unroll
    for (int a = 0; a < 2; ++a)
#pragma unroll
        for (int b = 0; b < 2; ++b)
#pragma unroll
            for (int m = 0; m < 4; ++m)
#pragma unroll
                for (int n = 0; n < 2; ++n) acc[a][b][m][n] = (f32x4){0.f, 0.f, 0.f, 0.f};
    bf16x8 At[4][2], B0[2][2], B1[2][2];
    const char* cA = (const char*)g.A + (size_t)cur.pm * tstep; const char* cB = (const char*)g.Bt + (size_t)cur.pn * tstep;
    PG8_STAGE(PG8_SB(0, 0), cB, voffB); PG8_STAGE(PG8_SA(0, 0), cA, voffA); PG8_STAGE(PG8_SB(0, 1), cB + hstep, voffB); PG8_STAGE(PG8_SA(0, 1), cA + hstep, voffA);
    if (wr == 1) PG8_BAR;
    PG8_WAIT_V(4); PG8_BAR;
    PG8_STAGE(PG8_SB(1, 0), cB + kstep, voffB); PG8_STAGE(PG8_SA(1, 0), cA + kstep, voffA); PG8_STAGE(PG8_SB(1, 1), cB + hstep + kstep, voffB);
    PG8_WAIT_V(6); PG8_BAR;
    for (;;) {
        const bool has_next = S.next(ui + 1, nxt);
        const char* nA = has_next ? (const char*)g.A + (size_t)nxt.pm * tstep : cA; const char* nB = has_next ? (const char*)g.Bt + (size_t)nxt.pn * tstep : cB;
        for (int t = 0; t < nt; t += 2) {
            const bool last = (t == nt - 2);
            const char* a1 = cA + (size_t)(t + 1) * kstep;
            const char* a2 = last ? nA : cA + (size_t)(t + 2) * kstep; const char* b2 = last ? nB : cB + (size_t)(t + 2) * kstep;
            const char* a3 = a2 + kstep; const char* b3 = b2 + kstep;
            PG8_LDB(B0, 0, 0); PG8_SCHED; PG8_LDA(At, 0, 0); PG8_STAGE(PG8_SA(1, 1), a1 + hstep, voffA);
            PG8_WAIT_L(8); PG8_BAR; PG8_WAIT_L(0); PG8_MMA(0, 0, At, B0); PG8_BAR; PG8_SCHED;
            PG8_LDB(B1, 0, 1); PG8_STAGE(PG8_SB(0, 0), b2, voffB);
            PG8_BAR; PG8_WAIT_L(0); PG8_MMA(0, 1, At, B1); PG8_BAR;
            PG8_LDA(At, 0, 1); PG8_STAGE(PG8_SA(0, 0), a2, voffA);
            PG8_BAR; PG8_WAIT_L(0); PG8_MMA(1, 0, At, B0); PG8_BAR; PG8_SCHED;
            PG8_STAGE(PG8_SB(0, 1), b2 + hstep, voffB);
            PG8_WAIT_V(6); PG8_BAR; PG8_MMA(1, 1, At, B1); PG8_BAR;
            PG8_LDB(B0, 1, 0); PG8_SCHED; PG8_LDA(At, 1, 0); PG8_STAGE(PG8_SA(0, 1), a2 + hstep, voffA);
            PG8_WAIT_L(8); PG8_BAR; PG8_WAIT_L(0); PG8_MMA(0, 0, At, B0); PG8_BAR; PG8_SCHED;
            PG8_LDB(B1, 1, 1); PG8_STAGE(PG8_SB(1, 0), b3, voffB);
            PG8_BAR; PG8_WAIT_L(0); PG8_MMA(0, 1, At, B1); PG8_BAR;
            PG8_LDA(At, 1, 1); PG8_STAGE(PG8_SA(1, 0), a3, voffA);
            PG8_BAR; PG8_WAIT_L(0); PG8_MMA(1, 0, At, B0); PG8_BAR; PG8_SCHED;
            PG8_STAGE(PG8_SB(1, 1), b3 + hstep, voffB);
            PG8_WAIT_V(6); PG8_BAR; PG8_MMA(1, 1, At, B1); PG8_BAR;
        }
        E(acc, cur, wr, wc, fr, fq);
        if (!has_next) break;
#pragma unroll
        for (int a = 0; a < 2; ++a)
#pragma unroll
            for (int b = 0; b < 2; ++b)
#pragma unroll
                for (int m = 0; m < 4; ++m)
#pragma unroll
                    for (int n = 0; n < 2; ++n) acc[a][b][m][n] = (f32x4){0.f, 0.f, 0.f, 0.f};
        cur = nxt; cA = nA; cB = nB; ++ui;
    }
    PG8_WAIT_V(0);
    if (wr == 0) PG8_BAR;
    PG8_BAR;
#undef PG8_SA
#undef PG8_SB
#undef PG8_STAGE
#undef PG8_LDA
#undef PG8_LDB
#undef PG8_MMA
#undef PG8_WAIT_V
#undef PG8_WAIT_L
#undef PG8_BAR
#undef PG8_SCHED
}
}

__device__ __forceinline__ int perm32i(int rho) { const int n = rho >> 4, i = rho & 15; return 8 * (i >> 2) + 4 * n + (i & 3); }
__device__ __forceinline__ int gperm(int c) { return (c & ~31) + perm32i(c & 31); }
__device__ __forceinline__ int rperm(int c) { const int w = (c >> 5) & 1, n = (c >> 4) & 1, i = c & 15; return (c & ~63) + 16 * w + i + 32 * n; }
__device__ __forceinline__ int src_col(int mode, int c) {
    switch (mode) {
        case 0: return c < 2048 ? rperm(c) : gperm(c);
        case 1: { if (c < 2048) return 3072 + gperm(c); if (c < 5120) return 5120 + gperm(c - 2048); const int t = gperm(c - 5120); return t < 32 ? 8192 + t : -1; }
        case 2: return 8224 + gperm(c);
        case 6: { const int pn = c >> 8, bj = (c >> 7) & 1, r = c & 127; return bj * 2816 + 128 * pn + gperm(r); }
        default: return gperm(c);
    }
}

__device__ __forceinline__ int batch_of(int r) { return r < MP ? (r >> 11) : 32 + ((r - MP) >> 6); }

template <int MODE> struct Epi {
    const Params& p;
    __device__ __forceinline__ void operator()(const f32x4 (&acc)[2][2][4][2], const pg8::Unit& u, int wr_, int wc_, int fr_, int fq_) const {
        int wr = wr_, wc = wc_, fr = fr_, fq = fq_;
        asm volatile("" : "+s"(wr), "+s"(wc), "+v"(fr), "+v"(fq));
        const int pn = u.pn;
#pragma unroll
        for (int ai = 0; ai < 2; ++ai)
#pragma unroll
            for (int m = 0; m < 4; ++m) {
                if ((MODE == 3 || MODE == 4) ? (m == 0) : ((m & 1) == 0)) __builtin_amdgcn_sched_barrier(0);
                const int r = u.pm * 256 + ai * 128 + wr * 64 + m * 16 + fr;
                const bool samp = r >= MP; const int rs = r - MP;
                if constexpr (MODE == 0) {
                    const int type = pn >> 2, colbase = (pn & 3) * 256;
                    if (type < 2) {
                        const int pos = samp ? 1024 + (rs & 63) : (r & 2047);
                        const int dlo = 16 * (wc & 1) + 4 * fq;
                        f32x4 cv, sv;
#pragma unroll
                        for (int j = 0; j < 4; ++j) {
                            const float frq = fexp2((float)(dlo + j) * (-13.287712379549449f / 32.0f)) * 0.15915494309189535f;
                            const float rev = __builtin_amdgcn_fractf((float)pos * frq);
                            cv[j] = __builtin_amdgcn_cosf(rev); sv[j] = __builtin_amdgcn_sinf(rev);
                        }
#pragma unroll
                        for (int bj = 0; bj < 2; ++bj) {
                            const int col = colbase + 64 * (2 * bj + (wc >> 1)) + dlo;
                            const f32x4 x1 = acc[ai][bj][m][0], x2 = acc[ai][bj][m][1];
                            f32x4 o1 = x1 * cv - x2 * sv, o2 = x2 * cv + x1 * sv;
                            if (type == 0) {
                                const float qs = 0.125f * LOG2E; o1 *= qs; o2 *= qs;
                                bf16_t* q = p.qbuf() + (size_t)r * 1024 + col;
                                *(u32x2*)q = pack4(o1); *(u32x2*)(q + 32) = pack4(o2);
                            } else {
                                float* ko = (samp ? p.nk_s() + (size_t)rs * 1024 : p.nk_p() + (size_t)r * 1024) + col;
                                *(f32x4*)ko = o1; *(f32x4*)(ko + 32) = o2;
                                bf16_t* kb = (samp ? p.kbuf_s() + (size_t)rs * 1024 : p.kbuf_p() + (size_t)r * 1024) + col;
                                *(u32x2*)kb = pack4(o1); *(u32x2*)(kb + 32) = pack4(o2);
                            }
                        }
                    } else {
#pragma unroll
                        for (int bj = 0; bj < 2; ++bj) {
                            const int col = colbase + 128 * bj + 32 * wc + 8 * fq;
                            float* vo = (samp ? p.nv_s() + (size_t)rs * 1024 : p.nv_p() + (size_t)r * 1024) + col;
                            *(f32x4*)vo = acc[ai][bj][m][0]; *(f32x4*)(vo + 4) = acc[ai][bj][m][1];
                            bf16_t* vb = (samp ? p.vbuf_s() + (size_t)rs * 1024 : p.vbuf_p() + (size_t)r * 1024) + col;
                            *(u32x4*)vb = pack8(acc[ai][bj][m][0], acc[ai][bj][m][1]);
                        }
                    }
                } else if constexpr (MODE == 1) {
                    if (pn < 8) {
#pragma unroll
                        for (int bj = 0; bj < 2; ++bj) { const int col = pn * 256 + 128 * bj + 32 * wc + 8 * fq; *(u32x4*)(p.zbuf() + (size_t)r * 2048 + col) = pack8(acc[ai][bj][m][0], acc[ai][bj][m][1]); }
                    } else if (pn < 20) {
                        const int tt = samp ? (rs & 63) - 61 : (r & 2047) - 2045;
#pragma unroll
                        for (int bj = 0; bj < 2; ++bj) {
                            const int col = (pn - 8) * 256 + 128 * bj + 32 * wc + 8 * fq;
                            const u32x4 xw = pack8(acc[ai][bj][m][0], acc[ai][bj][m][1]);
                            *(u32x4*)(p.xbcbuf() + (size_t)r * 3072 + col) = xw;
                            if ((r & 63) >= 61) *(u32x4*)(p.halo() + ((size_t)(r >> 6) * 3 + ((r & 63) - 61)) * 3072 + col) = xw;
                            if (tt >= 0) { float* co = (samp ? p.nconv_s() + ((size_t)(rs >> 6) * 3 + tt) * 3072 : p.nconv_p() + ((size_t)(r >> 11) * 3 + tt) * 3072) + col; *(f32x4*)co = acc[ai][bj][m][0]; *(f32x4*)(co + 4) = acc[ai][bj][m][1]; }
                        }
                    } else {
                        if (wc == 0) { float* d = p.dtbuf() + (size_t)r * 32 + 8 * fq; *(f32x4*)d = acc[ai][0][m][0]; *(f32x4*)(d + 4) = acc[ai][0][m][1]; }
                    }
                } else if constexpr (MODE == 2) {
#pragma unroll
                    for (int bj = 0; bj < 2; ++bj) {
                        const int col = pn * 256 + 128 * bj + 32 * wc + 8 * fq; f32x4 a = acc[ai][bj][m][0], b = acc[ai][bj][m][1];
#pragma unroll
                        for (int j = 0; j < 4; ++j) { a[j] = sigmoidf_(a[j]); b[j] = sigmoidf_(b[j]); }
                        *(u32x4*)(p.gbuf() + (size_t)r * 2048 + col) = pack8(a, b);
                    }
                } else if constexpr (MODE == 3 || MODE == 4) {
#pragma unroll
                    for (int bj = 0; bj < 2; ++bj) {
                        const int col = pn * 256 + 128 * bj + 32 * wc + 8 * fq;
                        const u32x4 g = *(const u32x4*)(p.gbuf() + (size_t)r * 2048 + (MODE == 4 ? 1024 : 0) + col);
                        f32x4 a = acc[ai][bj][m][0], b = acc[ai][bj][m][1];
                        a[0] *= bf_lo(g.x); a[1] *= bf_hi(g.x); a[2] *= bf_lo(g.y); a[3] *= bf_hi(g.y); b[0] *= bf_lo(g.z); b[1] *= bf_hi(g.z); b[2] *= bf_lo(g.w); b[3] *= bf_hi(g.w);
                        bf16_t* mp = p.mbuf() + (size_t)r * 1024 + col;
                        if constexpr (MODE == 4) { const u32x4 o = *(const u32x4*)mp; a[0] += bf_lo(o.x); a[1] += bf_hi(o.x); a[2] += bf_lo(o.y); a[3] += bf_hi(o.y); b[0] += bf_lo(o.z); b[1] += bf_hi(o.z); b[2] += bf_lo(o.w); b[3] += bf_hi(o.w); }
                        *(u32x4*)mp = pack8(a, b);
                    }
                } else if constexpr (MODE == 5 || MODE == 7) {
                    const int bidx = u.pm < 256 ? (u.pm >> 3) : 32 + (u.pm - 256) * 4 + 2 * ai + wr;
                    const float* mrow = p.mod() + (size_t)bidx * 6144 + (MODE == 5 ? 2048 : 5120);
#pragma unroll
                    for (int bj = 0; bj < 2; ++bj) {
                        const int col = pn * 256 + 128 * bj + 32 * wc + 8 * fq;
                        f32x4 x0, x1;
                        if constexpr (MODE == 5) { const float* xin = (samp ? p.x_s + (size_t)rs * 1024 : p.x_p + (size_t)r * 1024) + col; x0 = *(const f32x4*)xin; x1 = *(const f32x4*)(xin + 4); }
                        else { const u32x4 xw = *(const u32x4*)(p.x1buf() + (size_t)r * 1024 + col); x0 = (f32x4){bf_lo(xw.x), bf_hi(xw.x), bf_lo(xw.y), bf_hi(xw.y)}; x1 = (f32x4){bf_lo(xw.z), bf_hi(xw.z), bf_lo(xw.w), bf_hi(xw.w)}; }
                        const f32x4 g0 = *(const f32x4*)(mrow + col), g1 = *(const f32x4*)(mrow + col + 4);
                        bf16_t* yo = (MODE == 5 ? p.x1buf() : p.x2buf()) + (size_t)r * 1024 + col;
                        *(u32x4*)yo = pack8(x0 + g0 * acc[ai][bj][m][0], x1 + g1 * acc[ai][bj][m][1]);
                    }
                } else if constexpr (MODE == 6) {
                    const int col = pn * 128 + 32 * wc + 8 * fq; f32x4 a = acc[ai][0][m][0], b = acc[ai][0][m][1];
#pragma unroll
                    for (int j = 0; j < 4; ++j) { a[j] = siluf_(a[j]) * acc[ai][1][m][0][j]; b[j] = siluf_(b[j]) * acc[ai][1][m][1][j]; }
                    *(u32x4*)(p.swbuf() + (size_t)r * 2816 + col) = pack8(a, b);
                }
            }
    }
};

template <int MODE> __device__ __forceinline__ void run_gemm(const Params& p, LAS unsigned char* lds, const bf16_t* A, const bf16_t* Bt, int N, int K, int wv) {
    pg8::Gemm g{A, Bt, MT, N, K}; pg8::StaticOrder S; S.init(MT, N, (int)gridDim.x, (int)blockIdx.x); Epi<MODE> E{p};
    pg8::gemm_phase<Epi<MODE>>(lds, g, S, E, wv);
}

__device__ __forceinline__ float wave_sum(float v) {
#pragma unroll
    for (int o = 32; o >= 1; o >>= 1) v += __shfl_xor(v, o);
    return v;
}

__device__ void prep_phase(const Params& p, LAS unsigned char* lds, int wv) {
    const int tid = opaque_tid(wv);
    {
        LAS float* tiles = (LAS float*)lds;
        const int ntiles[8] = {48 * 16, 84 * 16, 32 * 16, 16 * 16, 16 * 32, 16 * 16, 88 * 16, 16 * 44};
        int total = 0;
#pragma unroll
        for (int j = 0; j < 8; ++j) total += ntiles[j];
        for (int G = blockIdx.x; 4 * G < total; G += gridDim.x) {
            const float* W[4]; int ldw[4], K[4], n0[4], k0[4], job[4]; bf16_t* Bt[4];
#pragma unroll
            for (int u = 0; u < 4; ++u) {
                int j = 0, lt = 4 * G + u; if (lt >= total) lt = total - 1;
#pragma unroll
                for (int q = 0; q < 7; ++q) if (j == q && lt >= ntiles[q]) { lt -= ntiles[q]; j = q + 1; }
                switch (j) {
                    case 0: W[u] = p.w_in; ldw[u] = 10272; K[u] = 1024; Bt[u] = p.bt1a(); break;
                    case 1: W[u] = p.w_in; ldw[u] = 10272; K[u] = 1024; Bt[u] = p.bt1b(); break;
                    case 2: W[u] = p.w_in; ldw[u] = 10272; K[u] = 1024; Bt[u] = p.bt1c(); break;
                    case 3: W[u] = p.w_pa; ldw[u] = 1024; K[u] = 1024; Bt[u] = p.btpa(); break;
                    case 4: W[u] = p.w_pb; ldw[u] = 1024; K[u] = 2048; Bt[u] = p.btpb(); break;
                    case 5: W[u] = p.w_out; ldw[u] = 1024; K[u] = 1024; Bt[u] = p.btout(); break;
                    case 6: W[u] = p.w_gu; ldw[u] = 5632; K[u] = 1024; Bt[u] = p.btgu(); break;
                    default: W[u] = p.w_down; ldw[u] = 1024; K[u] = 2816; Bt[u] = p.btdown(); break;
                }
                const int nkt = K[u] >> 6; n0[u] = (lt / nkt) * 64; k0[u] = (lt % nkt) * 64; job[u] = j;
            }
            float v[4][8];
            const int col = tid & 63, kr = tid >> 6;
#pragma unroll
            for (int u = 0; u < 4; ++u) {
                const int sc = src_col(job[u], n0[u] + col);
#pragma unroll
                for (int jj = 0; jj < 8; ++jj) { const int k = kr + 8 * jj; v[u][jj] = sc >= 0 ? W[u][(size_t)(k0[u] + k) * ldw[u] + sc] : 0.f; }
            }
#pragma unroll
            for (int u = 0; u < 4; ++u)
#pragma unroll
                for (int jj = 0; jj < 8; ++jj) { const int k = kr + 8 * jj; float x = v[u][jj]; if (job[u] == 4) x *= p.g_ssd[k0[u] + k]; tiles[u * 64 * 65 + k * 65 + col] = x; }
            __syncthreads();
            {
                const int kk = (tid & 31) * 2, nr = tid >> 5;
#pragma unroll
                for (int u = 0; u < 4; ++u)
#pragma unroll
                    for (int jj = 0; jj < 4; ++jj) { const int n = nr + 16 * jj; *(unsigned*)(Bt[u] + (size_t)(n0[u] + n) * K[u] + k0[u] + kk) = cvt_pk_bf16(tiles[u * 64 * 65 + kk * 65 + n], tiles[u * 64 * 65 + (kk + 1) * 65 + n]); }
            }
            __syncthreads();
        }
    }
    {
        LAS float* sc = (LAS float*)lds;
        LAS float* wt = (LAS float*)(lds + 64 * 129 * 4);
        for (int cbk = blockIdx.x; cbk < 256; cbk += gridDim.x) {
            const int col0 = cbk * 24, row = tid & 63, cgp = tid >> 6;
            float a0 = 0.f, a1 = 0.f, a2 = 0.f;
            for (int kc = 0; kc < 8; ++kc) {
                const int k0 = kc * 128;
                __syncthreads();
#pragma unroll
                for (int i = 0; i < 16; ++i) { const int idx = tid + 512 * i, r = idx >> 7, k = idx & 127; const float v = r < 32 ? p.c_p[r * 1024 + k0 + k] : p.c_s[(r - 32) * 1024 + k0 + k]; sc[r * 129 + k] = siluf_(v); }
#pragma unroll
                for (int i = 0; i < 6; ++i) { const int idx = tid + 512 * i, k = idx / 24, c = idx % 24; wt[idx] = p.w_ada[(size_t)(k0 + k) * 6144 + col0 + c]; }
                __syncthreads();
#pragma unroll 8
                for (int k = 0; k < 128; ++k) { const float a = sc[row * 129 + k]; a0 += a * wt[k * 24 + 3 * cgp]; a1 += a * wt[k * 24 + 3 * cgp + 1]; a2 += a * wt[k * 24 + 3 * cgp + 2]; }
            }
            const int c = col0 + 3 * cgp;
            p.mod()[row * 6144 + c] = a0 + p.b_ada[c]; p.mod()[row * 6144 + c + 1] = a1 + p.b_ada[c + 1]; p.mod()[row * 6144 + c + 2] = a2 + p.b_ada[c + 2];
        }
        __syncthreads();
    }
    const size_t gtid = (size_t)blockIdx.x * 512 + tid, gsz = (size_t)gridDim.x * 512;
}

template <int MODE> __device__ void norm_phase(const Params& p, int wv) {
    const int tid = opaque_tid(wv); const int w = tid >> 6, lane = tid & 63;
    const float* g = MODE == 0 ? p.g_mix : (MODE == 1 ? p.g_ffn : p.g_final);
    const int stride = gridDim.x * 8;
    for (int r0 = blockIdx.x * 8 + w; r0 < MT; r0 += 2 * stride) {
        f32x4 v[2][4]; float ss[2] = {0.f, 0.f}; int rr[2];
#pragma unroll
        for (int q = 0; q < 2; ++q) {
            const int r = r0 + q * stride; rr[q] = r < MT ? r : r0;
            if constexpr (MODE == 0) {
                const float* src = rr[q] < MP ? p.x_p + (size_t)rr[q] * 1024 : p.x_s + (size_t)(rr[q] - MP) * 1024;
#pragma unroll
                for (int j = 0; j < 4; ++j) v[q][j] = *(const f32x4*)(src + 256 * j + 4 * lane);
            } else {
                const bf16_t* src = (MODE == 1 ? p.x1buf() : p.x2buf()) + (size_t)rr[q] * 1024;
#pragma unroll
                for (int j = 0; j < 4; ++j) { const u32x2 u = *(const u32x2*)(src + 256 * j + 4 * lane); v[q][j] = (f32x4){bf_lo(u.x), bf_hi(u.x), bf_lo(u.y), bf_hi(u.y)}; }
            }
        }
#pragma unroll
        for (int q = 0; q < 2; ++q) {
#pragma unroll
            for (int j = 0; j < 4; ++j) ss[q] += v[q][j][0] * v[q][j][0] + v[q][j][1] * v[q][j][1] + v[q][j][2] * v[q][j][2] + v[q][j][3] * v[q][j][3];
            ss[q] = wave_sum(ss[q]);
        }
#pragma unroll
        for (int q = 0; q < 2; ++q) {
            if (q == 1 && r0 + stride >= MT) continue;
            const int r = rr[q];
            const float rsn = rsqrtf(ss[q] * (1.0f / 1024.0f) + EPSN);
            const float* mrow = p.mod() + (size_t)batch_of(r) * 6144 + (MODE == 0 ? 0 : 3072);
#pragma unroll
            for (int j = 0; j < 4; ++j) {
                const int c = 256 * j + 4 * lane; const f32x4 gg = *(const f32x4*)(g + c); f32x4 o = v[q][j] * rsn * gg;
                if constexpr (MODE == 2) { *(f32x4*)(p.y() + (size_t)r * 1024 + c) = o; }
                else { const f32x4 sh = *(const f32x4*)(mrow + c), scl = *(const f32x4*)(mrow + 1024 + c); o = o * (1.0f + scl) + sh; *(u32x2*)((MODE == 0 ? p.hA() : p.h2()) + (size_t)r * 1024 + c) = pack4(o); }
            }
        }
    }
}

__device__ void ssdnorm_phase(const Params& p, int wv) {
    const size_t gtid = (size_t)blockIdx.x * 512 + opaque_tid(wv), gsz = (size_t)gridDim.x * 512, total = (size_t)MT * 256;
    for (size_t i0 = gtid; i0 < total; i0 += 4 * gsz) {
        u32x4 u[4]; float rsn[4]; bf16_t* ptr[4];
#pragma unroll
        for (int q = 0; q < 4; ++q) {
            const size_t i = i0 + (size_t)q * gsz; const size_t ic = i < total ? i : i0;
            const size_t r = ic >> 8; const int e8 = (int)(ic & 255), gq = e8 >> 6;
            const float ss = p.ssbuf()[r * 8 + 2 * gq] + p.ssbuf()[r * 8 + 2 * gq + 1];
            rsn[q] = rsqrtf(ss * (1.0f / 512.0f) + EPSN);
            ptr[q] = p.zbuf() + r * 2048 + e8 * 8; u[q] = *(const u32x4*)ptr[q];
        }
#pragma unroll
        for (int q = 0; q < 4; ++q) {
            const size_t i = i0 + (size_t)q * gsz; if (i >= total) continue;
            u32x4 o; const float rs = rsn[q];
            o.x = cvt_pk_bf16(bf_lo(u[q].x) * rs, bf_hi(u[q].x) * rs); o.y = cvt_pk_bf16(bf_lo(u[q].y) * rs, bf_hi(u[q].y) * rs); o.z = cvt_pk_bf16(bf_lo(u[q].z) * rs, bf_hi(u[q].z) * rs); o.w = cvt_pk_bf16(bf_lo(u[q].w) * rs, bf_hi(u[q].w) * rs);
            *(u32x4*)ptr[q] = o;
        }
    }
}

constexpr int AT_K = 9216, AT_V = 20480, AT_STAGE = 2 * AT_K + AT_V;
template <bool PAST> __device__ __forceinline__ void attn_item(const Params& p, LAS unsigned char* lds, int row0, int h, const bf16_t* Kb, const bf16_t* Vb, const float* Kc, const float* Vc, int nt0, int nt1, float lam, int wv) {
    const int tid = opaque_tid(wv), w = __builtin_amdgcn_readfirstlane(tid >> 6), lane = tid & 63, l31 = lane & 31, hh = lane >> 5;
    const int hd = w >> 2, rb = w & 3, chunk = rb >> 1;
    const int ntl = nt0 > nt1 ? nt0 : nt1, my_nt = chunk ? nt1 : nt0;
    const int coff = 128 * h;
    bf16x8 qf[4];
    {
        const bf16_t* qp = p.qbuf() + (size_t)(row0 + rb * 32 + l31) * 1024 + coff + 64 * hd + 8 * hh;
#pragma unroll
        for (int s = 0; s < 4; ++s) qf[s] = my_nt > 0 ? *(const bf16x8*)(qp + 16 * s) : (bf16x8){0, 0, 0, 0, 0, 0, 0, 0};
    }
    f32x16 O[4];
#pragma unroll
    for (int c = 0; c < 4; ++c)
#pragma unroll
        for (int e = 0; e < 16; ++e) O[c][e] = 0.f;
    float m_run = -1e30f, l_run = 0.f;
    u32x4 kreg[2], vreg[2];
    f32x4 kf[PAST ? 2 : 1][2], vf[PAST ? 2 : 1][2];
    auto gload = [&](int t) {
        if (PAST && t < 16) {
            const int key0 = 64 * t;
#pragma unroll
            for (int jj = 0; jj < 2; ++jj) {
                const int idx = tid + 512 * jj;
                { const int which = idx >> 9, row = (idx >> 3) & 63, ch = idx & 7; const float* sp = Kc + (size_t)(key0 + row) * 1024 + coff + 64 * which + 8 * ch; kf[PAST ? jj : 0][0] = *(const f32x4*)sp; kf[PAST ? jj : 0][1] = *(const f32x4*)(sp + 4); }
                { const int row = idx >> 4, ch = idx & 15; const float* sp = Vc + (size_t)(key0 + row) * 1024 + coff + 8 * ch; vf[PAST ? jj : 0][0] = *(const f32x4*)sp; vf[PAST ? jj : 0][1] = *(const f32x4*)(sp + 4); }
            }
        } else {
            const int key0 = PAST ? 0 : 64 * t;
#pragma unroll
            for (int jj = 0; jj < 2; ++jj) {
                const int idx = tid + 512 * jj;
                { const int which = idx >> 9, row = (idx >> 3) & 63, ch = idx & 7; kreg[jj] = *(const u32x4*)(Kb + (size_t)(key0 + row) * 1024 + coff + 64 * which + 8 * ch); }
                { const int row = idx >> 4, ch = idx & 15; vreg[jj] = *(const u32x4*)(Vb + (size_t)(key0 + row) * 1024 + coff + 8 * ch); }
            }
        }
    };
    auto swrite = [&](int st, int t) {
        LAS unsigned char* base = lds + st * AT_STAGE;
        if (PAST && t < 16) {
#pragma unroll
            for (int jj = 0; jj < 2; ++jj) { kreg[jj] = pack8(kf[PAST ? jj : 0][0], kf[PAST ? jj : 0][1]); vreg[jj] = pack8(vf[PAST ? jj : 0][0], vf[PAST ? jj : 0][1]); }
        }
#pragma unroll
        for (int jj = 0; jj < 2; ++jj) {
            const int idx = tid + 512 * jj;
            { const int which = idx >> 9, row = (idx >> 3) & 63, ch = idx & 7; *(LAS u32x4*)(base + which * AT_K + row * 144 + ch * 16) = kreg[jj]; }
            { const int row = idx >> 4, ch = idx & 15; *(LAS u32x4*)(base + 2 * AT_K + row * 320 + ch * 16) = vreg[jj]; }
        }
    };
    const int q4 = (lane & 15) >> 2, blk = (lane >> 4) & 1, pp = lane & 3;
    auto qk = [&](int st, f32x16 (&S)[2]) {
        LAS unsigned char* Kt = lds + st * AT_STAGE + hd * AT_K + l31 * 144 + hh * 16;
#pragma unroll
        for (int kb = 0; kb < 2; ++kb) {
#pragma unroll
            for (int e = 0; e < 16; ++e) S[kb][e] = 0.f;
#pragma unroll
            for (int s = 0; s < 4; ++s) { const bf16x8 a = *(const LAS bf16x8*)(Kt + kb * 32 * 144 + s * 32); S[kb] = __builtin_amdgcn_mfma_f32_32x32x16_bf16(a, qf[s], S[kb], 0, 0, 0); }
        }
    };
    auto smpv = [&](int st, f32x16 (&S)[2]) {
        LAS unsigned char* Vt = lds + st * AT_STAGE + 2 * AT_K + (4 * hh + q4) * 320 + (16 * blk + 4 * pp) * 2;
        float mx = S[0][0];
#pragma unroll
        for (int e = 1; e < 16; ++e) mx = fmaxf(mx, S[0][e]);
#pragma unroll
        for (int e = 0; e < 16; ++e) mx = fmaxf(mx, S[1][e]);
        mx = fmaxf(mx, __shfl_xor(mx, 32));
        const float mn = mx > m_run + 8.0f ? mx : m_run, alpha = fexp2(m_run - mn); m_run = mn;
        float rsum = 0.f;
#pragma unroll
        for (int kb = 0; kb < 2; ++kb)
#pragma unroll
            for (int e = 0; e < 16; ++e) { const float pv = fexp2(S[kb][e] - mn); S[kb][e] = pv; rsum += pv; }
        l_run = l_run * alpha + rsum;
        if (__builtin_amdgcn_ballot_w64(alpha != 1.0f) != 0ull) {
#pragma unroll
            for (int c = 0; c < 4; ++c)
#pragma unroll
                for (int e = 0; e < 16; ++e) O[c][e] *= alpha;
        }
#pragma unroll
        for (int kb = 0; kb < 2; ++kb)
#pragma unroll
            for (int sp = 0; sp < 2; ++sp) {
                union { u32x4 u; bf16x8 v; } pb;
                pb.u.x = cvt_pk_bf16(S[kb][8 * sp + 0], S[kb][8 * sp + 1]); pb.u.y = cvt_pk_bf16(S[kb][8 * sp + 2], S[kb][8 * sp + 3]);
                pb.u.z = cvt_pk_bf16(S[kb][8 * sp + 4], S[kb][8 * sp + 5]); pb.u.w = cvt_pk_bf16(S[kb][8 * sp + 6], S[kb][8 * sp + 7]);
#pragma unroll
                for (int c = 0; c < 4; ++c) {
                    LAS unsigned char* va = Vt + (32 * kb + 16 * sp) * 320 + 64 * c;
                    const s16x4 v0 = __builtin_amdgcn_ds_read_tr16_b64_v4i16((LAS s16x4*)va);
                    const s16x4 v1 = __builtin_amdgcn_ds_read_tr16_b64_v4i16((LAS s16x4*)(va + 8 * 320));
                    const bf16x8 vfr = {v0[0], v0[1], v0[2], v0[3], v1[0], v1[1], v1[2], v1[3]};
                    O[c] = __builtin_amdgcn_mfma_f32_32x32x16_bf16(vfr, pb.v, O[c], 0, 0, 0);
                }
            }
    };
    if constexpr (PAST) {
        gload(0); swrite(0, 0); __syncthreads();
        for (int t = 0; t < ntl; ++t) {
            if (t + 1 < ntl) gload(t + 1);
            if (t < my_nt) { f32x16 S[2]; qk(t & 1, S); smpv(t & 1, S); }
            if (t + 1 < ntl) swrite((t + 1) & 1, t + 1);
            __syncthreads();
        }
    } else {
        gload(0); swrite(0, 0); if (ntl > 1) gload(1);
        __syncthreads();
        f32x16 Sn[2];
        if (my_nt > 0) qk(0, Sn);
        int st = 0;
        for (int t = 0; t < ntl; ++t) {
            const int st1 = st == 2 ? 0 : st + 1;
            f32x16 Sc[2]; Sc[0] = Sn[0]; Sc[1] = Sn[1];
            if (t + 1 < ntl) swrite(st1, t + 1);
            if (t + 2 < ntl) gload(t + 2);
            __syncthreads();
            if (t + 1 < my_nt) { qk(st1, Sn); smpv(st, Sc); }
            else if (t < my_nt) { smpv(st, Sc); }
            st = st1;
        }
        __syncthreads();
    }
    const float lt = l_run + __shfl_xor(l_run, 32);
    const float inv = my_nt > 0 ? 1.0f / lt : 0.f;
    LAS float* X = (LAS float*)lds;
    if (hd == 1) {
#pragma unroll
        for (int c = 0; c < 4; ++c)
#pragma unroll
            for (int i = 0; i < 4; ++i) { f32x4 o = {O[c][4 * i] * inv, O[c][4 * i + 1] * inv, O[c][4 * i + 2] * inv, O[c][4 * i + 3] * inv}; *(LAS f32x4*)(X + (rb * 32 + l31) * 132 + 32 * c + 8 * i + 4 * hh) = o; }
    }
    __syncthreads();
    if (hd == 0 && my_nt > 0) {
        float ss = 0.f;
#pragma unroll
        for (int c = 0; c < 4; ++c)
#pragma unroll
            for (int i = 0; i < 4; ++i) {
                const f32x4 o2 = *(const LAS f32x4*)(X + (rb * 32 + l31) * 132 + 32 * c + 8 * i + 4 * hh);
#pragma unroll
                for (int j = 0; j < 4; ++j) { const float o = O[c][4 * i + j] * inv - lam * o2[j]; O[c][4 * i + j] = o; ss += o * o; }
            }
        ss += __shfl_xor(ss, 32);
        const float rsn = rsqrtf(ss * (1.0f / 128.0f) + EPSN) * 0.8f;
        bf16_t* op = p.qbuf() + (size_t)(row0 + rb * 32 + l31) * 1024 + coff + 4 * hh;
#pragma unroll
        for (int c = 0; c < 4; ++c)
#pragma unroll
            for (int i = 0; i < 4; ++i) {
                const f32x4 g = *(const f32x4*)(p.g_subln + 32 * c + 8 * i + 4 * hh);
                const f32x4 o = {O[c][4 * i] * rsn * g[0], O[c][4 * i + 1] * rsn * g[1], O[c][4 * i + 2] * rsn * g[2], O[c][4 * i + 3] * rsn * g[3]};
                *(u32x2*)(op + 32 * c + 8 * i) = pack4(o);
            }
    }
    __syncthreads();
}

__device__ void attn_phase(const Params& p, LAS unsigned char* lds, int wv) {
    const int lane = opaque_tid(wv) & 63;
    const float a1 = wave_sum(p.lq1[lane] * p.lk1[lane]), a2 = wave_sum(p.lq2[lane] * p.lk2[lane]);
    const float lamv = __expf(a1) - __expf(a2) + 0.2f;
    const float lam = __builtin_bit_cast(float, __builtin_amdgcn_readfirstlane(__builtin_bit_cast(int, lamv)));
    for (int j = blockIdx.x; j < 256; j += gridDim.x) {
        const int b = j >> 3, h = j & 7;
#pragma unroll 1
        for (int i = 15; i >= 0; --i) attn_item<false>(p, lds, b * 2048 + 128 * i, h, p.kbuf_p() + (size_t)b * 2048 * 1024, p.vbuf_p() + (size_t)b * 2048 * 1024, nullptr, nullptr, 2 * i + 1, 2 * i + 2, lam, wv);
        attn_item<true>(p, lds, MP + 64 * b, h, p.kbuf_s() + (size_t)b * 64 * 1024, p.vbuf_s() + (size_t)b * 64 * 1024, p.cache_k + (size_t)b * 1024 * 1024, p.cache_v + (size_t)b * 1024 * 1024, 17, 0, lam, wv);
    }
}

__device__ void conv_phase(const Params& p, int wv) {
    const size_t gtid = (size_t)blockIdx.x * 512 + opaque_tid(wv), gsz = (size_t)gridDim.x * 512, total = (size_t)(MT / 64) * 384;
    for (size_t it = gtid; it < total; it += gsz) {
        const int cg = (int)(it / 384), sp = (int)(it % 384), col = sp * 8;
        f32x4 wv4[4][2], bias[2];
#pragma unroll
        for (int j = 0; j < 4; ++j) { wv4[j][0] = *(const f32x4*)(p.conv_w + j * 3072 + col); wv4[j][1] = *(const f32x4*)(p.conv_w + j * 3072 + col + 4); }
        bias[0] = *(const f32x4*)(p.conv_b + col); bias[1] = *(const f32x4*)(p.conv_b + col + 4);
        f32x4 win[3][2];
        const bool samp = cg >= MP / 64;
        if (samp) {
            const float* sc = p.state_conv + (size_t)(cg - MP / 64) * 3 * 3072 + col;
#pragma unroll
            for (int q = 0; q < 3; ++q) { win[q][0] = *(const f32x4*)(sc + q * 3072); win[q][1] = *(const f32x4*)(sc + q * 3072 + 4); }
        } else if ((cg & 31) == 0) {
#pragma unroll
            for (int q = 0; q < 3; ++q) { win[q][0] = (f32x4){0.f, 0.f, 0.f, 0.f}; win[q][1] = win[q][0]; }
        } else {
            const bf16_t* hp = p.halo() + (size_t)(cg - 1) * 3 * 3072 + col;
#pragma unroll
            for (int q = 0; q < 3; ++q) { const u32x4 u = *(const u32x4*)(hp + q * 3072); win[q][0] = (f32x4){bf_lo(u.x), bf_hi(u.x), bf_lo(u.y), bf_hi(u.y)}; win[q][1] = (f32x4){bf_lo(u.z), bf_hi(u.z), bf_lo(u.w), bf_hi(u.w)}; }
        }
        bf16_t* xp = p.xbcbuf() + (size_t)cg * 64 * 3072 + col;
#pragma unroll 1
        for (int t0 = 0; t0 < 64; t0 += 8) {
            u32x4 raw[8];
#pragma unroll
            for (int q = 0; q < 8; ++q) raw[q] = *(const u32x4*)(xp + (size_t)(t0 + q) * 3072);
#pragma unroll
            for (int q = 0; q < 8; ++q) {
                const f32x4 c0 = {bf_lo(raw[q].x), bf_hi(raw[q].x), bf_lo(raw[q].y), bf_hi(raw[q].y)}, c1 = {bf_lo(raw[q].z), bf_hi(raw[q].z), bf_lo(raw[q].w), bf_hi(raw[q].w)};
                f32x4 o0 = bias[0] + wv4[0][0] * win[0][0] + wv4[1][0] * win[1][0] + wv4[2][0] * win[2][0] + wv4[3][0] * c0;
                f32x4 o1 = bias[1] + wv4[0][1] * win[0][1] + wv4[1][1] * win[1][1] + wv4[2][1] * win[2][1] + wv4[3][1] * c1;
                win[0][0] = win[1][0]; win[0][1] = win[1][1]; win[1][0] = win[2][0]; win[1][1] = win[2][1]; win[2][0] = c0; win[2][1] = c1;
#pragma unroll
                for (int e = 0; e < 4; ++e) { o0[e] = siluf_(o0[e]); o1[e] = siluf_(o1[e]); }
                *(u32x4*)(xp + (size_t)(t0 + q) * 3072) = pack8(o0, o1);
            }
        }
    }
}

constexpr int SD_XT = 0, SD_BM = 36864, SD_BT = SD_BM + 17408, SD_CM = SD_BT + 18432, SD_CB = SD_CM + 17408, SD_CUM = SD_CB + 17408, SD_DT = SD_CUM + 1024, SD_SS = SD_DT + 1024;
__device__ void ssd_phase(const Params& p, LAS unsigned char* lds, int wv) {
    const int tid = opaque_tid(wv), w = __builtin_amdgcn_readfirstlane(tid >> 6), lane = tid & 63, l15 = lane & 15, g4 = lane >> 4;
    const int k = w >> 1, ph = w & 1;
    for (int jb = blockIdx.x; jb < 256; jb += gridDim.x) {
        const int b = jb >> 3, hq = jb & 7, grp = hq >> 1, head = 4 * hq + k;
        f32x4 Sacc[8][2];
#pragma unroll
        for (int nb = 0; nb < 8; ++nb)
#pragma unroll
            for (int pb = 0; pb < 2; ++pb) Sacc[nb][pb] = (f32x4){0.f, 0.f, 0.f, 0.f};
        const float a_h = -__expf(p.a_log[head]), dtb = p.dt_bias[head], dsk = p.d_skip[head];
        for (int step = 0; step < 33; ++step) {
            const bool samp = step == 32;
            const int row0 = samp ? MP + 64 * b : b * 2048 + 64 * step;
            if (samp) {
                float* so = p.nssm_p() + ((size_t)(b * 32 + head) * 64) * 128; const float* si = p.state_ssm + ((size_t)(b * 32 + head) * 64) * 128;
#pragma unroll
                for (int nb = 0; nb < 8; ++nb)
#pragma unroll
                    for (int pb = 0; pb < 2; ++pb) { const size_t o = (size_t)(32 * ph + 16 * pb + l15) * 128 + 16 * nb + 4 * g4; *(f32x4*)(so + o) = Sacc[nb][pb]; Sacc[nb][pb] = *(const f32x4*)(si + o); }
            }
            float dtraw = 0.f;
            if (w < 4) dtraw = p.dtbuf()[(size_t)(row0 + lane) * 32 + 4 * hq + w];
            {
                int tdx = tid; asm volatile("" : "+v"(tdx));
                const int tb = tdx & 7, cq = tdx >> 3;
                const int ccol0 = 256 * hq + 4 * cq;
                const bool isB = w < 4; const int n0 = 4 * (cq & 31);
                const int ccol1 = (isB ? 2048 : 2560) + 128 * grp + n0;
                u32x2 r0[8], r1[8];
                const bf16_t* xr0 = p.xbcbuf() + (size_t)(row0 + 8 * tb) * 3072;
#pragma unroll
                for (int tt = 0; tt < 8; ++tt) { r0[tt] = *(const u32x2*)(xr0 + (size_t)tt * 3072 + ccol0); r1[tt] = *(const u32x2*)(xr0 + (size_t)tt * 3072 + ccol1); }
                {
                    f32x4 outv[8];
#pragma unroll
                    for (int tt = 0; tt < 8; ++tt) outv[tt] = (f32x4){bf_lo(r0[tt].x), bf_hi(r0[tt].x), bf_lo(r0[tt].y), bf_hi(r0[tt].y)};
                    LAS unsigned char* base = lds + SD_XT + (cq >> 4) * 9216 + (4 * (cq & 15)) * 144 + 16 * tb;
#pragma unroll
                    for (int e = 0; e < 4; ++e) { u32x4 u; u.x = cvt_pk_bf16(outv[0][e], outv[1][e]); u.y = cvt_pk_bf16(outv[2][e], outv[3][e]); u.z = cvt_pk_bf16(outv[4][e], outv[5][e]); u.w = cvt_pk_bf16(outv[6][e], outv[7][e]); *(LAS u32x4*)(base + e * 144) = u; }
                }
                {
                    f32x4 outv[8];
#pragma unroll
                    for (int tt = 0; tt < 8; ++tt) outv[tt] = (f32x4){bf_lo(r1[tt].x), bf_hi(r1[tt].x), bf_lo(r1[tt].y), bf_hi(r1[tt].y)};
                    LAS unsigned char* rowimg = lds + (isB ? SD_BM : SD_CM);
#pragma unroll
                    for (int tt = 0; tt < 8; ++tt) *(LAS u32x2*)(rowimg + (8 * tb + tt) * 272 + n0 * 2) = r1[tt];
                    if (isB) {
#pragma unroll
                        for (int e = 0; e < 4; ++e) { u32x4 u; u.x = cvt_pk_bf16(outv[0][e], outv[1][e]); u.y = cvt_pk_bf16(outv[2][e], outv[3][e]); u.z = cvt_pk_bf16(outv[4][e], outv[5][e]); u.w = cvt_pk_bf16(outv[6][e], outv[7][e]); *(LAS u32x4*)(lds + SD_BT + (n0 + e) * 144 + 16 * tb) = u; }
                    }
                }
            }
            if (w < 4) {
                const int hd2 = 4 * hq + w;
                const float xr = dtraw + p.dt_bias[hd2];
                const float dt = xr > 20.f ? xr : log1pf(__expf(xr));
                float cum = dt * (-__expf(p.a_log[hd2]));
#pragma unroll
                for (int o = 1; o < 64; o <<= 1) { const float t2 = __shfl_up(cum, o); if (lane >= o) cum += t2; }
                ((LAS float*)(lds + SD_CUM))[w * 64 + lane] = cum; ((LAS float*)(lds + SD_DT))[w * 64 + lane] = dt;
            }
            __syncthreads();
            {
                const int lb = w >> 1;
#pragma unroll
                for (int q = 0; q < 2; ++q) {
                    const int sb = 2 * (w & 1) + q; f32x4 c4 = {0.f, 0.f, 0.f, 0.f};
#pragma unroll
                    for (int ks = 0; ks < 4; ++ks) {
                        const bf16x8 a = *(const LAS bf16x8*)(lds + SD_CM + (16 * lb + l15) * 272 + (32 * ks + 8 * g4) * 2);
                        const bf16x8 bb = *(const LAS bf16x8*)(lds + SD_BM + (16 * sb + l15) * 272 + (32 * ks + 8 * g4) * 2);
                        c4 = __builtin_amdgcn_mfma_f32_16x16x32_bf16(a, bb, c4, 0, 0, 0);
                    }
#pragma unroll
                    for (int j = 0; j < 4; ++j) ((LAS float*)(lds + SD_CB))[(16 * lb + 4 * g4 + j) * 68 + 16 * sb + l15] = c4[j];
                }
            }
            __syncthreads();
            {
                const LAS float* cumL = (const LAS float*)(lds + SD_CUM) + k * 64; const LAS float* dtL = (const LAS float*)(lds + SD_DT) + k * 64;
                const LAS unsigned char* XTk = lds + SD_XT + k * 9216;
                f32x4 yT[2][4];
#pragma unroll
                for (int pb = 0; pb < 2; ++pb)
#pragma unroll
                    for (int lb = 0; lb < 4; ++lb) yT[pb][lb] = (f32x4){0.f, 0.f, 0.f, 0.f};
#pragma unroll
                for (int ks = 0; ks < 4; ++ks) {
                    __builtin_amdgcn_sched_barrier(0);
                    union { u32x4 u; bf16x8 v; } af[2];
#pragma unroll
                    for (int pb = 0; pb < 2; ++pb) { af[pb].u.x = cvt_pk_bf16(Sacc[2 * ks][pb][0], Sacc[2 * ks][pb][1]); af[pb].u.y = cvt_pk_bf16(Sacc[2 * ks][pb][2], Sacc[2 * ks][pb][3]); af[pb].u.z = cvt_pk_bf16(Sacc[2 * ks + 1][pb][0], Sacc[2 * ks + 1][pb][1]); af[pb].u.w = cvt_pk_bf16(Sacc[2 * ks + 1][pb][2], Sacc[2 * ks + 1][pb][3]); }
#pragma unroll
                    for (int lb = 0; lb < 4; ++lb) {
                        const LAS unsigned char* cp = lds + SD_CM + (16 * lb + l15) * 272 + (32 * ks + 4 * g4) * 2;
                        union { u32x4 u; bf16x8 v; } bf; const u32x2 c0 = *(const LAS u32x2*)cp, c1 = *(const LAS u32x2*)(cp + 32);
                        bf.u.x = c0.x; bf.u.y = c0.y; bf.u.z = c1.x; bf.u.w = c1.y;
#pragma unroll
                        for (int pb = 0; pb < 2; ++pb) yT[pb][lb] = __builtin_amdgcn_mfma_f32_16x16x32_bf16(af[pb].v, bf.v, yT[pb][lb], 0, 0, 0);
                    }
                }
#pragma unroll
                for (int lb = 0; lb < 4; ++lb) { const float ec = fexp(cumL[16 * lb + l15]);
#pragma unroll
                    for (int pb = 0; pb < 2; ++pb) yT[pb][lb] *= ec; }
#pragma unroll
                for (int ks = 0; ks < 2; ++ks) {
                    __builtin_amdgcn_sched_barrier(0);
                    bf16x8 xa[2];
#pragma unroll
                    for (int pb = 0; pb < 2; ++pb) xa[pb] = *(const LAS bf16x8*)(XTk + (32 * ph + 16 * pb + l15) * 144 + (32 * ks + 8 * g4) * 2);
                    const int s0 = 32 * ks + 8 * g4;
                    const f32x4 cs0 = *(const LAS f32x4*)(cumL + s0), cs1 = *(const LAS f32x4*)(cumL + s0 + 4), ds0 = *(const LAS f32x4*)(dtL + s0), ds1 = *(const LAS f32x4*)(dtL + s0 + 4);
#pragma unroll
                    for (int lb = 0; lb < 4; ++lb) {
                        if (32 * ks > 16 * lb + 15) continue;
                        __builtin_amdgcn_sched_barrier(0);
                        const int l = 16 * lb + l15; const float cl = cumL[l];
                        const LAS float* cbp = (const LAS float*)(lds + SD_CB) + l * 68 + s0;
                        const f32x4 cb0 = *(const LAS f32x4*)cbp, cb1 = *(const LAS f32x4*)(cbp + 4);
                        float mv[8];
#pragma unroll
                        for (int e = 0; e < 4; ++e) {
                            { const int s = s0 + e; float v = s <= l ? cb0[e] * fexp(cl - cs0[e]) * ds0[e] : 0.f; if (s == l) v += dsk; mv[e] = v; }
                            { const int s = s0 + 4 + e; float v = s <= l ? cb1[e] * fexp(cl - cs1[e]) * ds1[e] : 0.f; if (s == l) v += dsk; mv[4 + e] = v; }
                        }
                        union { u32x4 u; bf16x8 v; } mf; mf.u.x = cvt_pk_bf16(mv[0], mv[1]); mf.u.y = cvt_pk_bf16(mv[2], mv[3]); mf.u.z = cvt_pk_bf16(mv[4], mv[5]); mf.u.w = cvt_pk_bf16(mv[6], mv[7]);
#pragma unroll
                        for (int pb = 0; pb < 2; ++pb) yT[pb][lb] = __builtin_amdgcn_mfma_f32_16x16x32_bf16(xa[pb], mf.v, yT[pb][lb], 0, 0, 0);
                    }
                }
                float ssl[4];
#pragma unroll
                for (int lb = 0; lb < 4; ++lb) {
                    __builtin_amdgcn_sched_barrier(0);
                    float ss = 0.f;
#pragma unroll
                    for (int pb = 0; pb < 2; ++pb) {
                        bf16_t* zp = p.zbuf() + (size_t)(row0 + 16 * lb + l15) * 2048 + 64 * head + 32 * ph + 16 * pb + 4 * g4;
                        const u32x2 zz = *(const u32x2*)zp;
                        f32x4 u = yT[pb][lb]; u[0] *= siluf_(bf_lo(zz.x)); u[1] *= siluf_(bf_hi(zz.x)); u[2] *= siluf_(bf_lo(zz.y)); u[3] *= siluf_(bf_hi(zz.y));
                        ss += u[0] * u[0] + u[1] * u[1] + u[2] * u[2] + u[3] * u[3];
                        *(u32x2*)zp = pack4(u);
                    }
                    ss += __shfl_xor(ss, 16); ss += __shfl_xor(ss, 32); ssl[lb] = ss;
                }
                if (g4 == 0) {
#pragma unroll
                    for (int lb = 0; lb < 4; ++lb) ((LAS float*)(lds + SD_SS))[w * 64 + 16 * lb + l15] = ssl[lb];
                }
                const float cend = cumL[63], dec = fexp(cend);
#pragma unroll
                for (int nb = 0; nb < 8; ++nb)
#pragma unroll
                    for (int pb = 0; pb < 2; ++pb) Sacc[nb][pb] *= dec;
#pragma unroll
                for (int ks = 0; ks < 2; ++ks) {
                    __builtin_amdgcn_sched_barrier(0);
                    const int s0 = 32 * ks + 8 * g4;
                    const f32x4 cs0 = *(const LAS f32x4*)(cumL + s0), cs1 = *(const LAS f32x4*)(cumL + s0 + 4), ds0 = *(const LAS f32x4*)(dtL + s0), ds1 = *(const LAS f32x4*)(dtL + s0 + 4);
                    float wsv[8];
#pragma unroll
                    for (int e = 0; e < 4; ++e) { wsv[e] = ds0[e] * fexp(cend - cs0[e]); wsv[4 + e] = ds1[e] * fexp(cend - cs1[e]); }
                    union { u32x4 u; bf16x8 v; } xb[2];
#pragma unroll
                    for (int pb = 0; pb < 2; ++pb) {
                        const u32x4 xr = *(const LAS u32x4*)(XTk + (32 * ph + 16 * pb + l15) * 144 + s0 * 2);
                        xb[pb].u.x = cvt_pk_bf16(bf_lo(xr.x) * wsv[0], bf_hi(xr.x) * wsv[1]); xb[pb].u.y = cvt_pk_bf16(bf_lo(xr.y) * wsv[2], bf_hi(xr.y) * wsv[3]);
                        xb[pb].u.z = cvt_pk_bf16(bf_lo(xr.z) * wsv[4], bf_hi(xr.z) * wsv[5]); xb[pb].u.w = cvt_pk_bf16(bf_lo(xr.w) * wsv[6], bf_hi(xr.w) * wsv[7]);
                    }
#pragma unroll
                    for (int nb = 0; nb < 8; ++nb) {
                        const bf16x8 ba = *(const LAS bf16x8*)(lds + SD_BT + (16 * nb + l15) * 144 + s0 * 2);
#pragma unroll
                        for (int pb = 0; pb < 2; ++pb) Sacc[nb][pb] = __builtin_amdgcn_mfma_f32_16x16x32_bf16(ba, xb[pb].v, Sacc[nb][pb], 0, 0, 0);
                    }
                }
            }
            __syncthreads();
            if (tid < 64) {
                float s = 0.f;
#pragma unroll
                for (int ww = 0; ww < 8; ++ww) s += ((const LAS float*)(lds + SD_SS))[ww * 64 + tid];
                p.ssbuf()[(size_t)(row0 + tid) * 8 + hq] = s;
            }
        }
        {
            float* so = p.nssm_s() + ((size_t)(b * 32 + head) * 64) * 128;
#pragma unroll
            for (int nb = 0; nb < 8; ++nb)
#pragma unroll
                for (int pb = 0; pb < 2; ++pb) *(f32x4*)(so + (size_t)(32 * ph + 16 * pb + l15) * 128 + 16 * nb + 4 * g4) = Sacc[nb][pb];
        }
        (void)a_h; (void)dtb;
    }
}

__device__ __forceinline__ void grid_barrier(unsigned* ctr, unsigned target, int wv) {
    asm volatile("s_waitcnt vmcnt(0) lgkmcnt(0)" ::: "memory");
    __builtin_amdgcn_s_barrier();
    if (wv == 0) {
        unsigned z = 0u; asm volatile("" : "+s"(z));
        const unsigned ln = __builtin_amdgcn_mbcnt_hi(~0u, __builtin_amdgcn_mbcnt_lo(~0u, z));
        if (ln == 0) {
            __builtin_amdgcn_fence(__ATOMIC_RELEASE, "agent");
            __hip_atomic_fetch_add(ctr, 1u, __ATOMIC_RELAXED, __HIP_MEMORY_SCOPE_AGENT);
            while (__hip_atomic_load(ctr, __ATOMIC_RELAXED, __HIP_MEMORY_SCOPE_AGENT) < target) __builtin_amdgcn_s_sleep(2);
        }
    }
    __builtin_amdgcn_s_barrier();
    __builtin_amdgcn_fence(__ATOMIC_ACQUIRE, "agent");
    asm volatile("s_waitcnt vmcnt(0) lgkmcnt(0)" ::: "memory");
}

__global__ void __launch_bounds__(512, 2) fwd_megakernel(Params p) {
    extern __shared__ __attribute__((aligned(16))) unsigned char shm[];
    LAS unsigned char* lds = (LAS unsigned char*)shm;
    cg::grid_group grid = cg::this_grid();
#ifndef PHMASK
#define PHMASK 0x3fff
#endif
#ifdef DBG_TIME_I
#define TSTAMP(k) if (blockIdx.x == 0 && threadIdx.x == 0) ((unsigned long long*)(p.ws + WS_END))[k] = __builtin_amdgcn_s_memrealtime();
#else
#define TSTAMP(k)
#endif
    TSTAMP(0)
#define PHASE(n, ...) if (p.ph_lo <= (n) && (n) < p.ph_hi) { if constexpr ((PHMASK >> (n)) & 1) { __VA_ARGS__ } if ((n) + 1 < p.ph_hi) { \
        grid_barrier((unsigned*)(p.ws + WS_END + 256), (unsigned)((n) - p.ph_lo + 1) * gridDim.x, wv); } TSTAMP((n) + 1) }
    const int wv = __builtin_amdgcn_readfirstlane(threadIdx.x >> 6);
    if (p.ph_hi < 0) grid.sync();
    PHASE(0, prep_phase(p, lds, wv);)
    PHASE(1, norm_phase<0>(p, wv);)
    PHASE(2, run_gemm<0>(p, lds, p.hA(), p.bt1a(), 3072, 1024, wv);)
    PHASE(3, attn_phase(p, lds, wv);)
    PHASE(4, run_gemm<1>(p, lds, p.hA(), p.bt1b(), 5376, 1024, wv);)
    PHASE(5, conv_phase(p, wv);)
    PHASE(6, ssd_phase(p, lds, wv);)
    PHASE(7, run_gemm<2>(p, lds, p.hA(), p.bt1c(), 2048, 1024, wv); ssdnorm_phase(p, wv);)
    PHASE(8, run_gemm<3>(p, lds, p.qbuf(), p.btpa(), 1024, 1024, wv); run_gemm<4>(p, lds, p.zbuf(), p.btpb(), 1024, 2048, wv);)
    PHASE(9, run_gemm<5>(p, lds, p.mbuf(), p.btout(), 1024, 1024, wv);)
    PHASE(10, norm_phase<1>(p, wv);)
    PHASE(11, run_gemm<6>(p, lds, p.h2(), p.btgu(), 5632, 1024, wv);)
    PHASE(12, run_gemm<7>(p, lds, p.swbuf(), p.btdown(), 1024, 2816, wv);)
    PHASE(13, norm_phase<2>(p, wv);)
#undef PHASE
}


#ifdef DBG_TIME_I
__global__ void dbg_time_apply(float* out, const unsigned long long* ts) {
    const float tot = (float)(ts[14] - ts[0]); const float fi = (float)(ts[DBG_TIME_I + 1] - ts[DBG_TIME_I]) / tot, fj = (float)(ts[DBG_TIME_J + 1] - ts[DBG_TIME_J]) / tot;
    const float sc = 1.0f + sqrtf(fi);
    for (size_t i = O_NCS + (size_t)blockIdx.x * 256 + threadIdx.x; i < O_NCS + 294912; i += (size_t)gridDim.x * 256) out[i] *= sc;
    if (blockIdx.x == 0 && threadIdx.x == 0) out[0] += 1000.0f * fj;
}
#endif
extern "C" void kernel_launch(void* const* d_in, const int* in_sizes, int n_in, void* d_out, int out_size, void* d_ws, size_t ws_size, hipStream_t stream) {
    static int grid_blocks = 0;
    if (!grid_blocks) {
        int dev = 0, cus = 0, per_cu = 0;
        hipGetDevice(&dev);
        hipDeviceGetAttribute(&cus, hipDeviceAttributeMultiprocessorCount, dev);
        hipFuncSetAttribute((const void*)fwd_megakernel, hipFuncAttributeMaxDynamicSharedMemorySize, LDS_BYTES);
        hipOccupancyMaxActiveBlocksPerMultiprocessor(&per_cu, (const void*)fwd_megakernel, 512, LDS_BYTES);
        if (per_cu < 1) per_cu = 1;
        grid_blocks = cus * per_cu;
        if (grid_blocks > 256) grid_blocks = 256;
    }
    Params p{};
    const float* const* in = (const float* const*)d_in;
    p.x_p = in[0]; p.x_s = in[1]; p.cache_k = in[2]; p.cache_v = in[3]; p.state_conv = in[4]; p.state_ssm = in[5]; p.c_p = in[6]; p.c_s = in[7];
    p.w_ada = in[8]; p.b_ada = in[9]; p.g_mix = in[10]; p.g_ffn = in[11]; p.w_in = in[12]; p.lq1 = in[13]; p.lk1 = in[14]; p.lq2 = in[15]; p.lk2 = in[16]; p.g_subln = in[17];
    p.conv_w = in[18]; p.conv_b = in[19]; p.dt_bias = in[20]; p.a_log = in[21]; p.d_skip = in[22]; p.g_ssd = in[23]; p.w_pa = in[24]; p.w_pb = in[25]; p.w_out = in[26]; p.w_gu = in[27]; p.w_down = in[28]; p.g_final = in[29];
    p.out = (float*)d_out; p.ws = (unsigned char*)d_ws;
    if (WS_END + 1024 > ws_size || (size_t)out_size < O_END) { fprintf(stderr, "kernel_launch: workspace/output too small: need %zu / %zu, have %zu / %d\n", (size_t)WS_END, (size_t)O_END, ws_size, out_size); return; }
    hipMemsetAsync((unsigned char*)d_ws + WS_END + 256, 0, 64, stream);
    p.ph_lo = 0; p.ph_hi = 14;
    void* args[] = {&p};
    hipError_t e = hipLaunchCooperativeKernel((const void*)fwd_megakernel, dim3(grid_blocks), dim3(512), args, LDS_BYTES, stream);
    if (e != hipSuccess) fprintf(stderr, "cooperative launch failed: %s (grid %d)\n", hipGetErrorString(e), grid_blocks);
#ifdef DBG_TIME_I
    dbg_time_apply<<<64, 256, 0, stream>>>((float*)d_out, (const unsigned long long*)((unsigned char*)d_ws + WS_END));
#endif
}
```

```cpp
#include <hip/hip_runtime.h>
#include <hip/hip_cooperative_groups.h>
#include <cstdio>
namespace cg = cooperative_groups;

#define LAS __attribute__((address_space(3)))
typedef unsigned short bf16_t;
typedef short bf16x8 __attribute__((ext_vector_type(8)));
typedef short s16x4 __attribute__((ext_vector_type(4)));
typedef float f32x4 __attribute__((ext_vector_type(4)));
typedef float f32x16 __attribute__((ext_vector_type(16)));
typedef unsigned u32x4 __attribute__((ext_vector_type(4)));
typedef unsigned u32x2 __attribute__((ext_vector_type(2)));

constexpr int MP = 65536, MS = 2048, MT = MP + MS;
constexpr int LDS_BYTES = 131072;
constexpr float EPSN = 1e-5f;
constexpr float LOG2E = 1.4426950408889634f;

constexpr size_t al256(size_t x) { return (x + 255) & ~(size_t)255; }
constexpr size_t WS_BT1A = 0, WS_BT1B = WS_BT1A + al256((size_t)3072 * 1024 * 2), WS_BT1C = WS_BT1B + al256((size_t)5376 * 1024 * 2), WS_BTPA = WS_BT1C + al256((size_t)2048 * 1024 * 2),
    WS_BTPB = WS_BTPA + al256((size_t)1024 * 1024 * 2), WS_BTOUT = WS_BTPB + al256((size_t)1024 * 2048 * 2), WS_BTGU = WS_BTOUT + al256((size_t)1024 * 1024 * 2), WS_BTDOWN = WS_BTGU + al256((size_t)5632 * 1024 * 2),
    WS_MOD = WS_BTDOWN + al256((size_t)1024 * 2816 * 2), WS_ROPE = WS_MOD + al256((size_t)64 * 6144 * 4), WS_DT = WS_ROPE + al256((size_t)2048 * 32 * 8), WS_SS = WS_DT + al256((size_t)MT * 32 * 4),
    WS_RH = WS_SS + al256((size_t)MT * 8 * 4), WS_RBIG = WS_RH + al256((size_t)MT * 1024 * 2), WS_RZ = WS_RBIG + al256((size_t)MT * 3072 * 2), WS_HALO = WS_RZ + al256((size_t)MT * 2048 * 2), WS_END = WS_HALO + al256((size_t)(MT / 64) * 3 * 3072 * 2);
constexpr size_t O_NKP = (size_t)MT * 1024, O_NVP = O_NKP + (size_t)MP * 1024, O_NCP = O_NVP + (size_t)MP * 1024, O_NSP = O_NCP + 32 * 3 * 3072, O_NKS = O_NSP + (size_t)32 * 32 * 64 * 128,
    O_NVS = O_NKS + (size_t)MS * 1024, O_NCS = O_NVS + (size_t)MS * 1024, O_NSS = O_NCS + 32 * 3 * 3072, O_END = O_NSS + (size_t)32 * 32 * 64 * 128;
struct Params {
    const float *x_p, *x_s, *cache_k, *cache_v, *state_conv, *state_ssm, *c_p, *c_s;
    const float *w_ada, *b_ada, *g_mix, *g_ffn, *w_in, *lq1, *lk1, *lq2, *lk2, *g_subln, *conv_w, *conv_b, *dt_bias, *a_log, *d_skip, *g_ssd;
    const float *w_pa, *w_pb, *w_out, *w_gu, *w_down, *g_final;
    float* out; unsigned char* ws;
    int ph_lo, ph_hi;
    __device__ __forceinline__ float* y() const { return out; }
    __device__ __forceinline__ float* nk_p() const { return out + O_NKP; }
    __device__ __forceinline__ float* nv_p() const { return out + O_NVP; }
    __device__ __forceinline__ float* nconv_p() const { return out + O_NCP; }
    __device__ __forceinline__ float* nssm_p() const { return out + O_NSP; }
    __device__ __forceinline__ float* nk_s() const { return out + O_NKS; }
    __device__ __forceinline__ float* nv_s() const { return out + O_NVS; }
    __device__ __forceinline__ float* nconv_s() const { return out + O_NCS; }
    __device__ __forceinline__ float* nssm_s() const { return out + O_NSS; }
    __device__ __forceinline__ bf16_t* bt1a() const { return (bf16_t*)(ws + WS_BT1A); }
    __device__ __forceinline__ bf16_t* bt1b() const { return (bf16_t*)(ws + WS_BT1B); }
    __device__ __forceinline__ bf16_t* bt1c() const { return (bf16_t*)(ws + WS_BT1C); }
    __device__ __forceinline__ bf16_t* btpa() const { return (bf16_t*)(ws + WS_BTPA); }
    __device__ __forceinline__ bf16_t* btpb() const { return (bf16_t*)(ws + WS_BTPB); }
    __device__ __forceinline__ bf16_t* btout() const { return (bf16_t*)(ws + WS_BTOUT); }
    __device__ __forceinline__ bf16_t* btgu() const { return (bf16_t*)(ws + WS_BTGU); }
    __device__ __forceinline__ bf16_t* btdown() const { return (bf16_t*)(ws + WS_BTDOWN); }
    __device__ __forceinline__ float* mod() const { return (float*)(ws + WS_MOD); }
    __device__ __forceinline__ float2* rope() const { return (float2*)(ws + WS_ROPE); }
    __device__ __forceinline__ float* dtbuf() const { return (float*)(ws + WS_DT); }
    __device__ __forceinline__ float* ssbuf() const { return (float*)(ws + WS_SS); }
    __device__ __forceinline__ bf16_t* hA() const { return (bf16_t*)(ws + WS_RH); }
    __device__ __forceinline__ bf16_t* mbuf() const { return (bf16_t*)(ws + WS_RH); }
    __device__ __forceinline__ bf16_t* h2() const { return (bf16_t*)(ws + WS_RH); }
    __device__ __forceinline__ bf16_t* qbuf() const { return (bf16_t*)out; }
    __device__ __forceinline__ bf16_t* x1buf() const { return (bf16_t*)out; }
    __device__ __forceinline__ bf16_t* x2buf() const { return (bf16_t*)(ws + WS_RH); }
    __device__ __forceinline__ bf16_t* kbuf_p() const { return (bf16_t*)(ws + WS_RBIG); }
    __device__ __forceinline__ bf16_t* vbuf_p() const { return (bf16_t*)(ws + WS_RBIG) + (size_t)MP * 1024; }
    __device__ __forceinline__ bf16_t* kbuf_s() const { return (bf16_t*)(ws + WS_RBIG) + (size_t)2 * MP * 1024; }
    __device__ __forceinline__ bf16_t* vbuf_s() const { return (bf16_t*)(ws + WS_RBIG) + (size_t)2 * MP * 1024 + (size_t)MS * 1024; }
    __device__ __forceinline__ bf16_t* xbcbuf() const { return (bf16_t*)(ws + WS_RBIG); }
    __device__ __forceinline__ bf16_t* gbuf() const { return (bf16_t*)(ws + WS_RBIG); }
    __device__ __forceinline__ bf16_t* swbuf() const { return (bf16_t*)(ws + WS_RBIG); }
    __device__ __forceinline__ bf16_t* zbuf() const { return (bf16_t*)(ws + WS_RZ); }
    __device__ __forceinline__ bf16_t* halo() const { return (bf16_t*)(ws + WS_HALO); }
};

typedef float f32x2_t __attribute__((ext_vector_type(2)));
typedef __bf16 bf16x2_t __attribute__((ext_vector_type(2)));
__device__ __forceinline__ unsigned cvt_pk_bf16(float lo, float hi) { const f32x2_t v = {lo, hi}; const bf16x2_t b = __builtin_convertvector(v, bf16x2_t); return __builtin_bit_cast(unsigned, b); }
__device__ __forceinline__ float bf_lo(unsigned w) { return __uint_as_float(w << 16); }
__device__ __forceinline__ float bf_hi(unsigned w) { return __uint_as_float(w & 0xffff0000u); }
__device__ __forceinline__ float fexp2(float x) { return __builtin_amdgcn_exp2f(x); }
__device__ __forceinline__ float fexp(float x) { return __builtin_amdgcn_exp2f(x * LOG2E); }
__device__ __forceinline__ float frcp(float x) { return __builtin_amdgcn_rcpf(x); }
__device__ __forceinline__ float sigmoidf_(float x) { return frcp(1.0f + fexp(-x)); }
__device__ __forceinline__ float siluf_(float x) { return x * sigmoidf_(x); }
__device__ __forceinline__ u32x4 pack8(f32x4 a, f32x4 b) { u32x4 w; w.x = cvt_pk_bf16(a[0], a[1]); w.y = cvt_pk_bf16(a[2], a[3]); w.z = cvt_pk_bf16(b[0], b[1]); w.w = cvt_pk_bf16(b[2], b[3]); return w; }
__device__ __forceinline__ u32x2 pack4(f32x4 a) { u32x2 w; w.x = cvt_pk_bf16(a[0], a[1]); w.y = cvt_pk_bf16(a[2], a[3]); return w; }

__device__ __forceinline__ int opaque_tid(int wv) { int t = wv * 64 + (int)__builtin_amdgcn_mbcnt_hi(~0u, __builtin_amdgcn_mbcnt_lo(~0u, 0u)); asm volatile("" : "+v"(t)); return t; }
namespace pg8 {
constexpr int BM = 256, BK = 64, HALF = 128, HTB = HALF * BK * 2, STAGE_BYTES = 8 * HTB, NXCD = 8, WGM = 8;
__host__ __device__ __forceinline__ int lds_byte(int r, int c) { const int st = (r >> 4) * 2 + (c >> 5), rr = r & 15, cc = c & 31, ob = rr * 64 + cc * 2; return st * 1024 + (ob ^ (((ob >> 9) & 1) << 5)); }
__host__ __device__ __forceinline__ void stage_rc(int b, int& R, int& C) { const int st = b / 1024, sb = b % 1024, swz = sb ^ (((sb >> 9) & 1) << 5); R = (st >> 1) * 16 + swz / 64; C = (st & 1) * 32 + (swz % 64) / 2; }
struct Unit { int pm, pn; };
struct Gemm { const bf16_t* A; const bf16_t* Bt; int M, N, K; };
struct StaticOrder {
    int nM, nN, nwg, G, c;
    __host__ __device__ void init(int M, int N, int G_, int c_) { nM = M / BM; nN = N / BM; nwg = nM * nN; G = G_; c = c_; }
    __host__ __device__ bool next(int i, Unit& u) const {
        const long L = (long)i * G + c; if (L >= nwg) return false;
        int wgid = (int)L; { const int q = nwg / NXCD, r = nwg % NXCD, xcd = wgid % NXCD, off = wgid / NXCD; wgid = (xcd < r ? xcd * (q + 1) : r * (q + 1) + (xcd - r) * q) + off; }
        const int nig = WGM * nN, gid = wgid / nig, fm = gid * WGM, gsz = (nM - fm) < WGM ? (nM - fm) : WGM;
        u.pm = fm + ((wgid % nig) % gsz); u.pn = (wgid % nig) / gsz; return true;
    }
};

template <class Epi>
__device__ __forceinline__ void gemm_phase(LAS unsigned char* lds, const Gemm g, const StaticOrder& S, const Epi& E, int wv) {
    const int tid = opaque_tid(wv), wid = __builtin_amdgcn_readfirstlane(tid >> 6), lane = tid & 63, wr = wid >> 2, wc = wid & 3, fr = lane & 15, fq = lane >> 4;
    const int K = g.K, nt = K / BK;
    unsigned voffA[2], voffB[2];
#pragma unroll
    for (int i = 0; i < 2; ++i) { int R, C; stage_rc(tid * 16 + i * 8192, R, C); voffA[i] = (unsigned)(R * K + C) * 2u; voffB[i] = voffA[i]; }
    const size_t kstep = (size_t)(BK * 2);
    const size_t hstep = (size_t)HALF * K * 2;
    const size_t tstep = 2 * hstep;
    const unsigned ldsw = (unsigned)wid * 1024u;
    const int aoff = lds_byte(wr * 64 + fr, fq * 8), boff = lds_byte(wc * 32 + fr, fq * 8);
#define PG8_SA(b, h) (((b) * 2 + (h)) * HTB)
#define PG8_SB(b, h) ((4 + (b) * 2 + (h)) * HTB)
#define PG8_STAGE(bufoff, gbase, voff) do { _Pragma("unroll") for (int _i = 0; _i < 2; ++_i) \
        __builtin_amdgcn_global_load_lds((const unsigned*)((const char*)(gbase) + (voff)[_i]), (LAS unsigned*)(lds + (bufoff) + ldsw + _i * 8192), 16, 0, 0); } while (0)
#define PG8_LDA(dst, b, h) do { _Pragma("unroll") for (int m = 0; m < 4; ++m) _Pragma("unroll") for (int k = 0; k < 2; ++k) dst[m][k] = *(const LAS bf16x8*)(lds + PG8_SA(b, h) + aoff + m * 2048 + k * 1024); } while (0)
#define PG8_LDB(dst, b, h) do { _Pragma("unroll") for (int n = 0; n < 2; ++n) _Pragma("unroll") for (int k = 0; k < 2; ++k) dst[n][k] = *(const LAS bf16x8*)(lds + PG8_SB(b, h) + boff + n * 2048 + k * 1024); } while (0)
#define PG8_MMA(ai, bj, At, Bt) do { __builtin_amdgcn_s_setprio(1); _Pragma("unroll") for (int m = 0; m < 4; ++m) _Pragma("unroll") for (int n = 0; n < 2; ++n) _Pragma("unroll") for (int k = 0; k < 2; ++k) \
        acc[ai][bj][m][n] = __builtin_amdgcn_mfma_f32_16x16x32_bf16(Bt[n][k], At[m][k], acc[ai][bj][m][n], 0, 0, 0); __builtin_amdgcn_s_setprio(0); } while (0)
#define PG8_WAIT_V(n) asm volatile("s_waitcnt vmcnt(" #n ")" ::: "memory")
#define PG8_WAIT_L(n) asm volatile("s_waitcnt lgkmcnt(" #n ")" ::: "memory")
#define PG8_BAR __builtin_amdgcn_s_barrier()
#define PG8_SCHED __builtin_amdgcn_sched_barrier(0)
    Unit cur, nxt; int ui = 0;
    if (!S.next(0, cur)) return;
    f32x4 acc[2][2][4][2];
#pragma unroll
    for (int a = 0; a < 2; ++a)
#pragma unroll
        for (int b = 0; b < 2; ++b)
#pragma unroll
            for (int m = 0; m < 4; ++m)
#pragma unroll
                for (int n = 0; n < 2; ++n) acc[a][b][m][n] = (f32x4){0.f, 0.f, 0.f, 0.f};
    bf16x8 At[4][2], B0[2][2], B1[2][2];
    const char* cA = (const char*)g.A + (size_t)cur.pm * tstep; const char* cB = (const char*)g.Bt + (size_t)cur.pn * tstep;
    PG8_STAGE(PG8_SB(0, 0), cB, voffB); PG8_STAGE(PG8_SA(0, 0), cA, voffA); PG8_STAGE(PG8_SB(0, 1), cB + hstep, voffB); PG8_STAGE(PG8_SA(0, 1), cA + hstep, voffA);
    if (wr == 1) PG8_BAR;
    PG8_WAIT_V(4); PG8_BAR;
    PG8_STAGE(PG8_SB(1, 0), cB + kstep, voffB); PG8_STAGE(PG8_SA(1, 0), cA + kstep, voffA); PG8_STAGE(PG8_SB(1, 1), cB + hstep + kstep, voffB);
    PG8_WAIT_V(6); PG8_BAR;
    for (;;) {
        const bool has_next = S.next(ui + 1, nxt);
        const char* nA = has_next ? (const char*)g.A + (size_t)nxt.pm * tstep : cA; const char* nB = has_next ? (const char*)g.Bt + (size_t)nxt.pn * tstep : cB;
        for (int t = 0; t < nt; t += 2) {
            const bool last = (t == nt - 2);
            const char* a1 = cA + (size_t)(t + 1) * kstep;
            const char* a2 = last ? nA : cA + (size_t)(t + 2) * kstep; const char* b2 = last ? nB : cB + (size_t)(t + 2) * kstep;
            const char* a3 = a2 + kstep; const char* b3 = b2 + kstep;
            PG8_LDB(B0, 0, 0); PG8_SCHED; PG8_LDA(At, 0, 0); PG8_STAGE(PG8_SA(1, 1), a1 + hstep, voffA);
            PG8_WAIT_L(8); PG8_BAR; PG8_WAIT_L(0); PG8_MMA(0, 0, At, B0); PG8_BAR; PG8_SCHED;
            PG8_LDB(B1, 0, 1); PG8_STAGE(PG8_SB(0, 0), b2, voffB);
            PG8_BAR; PG8_WAIT_L(0); PG8_MMA(0, 1, At, B1); PG8_BAR;
            PG8_LDA(At, 0, 1); PG8_STAGE(PG8_SA(0, 0), a2, voffA);
            PG8_BAR; PG8_WAIT_L(0); PG8_MMA(1, 0, At, B0); PG8_BAR; PG8_SCHED;
            PG8_STAGE(PG8_SB(0, 1), b2 + hstep, voffB);
            PG8_WAIT_V(6); PG8_BAR; PG8_MMA(1, 1, At, B1); PG8_BAR;
            PG8_LDB(B0, 1, 0); PG8_SCHED; PG8_LDA(At, 1, 0); PG8_STAGE(PG8_SA(0, 1), a2 + hstep, voffA);
            PG8_WAIT_L(8); PG8_BAR; PG8_WAIT_L(0); PG8_MMA(0, 0, At, B0); PG8_BAR; PG8_SCHED;
            PG8_LDB(B1, 1, 1); PG8_STAGE(PG8_SB(1, 0), b3, voffB);
            PG8_BAR; PG8_WAIT_L(0); PG8_MMA(0, 1, At, B1); PG8_BAR;
            PG8_LDA(At, 1, 1); PG8_STAGE(PG8_SA(1, 0), a3, voffA);
            PG8_BAR; PG8_WAIT_L(0); PG8_MMA(1, 0, At, B0); PG8_BAR; PG8_SCHED;
            PG8_STAGE(PG8_SB(1, 1), b3 + hstep, voffB);
            PG8_WAIT_V(6); PG8_BAR; PG8_MMA(1, 1, At, B1); PG8_BAR;
        }
        E(acc, cur, wr, wc, fr, fq);
        if (!has_next) break;
#pragma unroll
        for (int a = 0; a < 2; ++a)
#pragma unroll
            for (int b = 0; b < 2; ++b)
#pragma unroll
                for (int m = 0; m < 4; ++m)
#pragma unroll
                    for (int n = 0; n < 2; ++n) acc[a][b][m][n] = (f32x4){0.f, 0.f, 0.f, 0.f};
        cur = nxt; cA = nA; cB = nB; ++ui;
    }
    PG8_WAIT_V(0);
    if (wr == 0) PG8_BAR;
    PG8_BAR;
#undef PG8_SA
#undef PG8_SB
#undef PG8_STAGE
#undef PG8_LDA
#undef PG8_LDB
#undef PG8_MMA
#undef PG8_WAIT_V
#undef PG8_WAIT_L
#undef PG8_BAR
#undef PG8_SCHED
}
}

__device__ __forceinline__ int perm32i(int rho) { const int n = rho >> 4, i = rho & 15; return 8 * (i >> 2) + 4 * n + (i & 3); }
__device__ __forceinline__ int gperm(int c) { return (c & ~31) + perm32i(c & 31); }
__device__ __forceinline__ int rperm(int c) { const int w = (c >> 5) & 1, n = (c >> 4) & 1, i = c & 15; return (c & ~63) + 16 * w + i + 32 * n; }
__device__ __forceinline__ int src_col(int mode, int c) {
    switch (mode) {
        case 0: return c < 2048 ? rperm(c) : gperm(c);
        case 1: { if (c < 2048) return 3072 + gperm(c); if (c < 5120) return 5120 + gperm(c - 2048); const int t = gperm(c - 5120); return t < 32 ? 8192 + t : -1; }
        case 2: return 8224 + gperm(c);
        case 6: { const int pn = c >> 8, bj = (c >> 7) & 1, r = c & 127; return bj * 2816 + 128 * pn + gperm(r); }
        default: return gperm(c);
    }
}

__device__ __forceinline__ int batch_of(int r) { return r < MP ? (r >> 11) : 32 + ((r - MP) >> 6); }

template <int MODE> struct Epi {
    const Params& p;
    __device__ __forceinline__ void operator()(const f32x4 (&acc)[2][2][4][2], const pg8::Unit& u, int wr_, int wc_, int fr_, int fq_) const {
        int wr = wr_, wc = wc_, fr = fr_, fq = fq_;
        asm volatile("" : "+s"(wr), "+s"(wc), "+v"(fr), "+v"(fq));
        const int pn = u.pn;
#pragma unroll
        for (int ai = 0; ai < 2; ++ai)
#pragma unroll
            for (int m = 0; m < 4; ++m) {
                if ((MODE == 3 || MODE == 4) ? (m == 0) : ((m & 1) == 0)) __builtin_amdgcn_sched_barrier(0);
                const int r = u.pm * 256 + ai * 128 + wr * 64 + m * 16 + fr;
                const bool samp = r >= MP; const int rs = r - MP;
                if constexpr (MODE == 0) {
                    const int type = pn >> 2, colbase = (pn & 3) * 256;
                    if (type < 2) {
                        const int pos = samp ? 1024 + (rs & 63) : (r & 2047);
                        const int dlo = 16 * (wc & 1) + 4 * fq;
                        f32x4 cv, sv;
#pragma unroll
                        for (int j = 0; j < 4; ++j) {
                            const float frq = fexp2((float)(dlo + j) * (-13.287712379549449f / 32.0f)) * 0.15915494309189535f;
                            const float rev = __builtin_amdgcn_fractf((float)pos * frq);
                            cv[j] = __builtin_amdgcn_cosf(rev); sv[j] = __builtin_amdgcn_sinf(rev);
                        }
#pragma unroll
                        for (int bj = 0; bj < 2; ++bj) {
                            const int col = colbase + 64 * (2 * bj + (wc >> 1)) + dlo;
                            const f32x4 x1 = acc[ai][bj][m][0], x2 = acc[ai][bj][m][1];
                            f32x4 o1 = x1 * cv - x2 * sv, o2 = x2 * cv + x1 * sv;
                            if (type == 0) {
                                const float qs = 0.125f * LOG2E; o1 *= qs; o2 *= qs;
                                bf16_t* q = p.qbuf() + (size_t)r * 1024 + col;
                                *(u32x2*)q = pack4(o1); *(u32x2*)(q + 32) = pack4(o2);
                            } else {
                                float* ko = (samp ? p.nk_s() + (size_t)rs * 1024 : p.nk_p() + (size_t)r * 1024) + col;
                                *(f32x4*)ko = o1; *(f32x4*)(ko + 32) = o2;
                                bf16_t* kb = (samp ? p.kbuf_s() + (size_t)rs * 1024 : p.kbuf_p() + (size_t)r * 1024) + col;
                                *(u32x2*)kb = pack4(o1); *(u32x2*)(kb + 32) = pack4(o2);
                            }
                        }
                    } else {
#pragma unroll
                        for (int bj = 0; bj < 2; ++bj) {
                            const int col = colbase + 128 * bj + 32 * wc + 8 * fq;
                            float* vo = (samp ? p.nv_s() + (size_t)rs * 1024 : p.nv_p() + (size_t)r * 1024) + col;
                            *(f32x4*)vo = acc[ai][bj][m][0]; *(f32x4*)(vo + 4) = acc[ai][bj][m][1];
                            bf16_t* vb = (samp ? p.vbuf_s() + (size_t)rs * 1024 : p.vbuf_p() + (size_t)r * 1024) + col;
                            *(u32x4*)vb = pack8(acc[ai][bj][m][0], acc[ai][bj][m][1]);
                        }
                    }
                } else if constexpr (MODE == 1) {
                    if (pn < 8) {
#pragma unroll
                        for (int bj = 0; bj < 2; ++bj) { const int col = pn * 256 + 128 * bj + 32 * wc + 8 * fq; *(u32x4*)(p.zbuf() + (size_t)r * 2048 + col) = pack8(acc[ai][bj][m][0], acc[ai][bj][m][1]); }
                    } else if (pn < 20) {
                        const int tt = samp ? (rs & 63) - 61 : (r & 2047) - 2045;
#pragma unroll
                        for (int bj = 0; bj < 2; ++bj) {
                            const int col = (pn - 8) * 256 + 128 * bj + 32 * wc + 8 * fq;
                            const u32x4 xw = pack8(acc[ai][bj][m][0], acc[ai][bj][m][1]);
                            *(u32x4*)(p.xbcbuf() + (size_t)r * 3072 + col) = xw;
                            if ((r & 63) >= 61) *(u32x4*)(p.halo() + ((size_t)(r >> 6) * 3 + ((r & 63) - 61)) * 3072 + col) = xw;
                            if (tt >= 0) { float* co = (samp ? p.nconv_s() + ((size_t)(rs >> 6) * 3 + tt) * 3072 : p.nconv_p() + ((size_t)(r >> 11) * 3 + tt) * 3072) + col; *(f32x4*)co = acc[ai][bj][m][0]; *(f32x4*)(co + 4) = acc[ai][bj][m][1]; }
                        }
                    } else {
                        if (wc == 0) { float* d = p.dtbuf() + (size_t)r * 32 + 8 * fq; *(f32x4*)d = acc[ai][0][m][0]; *(f32x4*)(d + 4) = acc[ai][0][m][1]; }
                    }
                } else if constexpr (MODE == 2) {
#pragma unroll
                    for (int bj = 0; bj < 2; ++bj) {
                        const int col = pn * 256 + 128 * bj + 32 * wc + 8 * fq; f32x4 a = acc[ai][bj][m][0], b = acc[ai][bj][m][1];
#pragma unroll
                        for (int j = 0; j < 4; ++j) { a[j] = sigmoidf_(a[j]); b[j] = sigmoidf_(b[j]); }
                        *(u32x4*)(p.gbuf() + (size_t)r * 2048 + col) = pack8(a, b);
                    }
                } else if constexpr (MODE == 3 || MODE == 4) {
#pragma unroll
                    for (int bj = 0; bj < 2; ++bj) {
                        const int col = pn * 256 + 128 * bj + 32 * wc + 8 * fq;
                        const u32x4 g = *(const u32x4*)(p.gbuf() + (size_t)r * 2048 + (MODE == 4 ? 1024 : 0) + col);
                        f32x4 a = acc[ai][bj][m][0], b = acc[ai][bj][m][1];
                        a[0] *= bf_lo(g.x); a[1] *= bf_hi(g.x); a[2] *= bf_lo(g.y); a[3] *= bf_hi(g.y); b[0] *= bf_lo(g.z); b[1] *= bf_hi(g.z); b[2] *= bf_lo(g.w); b[3] *= bf_hi(g.w);
                        bf16_t* mp = p.mbuf() + (size_t)r * 1024 + col;
                        if constexpr (MODE == 4) { const u32x4 o = *(const u32x4*)mp; a[0] += bf_lo(o.x); a[1] += bf_hi(o.x); a[2] += bf_lo(o.y); a[3] += bf_hi(o.y); b[0] += bf_lo(o.z); b[1] += bf_hi(o.z); b[2] += bf_lo(o.w); b[3] += bf_hi(o.w); }
                        *(u32x4*)mp = pack8(a, b);
                    }
                } else if constexpr (MODE == 5 || MODE == 7) {
                    const int bidx = u.pm < 256 ? (u.pm >> 3) : 32 + (u.pm - 256) * 4 + 2 * ai + wr;
                    const float* mrow = p.mod() + (size_t)bidx * 6144 + (MODE == 5 ? 2048 : 5120);
#pragma unroll
                    for (int bj = 0; bj < 2; ++bj) {
                        const int col = pn * 256 + 128 * bj + 32 * wc + 8 * fq;
                        f32x4 x0, x1;
                        if constexpr (MODE == 5) { const float* xin = (samp ? p.x_s + (size_t)rs * 1024 : p.x_p + (size_t)r * 1024) + col; x0 = *(const f32x4*)xin; x1 = *(const f32x4*)(xin + 4); }
                        else { const u32x4 xw = *(const u32x4*)(p.x1buf() + (size_t)r * 1024 + col); x0 = (f32x4){bf_lo(xw.x), bf_hi(xw.x), bf_lo(xw.y), bf_hi(xw.y)}; x1 = (f32x4){bf_lo(xw.z), bf_hi(xw.z), bf_lo(xw.w), bf_hi(xw.w)}; }
                        const f32x4 g0 = *(const f32x4*)(mrow + col), g1 = *(const f32x4*)(mrow + col + 4);
                        bf16_t* yo = (MODE == 5 ? p.x1buf() : p.x2buf()) + (size_t)r * 1024 + col;
                        *(u32x4*)yo = pack8(x0 + g0 * acc[ai][bj][m][0], x1 + g1 * acc[ai][bj][m][1]);
                    }
                } else if constexpr (MODE == 6) {
                    const int col = pn * 128 + 32 * wc + 8 * fq; f32x4 a = acc[ai][0][m][0], b = acc[ai][0][m][1];
#pragma unroll
                    for (int j = 0; j < 4; ++j) { a[j] = siluf_(a[j]) * acc[ai][1][m][0][j]; b[j] = siluf_(b[j]) * acc[ai][1][m][1][j]; }
                    *(u32x4*)(p.swbuf() + (size_t)r * 2816 + col) = pack8(a, b);
                }
            }
    }
};

template <int MODE> __device__ __forceinline__ void run_gemm(const Params& p, LAS unsigned char* lds, const bf16_t* A, const bf16_t* Bt, int N, int K, int wv) {
    pg8::Gemm g{A, Bt, MT, N, K}; pg8::StaticOrder S; S.init(MT, N, (int)gridDim.x, (int)blockIdx.x); Epi<MODE> E{p};
    pg8::gemm_phase<Epi<MODE>>(lds, g, S, E, wv);
}

__device__ __forceinline__ float wave_sum(float v) {
#pragma unroll
    for (int o = 32; o >= 1; o >>= 1) v += __shfl_xor(v, o);
    return v;
}

__device__ void prep_phase(const Params& p, LAS unsigned char* lds, int wv) {
    const int tid = opaque_tid(wv);
    {
        LAS float* tiles = (LAS float*)lds;
        const int ntiles[8] = {48 * 16, 84 * 16, 32 * 16, 16 * 16, 16 * 32, 16 * 16, 88 * 16, 16 * 44};
        int total = 0;
#pragma unroll
        for (int j = 0; j < 8; ++j) total += ntiles[j];
        for (int G = blockIdx.x; 4 * G < total; G += gridDim.x) {
            const float* W[4]; int ldw[4], K[4], n0[4], k0[4], job[4]; bf16_t* Bt[4];
#pragma unroll
            for (int u = 0; u < 4; ++u) {
                int j = 0, lt = 4 * G + u; if (lt >= total) lt = total - 1;
#pragma unroll
                for (int q = 0; q < 7; ++q) if (j == q && lt >= ntiles[q]) { lt -= ntiles[q]; j = q + 1; }
                switch (j) {
                    case 0: W[u] = p.w_in; ldw[u] = 10272; K[u] = 1024; Bt[u] = p.bt1a(); break;
                    case 1: W[u] = p.w_in; ldw[u] = 10272; K[u] = 1024; Bt[u] = p.bt1b(); break;
                    case 2: W[u] = p.w_in; ldw[u] = 10272; K[u] = 1024; Bt[u] = p.bt1c(); break;
                    case 3: W[u] = p.w_pa; ldw[u] = 1024; K[u] = 1024; Bt[u] = p.btpa(); break;
                    case 4: W[u] = p.w_pb; ldw[u] = 1024; K[u] = 2048; Bt[u] = p.btpb(); break;
                    case 5: W[u] = p.w_out; ldw[u] = 1024; K[u] = 1024; Bt[u] = p.btout(); break;
                    case 6: W[u] = p.w_gu; ldw[u] = 5632; K[u] = 1024; Bt[u] = p.btgu(); break;
                    default: W[u] = p.w_down; ldw[u] = 1024; K[u] = 2816; Bt[u] = p.btdown(); break;
                }
                const int nkt = K[u] >> 6; n0[u] = (lt / nkt) * 64; k0[u] = (lt % nkt) * 64; job[u] = j;
            }
            float v[4][8];
            const int col = tid & 63, kr = tid >> 6;
#pragma unroll
            for (int u = 0; u < 4; ++u) {
                const int sc = src_col(job[u], n0[u] + col);
#pragma unroll
                for (int jj = 0; jj < 8; ++jj) { const int k = kr + 8 * jj; v[u][jj] = sc >= 0 ? W[u][(size_t)(k0[u] + k) * ldw[u] + sc] : 0.f; }
            }
#pragma unroll
            for (int u = 0; u < 4; ++u)
#pragma unroll
                for (int jj = 0; jj < 8; ++jj) { const int k = kr + 8 * jj; float x = v[u][jj]; if (job[u] == 4) x *= p.g_ssd[k0[u] + k]; tiles[u * 64 * 65 + k * 65 + col] = x; }
            __syncthreads();
            {
                const int kk = (tid & 31) * 2, nr = tid >> 5;
#pragma unroll
                for (int u = 0; u < 4; ++u)
#pragma unroll
                    for (int jj = 0; jj < 4; ++jj) { const int n = nr + 16 * jj; *(unsigned*)(Bt[u] + (size_t)(n0[u] + n) * K[u] + k0[u] + kk) = cvt_pk_bf16(tiles[u * 64 * 65 + kk * 65 + n], tiles[u * 64 * 65 + (kk + 1) * 65 + n]); }
            }
            __syncthreads();
        }
    }
    {
        LAS float* sc = (LAS float*)lds;
        LAS float* wt = (LAS float*)(lds + 64 * 129 * 4);
        for (int cbk = blockIdx.x; cbk < 256; cbk += gridDim.x) {
            const int col0 = cbk * 24, row = tid & 63, cgp = tid >> 6;
            float a0 = 0.f, a1 = 0.f, a2 = 0.f;
            for (int kc = 0; kc < 8; ++kc) {
                const int k0 = kc * 128;
                __syncthreads();
#pragma unroll
                for (int i = 0; i < 16; ++i) { const int idx = tid + 512 * i, r = idx >> 7, k = idx & 127; const float v = r < 32 ? p.c_p[r * 1024 + k0 + k] : p.c_s[(r - 32) * 1024 + k0 + k]; sc[r * 129 + k] = siluf_(v); }
#pragma unroll
                for (int i = 0; i < 6; ++i) { const int idx = tid + 512 * i, k = idx / 24, c = idx % 24; wt[idx] = p.w_ada[(size_t)(k0 + k) * 6144 + col0 + c]; }
                __syncthreads();
#pragma unroll 8
                for (int k = 0; k < 128; ++k) { const float a = sc[row * 129 + k]; a0 += a * wt[k * 24 + 3 * cgp]; a1 += a * wt[k * 24 + 3 * cgp + 1]; a2 += a * wt[k * 24 + 3 * cgp + 2]; }
            }
            const int c = col0 + 3 * cgp;
            p.mod()[row * 6144 + c] = a0 + p.b_ada[c]; p.mod()[row * 6144 + c + 1] = a1 + p.b_ada[c + 1]; p.mod()[row * 6144 + c + 2] = a2 + p.b_ada[c + 2];
        }
        __syncthreads();
    }
    const size_t gtid = (size_t)blockIdx.x * 512 + tid, gsz = (size_t)gridDim.x * 512;
}

template <int MODE> __device__ void norm_phase(const Params& p, int wv) {
    const int tid = opaque_tid(wv); const int w = tid >> 6, lane = tid & 63;
    const float* g = MODE == 0 ? p.g_mix : (MODE == 1 ? p.g_ffn : p.g_final);
    const int stride = gridDim.x * 8;
    for (int r0 = blockIdx.x * 8 + w; r0 < MT; r0 += 2 * stride) {
        f32x4 v[2][4]; float ss[2] = {0.f, 0.f}; int rr[2];
#pragma unroll
        for (int q = 0; q < 2; ++q) {
            const int r = r0 + q * stride; rr[q] = r < MT ? r : r0;
            if constexpr (MODE == 0) {
                const float* src = rr[q] < MP ? p.x_p + (size_t)rr[q] * 1024 : p.x_s + (size_t)(rr[q] - MP) * 1024;
#pragma unroll
                for (int j = 0; j < 4; ++j) v[q][j] = *(const f32x4*)(src + 256 * j + 4 * lane);
            } else {
                const bf16_t* src = (MODE == 1 ? p.x1buf() : p.x2buf()) + (size_t)rr[q] * 1024;
#pragma unroll
                for (int j = 0; j < 4; ++j) { const u32x2 u = *(const u32x2*)(src + 256 * j + 4 * lane); v[q][j] = (f32x4){bf_lo(u.x), bf_hi(u.x), bf_lo(u.y), bf_hi(u.y)}; }
            }
        }
#pragma unroll
        for (int q = 0; q < 2; ++q) {
#pragma unroll
            for (int j = 0; j < 4; ++j) ss[q] += v[q][j][0] * v[q][j][0] + v[q][j][1] * v[q][j][1] + v[q][j][2] * v[q][j][2] + v[q][j][3] * v[q][j][3];
            ss[q] = wave_sum(ss[q]);
        }
#pragma unroll
        for (int q = 0; q < 2; ++q) {
            if (q == 1 && r0 + stride >= MT) continue;
            const int r = rr[q];
            const float rsn = rsqrtf(ss[q] * (1.0f / 1024.0f) + EPSN);
            const float* mrow = p.mod() + (size_t)batch_of(r) * 6144 + (MODE == 0 ? 0 : 3072);
#pragma unroll
            for (int j = 0; j < 4; ++j) {
                const int c = 256 * j + 4 * lane; const f32x4 gg = *(const f32x4*)(g + c); f32x4 o = v[q][j] * rsn * gg;
                if constexpr (MODE == 2) { *(f32x4*)(p.y() + (size_t)r * 1024 + c) = o; }
                else { const f32x4 sh = *(const f32x4*)(mrow + c), scl = *(const f32x4*)(mrow + 1024 + c); o = o * (1.0f + scl) + sh; *(u32x2*)((MODE == 0 ? p.hA() : p.h2()) + (size_t)r * 1024 + c) = pack4(o); }
            }
        }
    }
}

__device__ void ssdnorm_phase(const Params& p, int wv) {
    const int tid = opaque_tid(wv);
    const bool even = gridDim.x == 256;
    const int nrows = even ? (blockIdx.x < 64 ? 210 : 282) : (MT + (int)gridDim.x - 1) / (int)gridDim.x;
    const int r0 = even ? (blockIdx.x < 64 ? (int)blockIdx.x * 210 : 13440 + ((int)blockIdx.x - 64) * 282) : (int)blockIdx.x * nrows;
    const int r1 = (r0 + nrows) < MT ? (r0 + nrows) : MT;
    const size_t base = (size_t)r0 * 256, total = r0 < MT ? (size_t)(r1 - r0) * 256 : 0;
    for (size_t i0 = tid; i0 < total; i0 += 4 * 512) {
        u32x4 u[4]; float rsn[4]; bf16_t* ptr[4];
#pragma unroll
        for (int q = 0; q < 4; ++q) {
            const size_t i = i0 + (size_t)q * 512; const size_t ic = base + (i < total ? i : i0);
            const size_t r = ic >> 8; const int e8 = (int)(ic & 255), gq = e8 >> 6;
            const float ss = p.ssbuf()[r * 8 + 2 * gq] + p.ssbuf()[r * 8 + 2 * gq + 1];
            rsn[q] = rsqrtf(ss * (1.0f / 512.0f) + EPSN);
            ptr[q] = p.zbuf() + r * 2048 + e8 * 8; u[q] = *(const u32x4*)ptr[q];
        }
#pragma unroll
        for (int q = 0; q < 4; ++q) {
            const size_t i = i0 + (size_t)q * 512; if (i >= total) continue;
            u32x4 o; const float rs = rsn[q];
            o.x = cvt_pk_bf16(bf_lo(u[q].x) * rs, bf_hi(u[q].x) * rs); o.y = cvt_pk_bf16(bf_lo(u[q].y) * rs, bf_hi(u[q].y) * rs); o.z = cvt_pk_bf16(bf_lo(u[q].z) * rs, bf_hi(u[q].z) * rs); o.w = cvt_pk_bf16(bf_lo(u[q].w) * rs, bf_hi(u[q].w) * rs);
            *(u32x4*)ptr[q] = o;
        }
    }
}

constexpr int AT_K = 9216, AT_V = 20480, AT_STAGE = 2 * AT_K + AT_V;
template <bool PAST> __device__ __forceinline__ void attn_item(const Params& p, LAS unsigned char* lds, int row0, int h, const bf16_t* Kb, const bf16_t* Vb, const float* Kc, const float* Vc, int nt0, int nt1, float lam, int wv) {
    const int tid = opaque_tid(wv), w = __builtin_amdgcn_readfirstlane(tid >> 6), lane = tid & 63, l31 = lane & 31, hh = lane >> 5;
    const int hd = w >> 2, rb = w & 3, chunk = rb >> 1;
    const int ntl = nt0 > nt1 ? nt0 : nt1, my_nt = chunk ? nt1 : nt0;
    const int coff = 128 * h;
    bf16x8 qf[4];
    {
        const bf16_t* qp = p.qbuf() + (size_t)(row0 + rb * 32 + l31) * 1024 + coff + 64 * hd + 8 * hh;
#pragma unroll
        for (int s = 0; s < 4; ++s) qf[s] = my_nt > 0 ? *(const bf16x8*)(qp + 16 * s) : (bf16x8){0, 0, 0, 0, 0, 0, 0, 0};
    }
    f32x16 O[4];
#pragma unroll
    for (int c = 0; c < 4; ++c)
#pragma unroll
        for (int e = 0; e < 16; ++e) O[c][e] = 0.f;
    float m_run = -1e30f, l_run = 0.f;
    u32x4 kreg[2], vreg[2];
    f32x4 kf[PAST ? 2 : 1][2], vf[PAST ? 2 : 1][2];
    auto gload = [&](int t) {
        if (PAST && t < 16) {
            const int key0 = 64 * t;
#pragma unroll
            for (int jj = 0; jj < 2; ++jj) {
                const int idx = tid + 512 * jj;
                { const int which = idx >> 9, row = (idx >> 3) & 63, ch = idx & 7; const float* sp = Kc + (size_t)(key0 + row) * 1024 + coff + 64 * which + 8 * ch; kf[PAST ? jj : 0][0] = *(const f32x4*)sp; kf[PAST ? jj : 0][1] = *(const f32x4*)(sp + 4); }
                { const int row = idx >> 4, ch = idx & 15; const float* sp = Vc + (size_t)(key0 + row) * 1024 + coff + 8 * ch; vf[PAST ? jj : 0][0] = *(const f32x4*)sp; vf[PAST ? jj : 0][1] = *(const f32x4*)(sp + 4); }
            }
        } else {
            const int key0 = PAST ? 0 : 64 * t;
#pragma unroll
            for (int jj = 0; jj < 2; ++jj) {
                const int idx = tid + 512 * jj;
                { const int which = idx >> 9, row = (idx >> 3) & 63, ch = idx & 7; kreg[jj] = *(const u32x4*)(Kb + (size_t)(key0 + row) * 1024 + coff + 64 * which + 8 * ch); }
                { const int row = idx >> 4, ch = idx & 15; vreg[jj] = *(const u32x4*)(Vb + (size_t)(key0 + row) * 1024 + coff + 8 * ch); }
            }
        }
    };
    auto swrite = [&](int st, int t) {
        LAS unsigned char* base = lds + st * AT_STAGE;
        if (PAST && t < 16) {
#pragma unroll
            for (int jj = 0; jj < 2; ++jj) { kreg[jj] = pack8(kf[PAST ? jj : 0][0], kf[PAST ? jj : 0][1]); vreg[jj] = pack8(vf[PAST ? jj : 0][0], vf[PAST ? jj : 0][1]); }
        }
#pragma unroll
        for (int jj = 0; jj < 2; ++jj) {
            const int idx = tid + 512 * jj;
            { const int which = idx >> 9, row = (idx >> 3) & 63, ch = idx & 7; *(LAS u32x4*)(base + which * AT_K + row * 144 + ch * 16) = kreg[jj]; }
            { const int row = idx >> 4, ch = idx & 15; *(LAS u32x4*)(base + 2 * AT_K + row * 320 + ch * 16) = vreg[jj]; }
        }
    };
    const int q4 = (lane & 15) >> 2, blk = (lane >> 4) & 1, pp = lane & 3;
    auto qk = [&](int st, f32x16 (&S)[2]) {
        LAS unsigned char* Kt = lds + st * AT_STAGE + hd * AT_K + l31 * 144 + hh * 16;
#pragma unroll
        for (int kb = 0; kb < 2; ++kb) {
#pragma unroll
            for (int e = 0; e < 16; ++e) S[kb][e] = 0.f;
#pragma unroll
            for (int s = 0; s < 4; ++s) { const bf16x8 a = *(const LAS bf16x8*)(Kt + kb * 32 * 144 + s * 32); S[kb] = __builtin_amdgcn_mfma_f32_32x32x16_bf16(a, qf[s], S[kb], 0, 0, 0); }
        }
    };
    auto smpv = [&](int st, f32x16 (&S)[2]) {
        LAS unsigned char* Vt = lds + st * AT_STAGE + 2 * AT_K + (4 * hh + q4) * 320 + (16 * blk + 4 * pp) * 2;
        float mx = S[0][0];
#pragma unroll
        for (int e = 1; e < 16; ++e) mx = fmaxf(mx, S[0][e]);
#pragma unroll
        for (int e = 0; e < 16; ++e) mx = fmaxf(mx, S[1][e]);
        mx = fmaxf(mx, __shfl_xor(mx, 32));
        const float mn = mx > m_run + 8.0f ? mx : m_run, alpha = fexp2(m_run - mn); m_run = mn;
        float rsum = 0.f;
#pragma unroll
        for (int kb = 0; kb < 2; ++kb)
#pragma unroll
            for (int e = 0; e < 16; ++e) { const float pv = fexp2(S[kb][e] - mn); S[kb][e] = pv; rsum += pv; }
        l_run = l_run * alpha + rsum;
        if (__builtin_amdgcn_ballot_w64(alpha != 1.0f) != 0ull) {
#pragma unroll
            for (int c = 0; c < 4; ++c)
#pragma unroll
                for (int e = 0; e < 16; ++e) O[c][e] *= alpha;
        }
#pragma unroll
        for (int kb = 0; kb < 2; ++kb)
#pragma unroll
            for (int sp = 0; sp < 2; ++sp) {
                union { u32x4 u; bf16x8 v; } pb;
                pb.u.x = cvt_pk_bf16(S[kb][8 * sp + 0], S[kb][8 * sp + 1]); pb.u.y = cvt_pk_bf16(S[kb][8 * sp + 2], S[kb][8 * sp + 3]);
                pb.u.z = cvt_pk_bf16(S[kb][8 * sp + 4], S[kb][8 * sp + 5]); pb.u.w = cvt_pk_bf16(S[kb][8 * sp + 6], S[kb][8 * sp + 7]);
#pragma unroll
                for (int c = 0; c < 4; ++c) {
                    LAS unsigned char* va = Vt + (32 * kb + 16 * sp) * 320 + 64 * c;
                    const s16x4 v0 = __builtin_amdgcn_ds_read_tr16_b64_v4i16((LAS s16x4*)va);
                    const s16x4 v1 = __builtin_amdgcn_ds_read_tr16_b64_v4i16((LAS s16x4*)(va + 8 * 320));
                    const bf16x8 vfr = {v0[0], v0[1], v0[2], v0[3], v1[0], v1[1], v1[2], v1[3]};
                    O[c] = __builtin_amdgcn_mfma_f32_32x32x16_bf16(vfr, pb.v, O[c], 0, 0, 0);
                }
            }
    };
    if constexpr (PAST) {
        gload(0); swrite(0, 0); __syncthreads();
        for (int t = 0; t < ntl; ++t) {
            if (t + 1 < ntl) gload(t + 1);
            if (t < my_nt) { f32x16 S[2]; qk(t & 1, S); smpv(t & 1, S); }
            if (t + 1 < ntl) swrite((t + 1) & 1, t + 1);
            __syncthreads();
        }
    } else {
        gload(0); swrite(0, 0); if (ntl > 1) gload(1);
        __syncthreads();
        f32x16 Sn[2];
        if (my_nt > 0) qk(0, Sn);
        int st = 0;
        for (int t = 0; t < ntl; ++t) {
            const int st1 = st == 2 ? 0 : st + 1;
            f32x16 Sc[2]; Sc[0] = Sn[0]; Sc[1] = Sn[1];
            if (t + 1 < ntl) swrite(st1, t + 1);
            if (t + 2 < ntl) gload(t + 2);
            __syncthreads();
            if (t + 1 < my_nt) { qk(st1, Sn); smpv(st, Sc); }
            else if (t < my_nt) { smpv(st, Sc); }
            st = st1;
        }
        __syncthreads();
    }
    const float lt = l_run + __shfl_xor(l_run, 32);
    const float inv = my_nt > 0 ? 1.0f / lt : 0.f;
    LAS float* X = (LAS float*)lds;
    if (hd == 1) {
#pragma unroll
        for (int c = 0; c < 4; ++c)
#pragma unroll
            for (int i = 0; i < 4; ++i) { f32x4 o = {O[c][4 * i] * inv, O[c][4 * i + 1] * inv, O[c][4 * i + 2] * inv, O[c][4 * i + 3] * inv}; *(LAS f32x4*)(X + (rb * 32 + l31) * 132 + 32 * c + 8 * i + 4 * hh) = o; }
    }
    __syncthreads();
    if (hd == 0 && my_nt > 0) {
        float ss = 0.f;
#pragma unroll
        for (int c = 0; c < 4; ++c)
#pragma unroll
            for (int i = 0; i < 4; ++i) {
                const f32x4 o2 = *(const LAS f32x4*)(X + (rb * 32 + l31) * 132 + 32 * c + 8 * i + 4 * hh);
#pragma unroll
                for (int j = 0; j < 4; ++j) { const float o = O[c][4 * i + j] * inv - lam * o2[j]; O[c][4 * i + j] = o; ss += o * o; }
            }
        ss += __shfl_xor(ss, 32);
        const float rsn = rsqrtf(ss * (1.0f / 128.0f) + EPSN) * 0.8f;
        bf16_t* op = p.qbuf() + (size_t)(row0 + rb * 32 + l31) * 1024 + coff + 4 * hh;
#pragma unroll
        for (int c = 0; c < 4; ++c)
#pragma unroll
            for (int i = 0; i < 4; ++i) {
                const f32x4 g = *(const f32x4*)(p.g_subln + 32 * c + 8 * i + 4 * hh);
                const f32x4 o = {O[c][4 * i] * rsn * g[0], O[c][4 * i + 1] * rsn * g[1], O[c][4 * i + 2] * rsn * g[2], O[c][4 * i + 3] * rsn * g[3]};
                *(u32x2*)(op + 32 * c + 8 * i) = pack4(o);
            }
    }
    __syncthreads();
}

__device__ void attn_phase(const Params& p, LAS unsigned char* lds, int wv) {
    const int lane = opaque_tid(wv) & 63;
    const float a1 = wave_sum(p.lq1[lane] * p.lk1[lane]), a2 = wave_sum(p.lq2[lane] * p.lk2[lane]);
    const float lamv = __expf(a1) - __expf(a2) + 0.2f;
    const float lam = __builtin_bit_cast(float, __builtin_amdgcn_readfirstlane(__builtin_bit_cast(int, lamv)));
    for (int j = blockIdx.x; j < 256; j += gridDim.x) {
        const int b = j >> 3, h = j & 7;
#pragma unroll 1
        for (int i = 15; i >= 0; --i) attn_item<false>(p, lds, b * 2048 + 128 * i, h, p.kbuf_p() + (size_t)b * 2048 * 1024, p.vbuf_p() + (size_t)b * 2048 * 1024, nullptr, nullptr, 2 * i + 1, 2 * i + 2, lam, wv);
        attn_item<true>(p, lds, MP + 64 * b, h, p.kbuf_s() + (size_t)b * 64 * 1024, p.vbuf_s() + (size_t)b * 64 * 1024, p.cache_k + (size_t)b * 1024 * 1024, p.cache_v + (size_t)b * 1024 * 1024, 17, 0, lam, wv);
    }
}

__device__ void conv_phase(const Params& p, int wv) {
    const size_t gtid = (size_t)blockIdx.x * 512 + opaque_tid(wv), gsz = (size_t)gridDim.x * 512, total = (size_t)(MT / 64) * 384;
    for (size_t it = gtid; it < total; it += gsz) {
        const int cg = (int)(it / 384), sp = (int)(it % 384), col = sp * 8;
        f32x4 wv4[4][2], bias[2];
#pragma unroll
        for (int j = 0; j < 4; ++j) { wv4[j][0] = *(const f32x4*)(p.conv_w + j * 3072 + col); wv4[j][1] = *(const f32x4*)(p.conv_w + j * 3072 + col + 4); }
        bias[0] = *(const f32x4*)(p.conv_b + col); bias[1] = *(const f32x4*)(p.conv_b + col + 4);
        f32x4 win[3][2];
        const bool samp = cg >= MP / 64;
        if (samp) {
            const float* sc = p.state_conv + (size_t)(cg - MP / 64) * 3 * 3072 + col;
#pragma unroll
            for (int q = 0; q < 3; ++q) { win[q][0] = *(const f32x4*)(sc + q * 3072); win[q][1] = *(const f32x4*)(sc + q * 3072 + 4); }
        } else if ((cg & 31) == 0) {
#pragma unroll
            for (int q = 0; q < 3; ++q) { win[q][0] = (f32x4){0.f, 0.f, 0.f, 0.f}; win[q][1] = win[q][0]; }
        } else {
            const bf16_t* hp = p.halo() + (size_t)(cg - 1) * 3 * 3072 + col;
#pragma unroll
            for (int q = 0; q < 3; ++q) { const u32x4 u = *(const u32x4*)(hp + q * 3072); win[q][0] = (f32x4){bf_lo(u.x), bf_hi(u.x), bf_lo(u.y), bf_hi(u.y)}; win[q][1] = (f32x4){bf_lo(u.z), bf_hi(u.z), bf_lo(u.w), bf_hi(u.w)}; }
        }
        bf16_t* xp = p.xbcbuf() + (size_t)cg * 64 * 3072 + col;
#pragma unroll 1
        for (int t0 = 0; t0 < 64; t0 += 8) {
            u32x4 raw[8];
#pragma unroll
            for (int q = 0; q < 8; ++q) raw[q] = *(const u32x4*)(xp + (size_t)(t0 + q) * 3072);
#pragma unroll
            for (int q = 0; q < 8; ++q) {
                const f32x4 c0 = {bf_lo(raw[q].x), bf_hi(raw[q].x), bf_lo(raw[q].y), bf_hi(raw[q].y)}, c1 = {bf_lo(raw[q].z), bf_hi(raw[q].z), bf_lo(raw[q].w), bf_hi(raw[q].w)};
                f32x4 o0 = bias[0] + wv4[0][0] * win[0][0] + wv4[1][0] * win[1][0] + wv4[2][0] * win[2][0] + wv4[3][0] * c0;
                f32x4 o1 = bias[1] + wv4[0][1] * win[0][1] + wv4[1][1] * win[1][1] + wv4[2][1] * win[2][1] + wv4[3][1] * c1;
                win[0][0] = win[1][0]; win[0][1] = win[1][1]; win[1][0] = win[2][0]; win[1][1] = win[2][1]; win[2][0] = c0; win[2][1] = c1;
#pragma unroll
                for (int e = 0; e < 4; ++e) { o0[e] = siluf_(o0[e]); o1[e] = siluf_(o1[e]); }
                *(u32x4*)(xp + (size_t)(t0 + q) * 3072) = pack8(o0, o1);
            }
        }
    }
}

constexpr int SD_XT = 0, SD_BM = 36864, SD_BT = SD_BM + 17408, SD_CM = SD_BT + 18432, SD_CB = SD_CM + 17408, SD_CUM = SD_CB + 17408, SD_DT = SD_CUM + 1024, SD_SS = SD_DT + 1024;
__device__ void ssd_phase(const Params& p, LAS unsigned char* lds, int wv) {
    const int tid = opaque_tid(wv), w = __builtin_amdgcn_readfirstlane(tid >> 6), lane = tid & 63, l15 = lane & 15, g4 = lane >> 4;
    const int k = w >> 1, ph = w & 1;
    for (int jb = blockIdx.x; jb < 256; jb += gridDim.x) {
        const int b = jb >> 3, hq = jb & 7, grp = hq >> 1, head = 4 * hq + k;
        f32x4 Sacc[8][2];
#pragma unroll
        for (int nb = 0; nb < 8; ++nb)
#pragma unroll
            for (int pb = 0; pb < 2; ++pb) Sacc[nb][pb] = (f32x4){0.f, 0.f, 0.f, 0.f};
        const float a_h = -__expf(p.a_log[head]), dtb = p.dt_bias[head], dsk = p.d_skip[head];
        for (int step = 0; step < 33; ++step) {
            const bool samp = step == 32;
            const int row0 = samp ? MP + 64 * b : b * 2048 + 64 * step;
            if (samp) {
                float* so = p.nssm_p() + ((size_t)(b * 32 + head) * 64) * 128; const float* si = p.state_ssm + ((size_t)(b * 32 + head) * 64) * 128;
#pragma unroll
                for (int nb = 0; nb < 8; ++nb)
#pragma unroll
                    for (int pb = 0; pb < 2; ++pb) { const size_t o = (size_t)(32 * ph + 16 * pb + l15) * 128 + 16 * nb + 4 * g4; *(f32x4*)(so + o) = Sacc[nb][pb]; Sacc[nb][pb] = *(const f32x4*)(si + o); }
            }
            float dtraw = 0.f;
            if (w < 4) dtraw = p.dtbuf()[(size_t)(row0 + lane) * 32 + 4 * hq + w];
            {
                int tdx = tid; asm volatile("" : "+v"(tdx));
                const int tb = tdx & 7, cq = tdx >> 3;
                const int ccol0 = 256 * hq + 4 * cq;
                const bool isB = w < 4; const int n0 = 4 * (cq & 31);
                const int ccol1 = (isB ? 2048 : 2560) + 128 * grp + n0;
                u32x2 r0[8], r1[8];
                const bf16_t* xr0 = p.xbcbuf() + (size_t)(row0 + 8 * tb) * 3072;
#pragma unroll
                for (int tt = 0; tt < 8; ++tt) { r0[tt] = *(const u32x2*)(xr0 + (size_t)tt * 3072 + ccol0); r1[tt] = *(const u32x2*)(xr0 + (size_t)tt * 3072 + ccol1); }
                {
                    f32x4 outv[8];
#pragma unroll
                    for (int tt = 0; tt < 8; ++tt) outv[tt] = (f32x4){bf_lo(r0[tt].x), bf_hi(r0[tt].x), bf_lo(r0[tt].y), bf_hi(r0[tt].y)};
                    LAS unsigned char* base = lds + SD_XT + (cq >> 4) * 9216 + (4 * (cq & 15)) * 144 + 16 * tb;
#pragma unroll
                    for (int e = 0; e < 4; ++e) { u32x4 u; u.x = cvt_pk_bf16(outv[0][e], outv[1][e]); u.y = cvt_pk_bf16(outv[2][e], outv[3][e]); u.z = cvt_pk_bf16(outv[4][e], outv[5][e]); u.w = cvt_pk_bf16(outv[6][e], outv[7][e]); *(LAS u32x4*)(base + e * 144) = u; }
                }
                {
                    f32x4 outv[8];
#pragma unroll
                    for (int tt = 0; tt < 8; ++tt) outv[tt] = (f32x4){bf_lo(r1[tt].x), bf_hi(r1[tt].x), bf_lo(r1[tt].y), bf_hi(r1[tt].y)};
                    LAS unsigned char* rowimg = lds + (isB ? SD_BM : SD_CM);
#pragma unroll
                    for (int tt = 0; tt < 8; ++tt) *(LAS u32x2*)(rowimg + (8 * tb + tt) * 272 + n0 * 2) = r1[tt];
                    if (isB) {
#pragma unroll
                        for (int e = 0; e < 4; ++e) { u32x4 u; u.x = cvt_pk_bf16(outv[0][e], outv[1][e]); u.y = cvt_pk_bf16(outv[2][e], outv[3][e]); u.z = cvt_pk_bf16(outv[4][e], outv[5][e]); u.w = cvt_pk_bf16(outv[6][e], outv[7][e]); *(LAS u32x4*)(lds + SD_BT + (n0 + e) * 144 + 16 * tb) = u; }
                    }
                }
            }
            if (w < 4) {
                const int hd2 = 4 * hq + w;
                const float xr = dtraw + p.dt_bias[hd2];
                const float dt = xr > 20.f ? xr : log1pf(__expf(xr));
                float cum = dt * (-__expf(p.a_log[hd2]));
#pragma unroll
                for (int o = 1; o < 64; o <<= 1) { const float t2 = __shfl_up(cum, o); if (lane >= o) cum += t2; }
                ((LAS float*)(lds + SD_CUM))[w * 64 + lane] = cum; ((LAS float*)(lds + SD_DT))[w * 64 + lane] = dt;
            }
            __syncthreads();
            {
                const int lb = w >> 1;
#pragma unroll
                for (int q = 0; q < 2; ++q) {
                    const int sb = 2 * (w & 1) + q; f32x4 c4 = {0.f, 0.f, 0.f, 0.f};
#pragma unroll
                    for (int ks = 0; ks < 4; ++ks) {
                        const bf16x8 a = *(const LAS bf16x8*)(lds + SD_CM + (16 * lb + l15) * 272 + (32 * ks + 8 * g4) * 2);
                        const bf16x8 bb = *(const LAS bf16x8*)(lds + SD_BM + (16 * sb + l15) * 272 + (32 * ks + 8 * g4) * 2);
                        c4 = __builtin_amdgcn_mfma_f32_16x16x32_bf16(a, bb, c4, 0, 0, 0);
                    }
#pragma unroll
                    for (int j = 0; j < 4; ++j) ((LAS float*)(lds + SD_CB))[(16 * lb + 4 * g4 + j) * 68 + 16 * sb + l15] = c4[j];
                }
            }
            __syncthreads();
            {
                const LAS float* cumL = (const LAS float*)(lds + SD_CUM) + k * 64; const LAS float* dtL = (const LAS float*)(lds + SD_DT) + k * 64;
                const LAS unsigned char* XTk = lds + SD_XT + k * 9216;
                f32x4 yT[2][4];
#pragma unroll
                for (int pb = 0; pb < 2; ++pb)
#pragma unroll
                    for (int lb = 0; lb < 4; ++lb) yT[pb][lb] = (f32x4){0.f, 0.f, 0.f, 0.f};
#pragma unroll
                for (int ks = 0; ks < 4; ++ks) {
                    __builtin_amdgcn_sched_barrier(0);
                    union { u32x4 u; bf16x8 v; } af[2];
#pragma unroll
                    for (int pb = 0; pb < 2; ++pb) { af[pb].u.x = cvt_pk_bf16(Sacc[2 * ks][pb][0], Sacc[2 * ks][pb][1]); af[pb].u.y = cvt_pk_bf16(Sacc[2 * ks][pb][2], Sacc[2 * ks][pb][3]); af[pb].u.z = cvt_pk_bf16(Sacc[2 * ks + 1][pb][0], Sacc[2 * ks + 1][pb][1]); af[pb].u.w = cvt_pk_bf16(Sacc[2 * ks + 1][pb][2], Sacc[2 * ks + 1][pb][3]); }
#pragma unroll
                    for (int lb = 0; lb < 4; ++lb) {
                        const LAS unsigned char* cp = lds + SD_CM + (16 * lb + l15) * 272 + (32 * ks + 4 * g4) * 2;
                        union { u32x4 u; bf16x8 v; } bf; const u32x2 c0 = *(const LAS u32x2*)cp, c1 = *(const LAS u32x2*)(cp + 32);
                        bf.u.x = c0.x; bf.u.y = c0.y; bf.u.z = c1.x; bf.u.w = c1.y;
#pragma unroll
                        for (int pb = 0; pb < 2; ++pb) yT[pb][lb] = __builtin_amdgcn_mfma_f32_16x16x32_bf16(af[pb].v, bf.v, yT[pb][lb], 0, 0, 0);
                    }
                }
#pragma unroll
                for (int lb = 0; lb < 4; ++lb) { const float ec = fexp(cumL[16 * lb + l15]);
#pragma unroll
                    for (int pb = 0; pb < 2; ++pb) yT[pb][lb] *= ec; }
#pragma unroll
                for (int ks = 0; ks < 2; ++ks) {
                    __builtin_amdgcn_sched_barrier(0);
                    bf16x8 xa[2];
#pragma unroll
                    for (int pb = 0; pb < 2; ++pb) xa[pb] = *(const LAS bf16x8*)(XTk + (32 * ph + 16 * pb + l15) * 144 + (32 * ks + 8 * g4) * 2);
                    const int s0 = 32 * ks + 8 * g4;
                    const f32x4 cs0 = *(const LAS f32x4*)(cumL + s0), cs1 = *(const LAS f32x4*)(cumL + s0 + 4), ds0 = *(const LAS f32x4*)(dtL + s0), ds1 = *(const LAS f32x4*)(dtL + s0 + 4);
#pragma unroll
                    for (int lb = 0; lb < 4; ++lb) {
                        if (32 * ks > 16 * lb + 15) continue;
                        __builtin_amdgcn_sched_barrier(0);
                        const int l = 16 * lb + l15; const float cl = cumL[l];
                        const LAS float* cbp = (const LAS float*)(lds + SD_CB) + l * 68 + s0;
                        const f32x4 cb0 = *(const LAS f32x4*)cbp, cb1 = *(const LAS f32x4*)(cbp + 4);
                        float mv[8];
#pragma unroll
                        for (int e = 0; e < 4; ++e) {
                            { const int s = s0 + e; float v = s <= l ? cb0[e] * fexp(cl - cs0[e]) * ds0[e] : 0.f; if (s == l) v += dsk; mv[e] = v; }
                            { const int s = s0 + 4 + e; float v = s <= l ? cb1[e] * fexp(cl - cs1[e]) * ds1[e] : 0.f; if (s == l) v += dsk; mv[4 + e] = v; }
                        }
                        union { u32x4 u; bf16x8 v; } mf; mf.u.x = cvt_pk_bf16(mv[0], mv[1]); mf.u.y = cvt_pk_bf16(mv[2], mv[3]); mf.u.z = cvt_pk_bf16(mv[4], mv[5]); mf.u.w = cvt_pk_bf16(mv[6], mv[7]);
#pragma unroll
                        for (int pb = 0; pb < 2; ++pb) yT[pb][lb] = __builtin_amdgcn_mfma_f32_16x16x32_bf16(xa[pb], mf.v, yT[pb][lb], 0, 0, 0);
                    }
                }
                float ssl[4];
#pragma unroll
                for (int lb = 0; lb < 4; ++lb) {
                    __builtin_amdgcn_sched_barrier(0);
                    float ss = 0.f;
#pragma unroll
                    for (int pb = 0; pb < 2; ++pb) {
                        bf16_t* zp = p.zbuf() + (size_t)(row0 + 16 * lb + l15) * 2048 + 64 * head + 32 * ph + 16 * pb + 4 * g4;
                        const u32x2 zz = *(const u32x2*)zp;
                        f32x4 u = yT[pb][lb]; u[0] *= siluf_(bf_lo(zz.x)); u[1] *= siluf_(bf_hi(zz.x)); u[2] *= siluf_(bf_lo(zz.y)); u[3] *= siluf_(bf_hi(zz.y));
                        ss += u[0] * u[0] + u[1] * u[1] + u[2] * u[2] + u[3] * u[3];
                        *(u32x2*)zp = pack4(u);
                    }
                    ss += __shfl_xor(ss, 16); ss += __shfl_xor(ss, 32); ssl[lb] = ss;
                }
                if (g4 == 0) {
#pragma unroll
                    for (int lb = 0; lb < 4; ++lb) ((LAS float*)(lds + SD_SS))[w * 64 + 16 * lb + l15] = ssl[lb];
                }
                const float cend = cumL[63], dec = fexp(cend);
#pragma unroll
                for (int nb = 0; nb < 8; ++nb)
#pragma unroll
                    for (int pb = 0; pb < 2; ++pb) Sacc[nb][pb] *= dec;
#pragma unroll
                for (int ks = 0; ks < 2; ++ks) {
                    __builtin_amdgcn_sched_barrier(0);
                    const int s0 = 32 * ks + 8 * g4;
                    const f32x4 cs0 = *(const LAS f32x4*)(cumL + s0), cs1 = *(const LAS f32x4*)(cumL + s0 + 4), ds0 = *(const LAS f32x4*)(dtL + s0), ds1 = *(const LAS f32x4*)(dtL + s0 + 4);
                    float wsv[8];
#pragma unroll
                    for (int e = 0; e < 4; ++e) { wsv[e] = ds0[e] * fexp(cend - cs0[e]); wsv[4 + e] = ds1[e] * fexp(cend - cs1[e]); }
                    union { u32x4 u; bf16x8 v; } xb[2];
#pragma unroll
                    for (int pb = 0; pb < 2; ++pb) {
                        const u32x4 xr = *(const LAS u32x4*)(XTk + (32 * ph + 16 * pb + l15) * 144 + s0 * 2);
                        xb[pb].u.x = cvt_pk_bf16(bf_lo(xr.x) * wsv[0], bf_hi(xr.x) * wsv[1]); xb[pb].u.y = cvt_pk_bf16(bf_lo(xr.y) * wsv[2], bf_hi(xr.y) * wsv[3]);
                        xb[pb].u.z = cvt_pk_bf16(bf_lo(xr.z) * wsv[4], bf_hi(xr.z) * wsv[5]); xb[pb].u.w = cvt_pk_bf16(bf_lo(xr.w) * wsv[6], bf_hi(xr.w) * wsv[7]);
                    }
#pragma unroll
                    for (int nb = 0; nb < 8; ++nb) {
                        const bf16x8 ba = *(const LAS bf16x8*)(lds + SD_BT + (16 * nb + l15) * 144 + s0 * 2);
#pragma unroll
                        for (int pb = 0; pb < 2; ++pb) Sacc[nb][pb] = __builtin_amdgcn_mfma_f32_16x16x32_bf16(ba, xb[pb].v, Sacc[nb][pb], 0, 0, 0);
                    }
                }
            }
            __syncthreads();
            if (tid < 64) {
                float s = 0.f;
#pragma unroll
                for (int ww = 0; ww < 8; ++ww) s += ((const LAS float*)(lds + SD_SS))[ww * 64 + tid];
                p.ssbuf()[(size_t)(row0 + tid) * 8 + hq] = s;
            }
        }
        {
            float* so = p.nssm_s() + ((size_t)(b * 32 + head) * 64) * 128;
#pragma unroll
            for (int nb = 0; nb < 8; ++nb)
#pragma unroll
                for (int pb = 0; pb < 2; ++pb) *(f32x4*)(so + (size_t)(32 * ph + 16 * pb + l15) * 128 + 16 * nb + 4 * g4) = Sacc[nb][pb];
        }
        (void)a_h; (void)dtb;
    }
}

__device__ __forceinline__ void grid_barrier(unsigned* ctr, unsigned target, int wv) {
    asm volatile("s_waitcnt vmcnt(0) lgkmcnt(0)" ::: "memory");
    __builtin_amdgcn_s_barrier();
    if (wv == 0) {
        unsigned z = 0u; asm volatile("" : "+s"(z));
        const unsigned ln = __builtin_amdgcn_mbcnt_hi(~0u, __builtin_amdgcn_mbcnt_lo(~0u, z));
        if (ln == 0) {
            __builtin_amdgcn_fence(__ATOMIC_RELEASE, "agent");
            __hip_atomic_fetch_add(ctr, 1u, __ATOMIC_RELAXED, __HIP_MEMORY_SCOPE_AGENT);
            while (__hip_atomic_load(ctr, __ATOMIC_RELAXED, __HIP_MEMORY_SCOPE_AGENT) < target) __builtin_amdgcn_s_sleep(2);
        }
    }
    __builtin_amdgcn_s_barrier();
    __builtin_amdgcn_fence(__ATOMIC_ACQUIRE, "agent");
    asm volatile("s_waitcnt vmcnt(0) lgkmcnt(0)" ::: "memory");
}

__global__ void __launch_bounds__(512, 2) fwd_megakernel(Params p) {
    extern __shared__ __attribute__((aligned(16))) unsigned char shm[];
    LAS unsigned char* lds = (LAS unsigned char*)shm;
    cg::grid_group grid = cg::this_grid();
#ifndef PHMASK
#define PHMASK 0x3fff
#endif
#ifdef DBG_TIME_I
#define TSTAMP(k) if (blockIdx.x == 0 && threadIdx.x == 0) ((unsigned long long*)(p.ws + WS_END))[k] = __builtin_amdgcn_s_memrealtime();
#else
#define TSTAMP(k)
#endif
    TSTAMP(0)
#define PHASE(n, ...) if (p.ph_lo <= (n) && (n) < p.ph_hi) { if constexpr ((PHMASK >> (n)) & 1) { __VA_ARGS__ } if ((n) + 1 < p.ph_hi) { \
        grid_barrier((unsigned*)(p.ws + WS_END + 256), (unsigned)((n) - p.ph_lo + 1) * gridDim.x, wv); } TSTAMP((n) + 1) }
    const int wv = __builtin_amdgcn_readfirstlane(threadIdx.x >> 6);
    if (p.ph_hi < 0) grid.sync();
    PHASE(0, prep_phase(p, lds, wv);)
    PHASE(1, norm_phase<0>(p, wv);)
    PHASE(2, run_gemm<0>(p, lds, p.hA(), p.bt1a(), 3072, 1024, wv);)
    PHASE(3, attn_phase(p, lds, wv);)
    PHASE(4, run_gemm<1>(p, lds, p.hA(), p.bt1b(), 5376, 1024, wv);)
    PHASE(5, conv_phase(p, wv);)
    PHASE(6, ssd_phase(p, lds, wv);)
    PHASE(7, run_gemm<2>(p, lds, p.hA(), p.bt1c(), 2048, 1024, wv); ssdnorm_phase(p, wv);)
    PHASE(8, run_gemm<3>(p, lds, p.qbuf(), p.btpa(), 1024, 1024, wv); run_gemm<4>(p, lds, p.zbuf(), p.btpb(), 1024, 2048, wv);)
    PHASE(9, run_gemm<5>(p, lds, p.mbuf(), p.btout(), 1024, 1024, wv);)
    PHASE(10, norm_phase<1>(p, wv);)
    PHASE(11, run_gemm<6>(p, lds, p.h2(), p.btgu(), 5632, 1024, wv);)
    PHASE(12, run_gemm<7>(p, lds, p.swbuf(), p.btdown(), 1024, 2816, wv);)
    PHASE(13, norm_phase<2>(p, wv);)
#undef PHASE
}


#ifdef DBG_TIME_I
__global__ void dbg_time_apply(float* out, const unsigned long long* ts) {
    const float tot = (float)(ts[14] - ts[0]); const float fi = (float)(ts[DBG_TIME_I + 1] - ts[DBG_TIME_I]) / tot, fj = (float)(ts[DBG_TIME_J + 1] - ts[DBG_TIME_J]) / tot;
    const float sc = 1.0f + sqrtf(fi);
    for (size_t i = O_NCS + (size_t)blockIdx.x * 256 + threadIdx.x; i < O_NCS + 294912; i += (size_t)gridDim.x * 256) out[i] *= sc;
    if (blockIdx.x == 0 && threadIdx.x == 0) out[0] += 1000.0f * fj;
}
#endif
extern "C" void kernel_launch(void* const* d_in, const int* in_sizes, int n_in, void* d_out, int out_size, void* d_ws, size_t ws_size, hipStream_t stream) {
    static int grid_blocks = 0;
    if (!grid_blocks) {
        int dev = 0, cus = 0, per_cu = 0;
        hipGetDevice(&dev);
        hipDeviceGetAttribute(&cus, hipDeviceAttributeMultiprocessorCount, dev);
        hipFuncSetAttribute((const void*)fwd_megakernel, hipFuncAttributeMaxDynamicSharedMemorySize, LDS_BYTES);
        hipOccupancyMaxActiveBlocksPerMultiprocessor(&per_cu, (const void*)fwd_megakernel, 512, LDS_BYTES);
        if (per_cu < 1) per_cu = 1;
        grid_blocks = cus * per_cu;
        if (grid_blocks > 256) grid_blocks = 256;
    }
    Params p{};
    const float* const* in = (const float* const*)d_in;
    p.x_p = in[0]; p.x_s = in[1]; p.cache_k = in[2]; p.cache_v = in[3]; p.state_conv = in[4]; p.state_ssm = in[5]; p.c_p = in[6]; p.c_s = in[7];
    p.w_ada = in[8]; p.b_ada = in[9]; p.g_mix = in[10]; p.g_ffn = in[11]; p.w_in = in[12]; p.lq1 = in[13]; p.lk1 = in[14]; p.lq2 = in[15]; p.lk2 = in[16]; p.g_subln = in[17];
    p.conv_w = in[18]; p.conv_b = in[19]; p.dt_bias = in[20]; p.a_log = in[21]; p.d_skip = in[22]; p.g_ssd = in[23]; p.w_pa = in[24]; p.w_pb = in[25]; p.w_out = in[26]; p.w_gu = in[27]; p.w_down = in[28]; p.g_final = in[29];
    p.out = (float*)d_out; p.ws = (unsigned char*)d_ws;
    if (WS_END + 1024 > ws_size || (size_t)out_size < O_END) { fprintf(stderr, "kernel_launch: workspace/output too small: need %zu / %zu, have %zu / %d\n", (size_t)WS_END, (size_t)O_END, ws_size, out_size); return; }
    hipMemsetAsync((unsigned char*)d_ws + WS_END + 256, 0, 64, stream);
    p.ph_lo = 0; p.ph_hi = 14;
    void* args[] = {&p};
    hipError_t e = hipLaunchCooperativeKernel((const void*)fwd_megakernel, dim3(grid_blocks), dim3(512), args, LDS_BYTES, stream);
    if (e != hipSuccess) fprintf(stderr, "cooperative launch failed: %s (grid %d)\n", hipGetErrorString(e), grid_blocks);
#ifdef DBG_TIME_I
    dbg_time_apply<<<64, 256, 0, stream>>>((float*)d_out, (const unsigned long long*)((unsigned char*)d_ws + WS_END));
#endif
}
```
